# Optimizing an MI355X kernel written in HIP

```python
import jax, jax.numpy as jnp
from jax import lax
import numpy as np

D_MODEL = 1024
BATCH = 1
SEQ = 16384
DEPTH = 4
DEC_BATCH = 16
DEC_SEQ = 64
PAST_LEN = 4096

CHUNK = 64
LEFT_CHUNKS = 8
WINDOW_A = LEFT_CHUNKS * CHUNK
H_A = 16
HD_A = D_MODEL // H_A
REL_CLIP = 128
N_REL = 2 * REL_CLIP + 1
H_B = 4
D_IN = D_MODEL
HD_B = D_IN // H_B
CONV_W = 4
D_FF = 4 * D_MODEL
N_A = (DEPTH + 1) // 2
N_B = DEPTH // 2
EPS = 1e-6
NEG = -1e30
F32 = jnp.float32

kernel_name = 'hybrid_chunkattn_mlstm_stream_step'


def rmsnorm(x, g):
    xf = x.astype(F32)
    y = xf * lax.rsqrt(jnp.mean(xf * xf, axis=-1, keepdims=True) + EPS)
    return (y * g.astype(F32)).astype(x.dtype)


def sq_relu_mlp(h, w_up, w_down):
    a = jax.nn.relu(h @ w_up)
    return (a * a) @ w_down


def attn_qkv(h, w_in, qg, kg):
    B, T, _ = h.shape
    q, k, v = jnp.split(h @ w_in, 3, axis=-1)
    q = rmsnorm(q.reshape(B, T, H_A, HD_A), qg)
    k = rmsnorm(k.reshape(B, T, H_A, HD_A), kg)
    return q, k, v.reshape(B, T, H_A, HD_A)


def band_attn(q, k, v, q_pos, k_pos, k_ok, rel_bias):
    s = jnp.einsum('bqhd,bkhd->bhqk', q, k).astype(F32) * (HD_A ** -0.5)
    rel = jnp.clip(q_pos[:, None] - k_pos[None, :], -REL_CLIP, REL_CLIP) + REL_CLIP
    s = s + rel_bias.astype(F32)[:, rel][None]
    s = jnp.where(k_ok[None, None, None, :], s, NEG)
    p = jax.nn.softmax(s, axis=-1).astype(v.dtype)
    return jnp.einsum('bhqk,bkhd->bqhd', p, v)


def attn_prompt(h, w_in, w_out, qg, kg, rel_bias):
    B, S, _ = h.shape
    q, k, v = attn_qkv(h, w_in, qg, kg)
    pad = ((0, 0), (WINDOW_A, 0), (0, 0), (0, 0))
    kp, vp = jnp.pad(k, pad), jnp.pad(v, pad)
    band = CHUNK + WINDOW_A

    def one_chunk(c):
        start = c * CHUNK
        qc = lax.dynamic_slice_in_dim(q, start, CHUNK, axis=1)
        kc = lax.dynamic_slice_in_dim(kp, start, band, axis=1)
        vc = lax.dynamic_slice_in_dim(vp, start, band, axis=1)
        q_pos = start + jnp.arange(CHUNK)
        k_pos = start - WINDOW_A + jnp.arange(band)
        return band_attn(qc, kc, vc, q_pos, k_pos, k_pos >= 0, rel_bias)

    o = lax.map(one_chunk, jnp.arange(S // CHUNK))
    o = jnp.moveaxis(o, 0, 1).reshape(B, S, D_MODEL)
    keep = min(WINDOW_A, S)
    return o @ w_out, k[:, S - keep:], v[:, S - keep:]


def attn_sample(h, ck, cv, w_in, w_out, qg, kg, rel_bias):
    B, T, _ = h.shape
    q, k, v = attn_qkv(h, w_in, qg, kg)
    Lc = ck.shape[1]
    kc = jnp.concatenate([ck.astype(k.dtype), k], axis=1)
    vc = jnp.concatenate([cv.astype(v.dtype), v], axis=1)
    q_pos = Lc + jnp.arange(T)
    k_pos = jnp.arange(Lc + T)
    o = band_attn(q, kc, vc, q_pos, k_pos, jnp.ones((Lc + T,), bool), rel_bias)
    return o.reshape(B, T, D_MODEL) @ w_out, k, v


def mlstm_chunk(carry, xs):
    C0, n0, m0 = carry
    q, k, v, ig, lf = xs
    L = q.shape[2]
    b = jnp.cumsum(lf, axis=-1)
    causal = jnp.tril(jnp.ones((L, L), bool))
    Dm = jnp.where(causal, b[..., :, None] - b[..., None, :] + ig[..., None, :], -jnp.inf)
    g = b + m0[..., None]
    m = jnp.maximum(g, jnp.max(Dm, axis=-1))
    S = jnp.einsum('bhtd,bhsd->bhts', q, k) * jnp.exp(Dm - m[..., None])
    inter = jnp.exp(g - m)
    num = jnp.einsum('bhts,bhse->bhte', S, v) + inter[..., None] * jnp.einsum('bhed,bhtd->bhte', C0, q)
    den = jnp.sum(S, axis=-1) + inter * jnp.einsum('bhd,bhtd->bht', n0, q)
    h = num / jnp.maximum(jnp.abs(den), jnp.exp(-m))[..., None]
    mL = m[..., -1]
    wS = jnp.exp(b[..., -1:] - b + ig - mL[..., None])
    decay = jnp.exp(b[..., -1] + m0 - mL)
    C = decay[..., None, None] * C0 + jnp.einsum('bhs,bhse,bhsd->bhed', wS, v, k)
    n = decay[..., None] * n0 + jnp.einsum('bhs,bhsd->bhd', wS, k)
    return (C, n, mL), h


def mlstm_mix(h, conv_buf, C0, n0, m0, w_in, b_i, b_f, cw, cb, hn, w_out):
    B, T, _ = h.shape
    z = h @ w_in
    qk_pre = z[..., :2 * D_IN]
    v = z[..., 2 * D_IN:3 * D_IN]
    o = z[..., 3 * D_IN:4 * D_IN]
    gi = z[..., 4 * D_IN:4 * D_IN + H_B]
    gf = z[..., 4 * D_IN + H_B:]
    xpad = jnp.concatenate([conv_buf.astype(qk_pre.dtype), qk_pre], axis=1)
    new_buf = xpad[:, T:]
    acc = cb
    for j in range(CONV_W):
        acc = acc + cw[j] * xpad[:, j:j + T]
    qk = jax.nn.silu(acc)

    def heads(a):
        return a.reshape(B, T, H_B, HD_B).transpose(0, 2, 1, 3).astype(F32)

    q = heads(qk[..., :D_IN])
    k = heads(qk[..., D_IN:]) * (HD_B ** -0.5)
    vv = heads(v)
    ig = (gi + b_i).astype(F32).transpose(0, 2, 1)
    lf = jax.nn.log_sigmoid((gf + b_f).astype(F32)).transpose(0, 2, 1)
    L = min(CHUNK, T)
    nc = T // L

    def blocks(a):
        return jnp.moveaxis(a.reshape((B, H_B, nc, L) + a.shape[3:]), 2, 0)

    (C, n, m), hs = lax.scan(mlstm_chunk, (C0.astype(F32), n0.astype(F32), m0.astype(F32)),
                             (blocks(q), blocks(k), blocks(vv), blocks(ig), blocks(lf)))
    hs = jnp.moveaxis(hs, 0, 2).reshape(B, H_B, T, HD_B).transpose(0, 2, 1, 3)
    hs = rmsnorm(hs, hn.reshape(H_B, HD_B)).astype(h.dtype)
    y = (hs * jax.nn.sigmoid(o).reshape(B, T, H_B, HD_B)).reshape(B, T, D_IN) @ w_out
    return y, C, n, m, new_buf


def setup_inputs(seed: int = 0) -> dict:
    key = jax.random.key(seed)
    ks = jax.random.split(key, 24)
    nrm = jax.random.normal
    a_len = min(WINDOW_A, PAST_LEN)
    d_in_b = 4 * D_IN + 2 * H_B
    return {
        'x_prompt': nrm(ks[0], (BATCH, SEQ, D_MODEL), F32),
        'x_sample': nrm(ks[1], (DEC_BATCH, DEC_SEQ, D_MODEL), F32),
        'cache_k': nrm(ks[2], (N_A, DEC_BATCH, a_len, H_A, HD_A), F32),
        'cache_v': nrm(ks[3], (N_A, DEC_BATCH, a_len, H_A, HD_A), F32),
        'state_C': nrm(ks[4], (N_B, DEC_BATCH, H_B, HD_B, HD_B), F32),
        'state_n': nrm(ks[5], (N_B, DEC_BATCH, H_B, HD_B), F32),
        'state_m': nrm(ks[6], (N_B, DEC_BATCH, H_B), F32),
        'state_conv': nrm(ks[7], (N_B, DEC_BATCH, CONV_W - 1, 2 * D_IN), F32),
        'norm_mix': 1.0 + 0.05 * nrm(ks[8], (DEPTH, D_MODEL), F32),
        'norm_ffn': 1.0 + 0.05 * nrm(ks[9], (DEPTH, D_MODEL), F32),
        'w_in_a': nrm(ks[10], (N_A, D_MODEL, 3 * D_MODEL), F32) * D_MODEL ** -0.5,
        'w_out_a': nrm(ks[11], (N_A, D_MODEL, D_MODEL), F32) * (0.5 * D_MODEL ** -0.5),
        'q_norm': 1.0 + 0.05 * nrm(ks[12], (N_A, HD_A), F32),
        'k_norm': 1.0 + 0.05 * nrm(ks[13], (N_A, HD_A), F32),
        'rel_bias': 0.2 * nrm(ks[14], (N_A, H_A, N_REL), F32),
        'w_in_b': nrm(ks[15], (N_B, D_MODEL, d_in_b), F32) * D_MODEL ** -0.5,
        'b_gate_i': 0.1 * nrm(ks[16], (N_B, H_B), F32),
        'b_gate_f': 3.0 + 0.5 * nrm(ks[17], (N_B, H_B), F32),
        'conv_w': 0.5 * nrm(ks[18], (N_B, CONV_W, 2 * D_IN), F32),
        'conv_b': 0.02 * nrm(ks[19], (N_B, 2 * D_IN), F32),
        'head_norm': 1.0 + 0.05 * nrm(ks[20], (N_B, D_IN), F32),
        'w_out_b': nrm(ks[21], (N_B, D_IN, D_MODEL), F32) * (0.5 * D_IN ** -0.5),
        'w_up': nrm(ks[22], (DEPTH, D_MODEL, D_FF), F32) * D_MODEL ** -0.5,
        'w_down': nrm(ks[23], (DEPTH, D_FF, D_MODEL), F32) * (0.5 * D_FF ** -0.5),
    }


def reference(x_prompt, x_sample, cache_k, cache_v, state_C, state_n, state_m, state_conv,
              norm_mix, norm_ffn, w_in_a, w_out_a, q_norm, k_norm, rel_bias,
              w_in_b, b_gate_i, b_gate_f, conv_w, conv_b, head_norm, w_out_b, w_up, w_down):
    xp, xs = x_prompt, x_sample
    Bp = xp.shape[0]
    kp_l, vp_l, ks_l, vs_l = [], [], [], []
    Cp_l, np_l, mp_l, bp_l = [], [], [], []
    Cs_l, ns_l, ms_l, bs_l = [], [], [], []
    for i in range(DEPTH):
        hp = rmsnorm(xp, norm_mix[i])
        hs = rmsnorm(xs, norm_mix[i])
        j = i // 2
        if i % 2 == 0:
            dp, k_p, v_p = attn_prompt(hp, w_in_a[j], w_out_a[j], q_norm[j], k_norm[j], rel_bias[j])
            ds, k_s, v_s = attn_sample(hs, cache_k[j], cache_v[j], w_in_a[j], w_out_a[j],
                                       q_norm[j], k_norm[j], rel_bias[j])
            kp_l.append(k_p); vp_l.append(v_p); ks_l.append(k_s); vs_l.append(v_s)
        else:
            prm = (w_in_b[j], b_gate_i[j], b_gate_f[j], conv_w[j], conv_b[j], head_norm[j], w_out_b[j])
            dp, C_p, n_p, m_p, b_p = mlstm_mix(
                hp, jnp.zeros((Bp, CONV_W - 1, 2 * D_IN), hp.dtype),
                jnp.zeros((Bp, H_B, HD_B, HD_B), F32), jnp.zeros((Bp, H_B, HD_B), F32),
                jnp.zeros((Bp, H_B), F32), *prm)
            ds, C_s, n_s, m_s, b_s = mlstm_mix(hs, state_conv[j], state_C[j], state_n[j], state_m[j], *prm)
            Cp_l.append(C_p); np_l.append(n_p); mp_l.append(m_p); bp_l.append(b_p)
            Cs_l.append(C_s); ns_l.append(n_s); ms_l.append(m_s); bs_l.append(b_s)
        xp = xp + dp
        xs = xs + ds
        xp = xp + sq_relu_mlp(rmsnorm(xp, norm_ffn[i]), w_up[i], w_down[i])
        xs = xs + sq_relu_mlp(rmsnorm(xs, norm_ffn[i]), w_up[i], w_down[i])
    return (xp, xs,
            jnp.stack(kp_l), jnp.stack(vp_l), jnp.stack(ks_l), jnp.stack(vs_l),
            jnp.stack(Cp_l), jnp.stack(np_l), jnp.stack(mp_l), jnp.stack(bp_l),
            jnp.stack(Cs_l), jnp.stack(ns_l), jnp.stack(ms_l), jnp.stack(bs_l))
```

```cpp
#include <hip/hip_runtime.h>
#include <cstdio>
#include <cstdint>
namespace pg8 {
#define PG8_LAS __attribute__((address_space(3)))
typedef unsigned short bf16_t;
typedef short bf16x8 __attribute__((ext_vector_type(8)));
typedef float f32x4 __attribute__((ext_vector_type(4)));
typedef unsigned u32x4 __attribute__((ext_vector_type(4)));
constexpr int BM = 256, BK = 64, HALF = 128, HTB = HALF * BK * 2  , STAGE_BYTES = 8 * HTB, NXCD = 8, WGM = 8;

__host__ __device__ __forceinline__ int lds_byte(int r, int c) { const int st = (r >> 4) * 2 + (c >> 5), rr = r & 15, cc = c & 31, ob = rr * 64 + cc * 2; return st * 1024 + (ob ^ (((ob >> 9) & 1) << 5)); }
__host__ __device__ __forceinline__ void stage_rc(int b, int& R, int& C) { const int st = b / 1024, sb = b % 1024, swz = sb ^ (((sb >> 9) & 1) << 5); R = (st >> 1) * 16 + swz / 64; C = (st & 1) * 32 + (swz % 64) / 2; }
__host__ __device__ __forceinline__ int perm32(int rho) { const int n = rho >> 4, i = rho & 15; return 8 * (i >> 2) + 4 * n + (i & 3); }

struct Unit { int pm, pn; };
struct Gemm { const bf16_t* A; const bf16_t* Bt; int M, N, K; };

struct StaticOrder {
    int nM, nN, nwg, G, c;
    __host__ __device__ void init(int M, int N, int G_, int c_) { nM = M / BM; nN = N / BM; nwg = nM * nN; G = G_; c = c_; }
    __host__ __device__ bool next(int i, Unit& u) const {
        const long L = (long)i * G + c; if (L >= nwg) return false;
        int wgid = (int)L; { const int q = nwg / NXCD, r = nwg % NXCD, xcd = wgid % NXCD, off = wgid / NXCD; wgid = (xcd < r ? xcd * (q + 1) : r * (q + 1) + (xcd - r) * q) + off; }
        const int nig = WGM * nN, gid = wgid / nig, fm = gid * WGM, gsz = (nM - fm) < WGM ? (nM - fm) : WGM;
        u.pm = fm + ((wgid % nig) % gsz); u.pn = (wgid % nig) / gsz; return true;
    }
    __device__ __forceinline__ void a_ready(const Unit&) const {}
    __device__ __forceinline__ void done(const Unit&) const {}
};

__device__ __forceinline__ unsigned cvt_pk_bf16(float lo, float hi) { unsigned r; asm volatile("v_cvt_pk_bf16_f32 %0, %1, %2" : "=v"(r) : "v"(lo), "v"(hi)); return r; }
constexpr int MP_ROWS = 16384, MS_ROWS = 1024, M_ROWS = 17408, DM = 1024;
constexpr float NEPS = 1e-6f;
__device__ __forceinline__ float row_rs(const float* ssq, int row) {
    const f32x4* p = (const f32x4*)(ssq + (size_t)row * 16);
    const f32x4 a = p[0], b = p[1], c = p[2], d = p[3];
    const float s = ((a[0] + a[1]) + (a[2] + a[3])) + ((b[0] + b[1]) + (b[2] + b[3])) + ((c[0] + c[1]) + (c[2] + c[3])) + ((d[0] + d[1]) + (d[2] + d[3]));
    return 1.0f / sqrtf(s * (1.0f / 1024.0f) + NEPS);
}
__device__ __forceinline__ u32x4 pack8(const f32x4 v0, const f32x4 v1) { u32x4 w; w.x = cvt_pk_bf16(v0[0], v0[1]); w.y = cvt_pk_bf16(v0[2], v0[3]); w.z = cvt_pk_bf16(v1[0], v1[1]); w.w = cvt_pk_bf16(v1[2], v1[3]); return w; }

struct Args { const float* in[24]; float* out; unsigned char* ws; };
typedef const __attribute__((address_space(4))) Args* KArgs;
__device__ __forceinline__ KArgs KA() { KArgs p = (KArgs)__builtin_amdgcn_kernarg_segment_ptr(); asm volatile("" : "+s"(p)); return p; }
constexpr size_t kMiB = 1u << 20;
constexpr size_t kWS_XB = 103 * kMiB, kWS_SSQ = 137 * kMiB, kWS_GATES = 139 * kMiB, kWS_A = 141 * kMiB;
constexpr size_t kA_Q = 0, kA_KP = 34 * kMiB, kA_VP = 66 * kMiB, kA_RK = 132 * kMiB, kA_RV = 150 * kMiB, kA_HID = 0, kA_QKP = 0, kA_V = 68 * kMiB, kA_OG = 102 * kMiB;
constexpr size_t kO_KP = 17825792, kO_VP = 18874368, kO_KS = 19922944, kO_VS = 22020096, kO_BP = 24643592, kO_BS = 33077384;

struct EpiRes {
    static constexpr bool PERM = true, AFTER_DRAIN = false;
    int first;
    __device__ __forceinline__ void operator()(const f32x4 (&acc)[2][2][4][2], const Unit& u, int wr, int wc, int fr, int fq) const {
        KArgs ka = KA(); float* out = ka->out; unsigned char* ws = ka->ws; bf16_t* xb = (bf16_t*)(ws + kWS_XB); float* ssq = (float*)(ws + kWS_SSQ);
        const float* base_p = first ? ka->in[0] : (const float*)out; const float* base_s = first ? ka->in[1] : (const float*)(out + (size_t)MP_ROWS * DM);
        const int row0 = u.pm * BM + wr * 64 + fr, col0 = u.pn * BM + wc * 32 + 8 * fq;
#pragma unroll
        for (int ai = 0; ai < 2; ++ai)
#pragma unroll
            for (int m = 0; m < 4; ++m) {
                const int row = row0 + ai * HALF + m * 16;
                const float* bp = (row < MP_ROWS) ? base_p + (size_t)row * DM : base_s + (size_t)(row - MP_ROWS) * DM;
                const size_t off = (size_t)row * DM + col0;
                float ss = 0.f;
#pragma unroll
                for (int bj = 0; bj < 2; ++bj) {
                    const f32x4 b0 = *(const f32x4*)(bp + col0 + bj * HALF), b1 = *(const f32x4*)(bp + col0 + bj * HALF + 4);
                    const f32x4 v0 = acc[ai][bj][m][0] + b0, v1 = acc[ai][bj][m][1] + b1;
                    *(f32x4*)(out + off + bj * HALF) = v0; *(f32x4*)(out + off + bj * HALF + 4) = v1;
                    *(u32x4*)(xb + off + bj * HALF) = pack8(v0, v1);
                    ss += (v0[0] * v0[0] + v0[1] * v0[1]) + (v0[2] * v0[2] + v0[3] * v0[3]) + (v1[0] * v1[0] + v1[1] * v1[1]) + (v1[2] * v1[2] + v1[3] * v1[3]);
                }
                ss += __shfl_xor(ss, 16); ss += __shfl_xor(ss, 32);
                if (fq == 0) ssq[(size_t)row * 16 + u.pn * 4 + wc] = ss;
                if (m & 1) asm volatile("" ::: "memory");
            }
    }
};

struct EpiUp {
    static constexpr bool PERM = true, AFTER_DRAIN = false;
    int dummy;
    __device__ __forceinline__ void operator()(const f32x4 (&acc)[2][2][4][2], const Unit& u, int wr, int wc, int fr, int fq) const {
        KArgs ka = KA(); unsigned char* ws = ka->ws; const float* ssq = (const float*)(ws + kWS_SSQ); bf16_t* hid = (bf16_t*)(ws + kWS_A + kA_HID);
        const int row0 = u.pm * BM + wr * 64 + fr, col0 = u.pn * BM + wc * 32 + 8 * fq;
#pragma unroll
        for (int ai = 0; ai < 2; ++ai)
#pragma unroll
            for (int m = 0; m < 4; ++m) {
                const int row = row0 + ai * HALF + m * 16;
                const float rs = row_rs(ssq, row);
#pragma unroll
                for (int bj = 0; bj < 2; ++bj) {
                    f32x4 v0 = acc[ai][bj][m][0] * rs, v1 = acc[ai][bj][m][1] * rs;
#pragma unroll
                    for (int i = 0; i < 4; ++i) { const float a = fmaxf(v0[i], 0.f), b = fmaxf(v1[i], 0.f); v0[i] = a * a; v1[i] = b * b; }
                    *(u32x4*)(hid + (size_t)row * 4096 + col0 + bj * HALF) = pack8(v0, v1);
                }
            }
    }
};

struct EpiQKV {
    static constexpr bool PERM = true, AFTER_DRAIN = false;
    int j;
    __device__ __forceinline__ void operator()(const f32x4 (&acc)[2][2][4][2], const Unit& u, int wr, int wc, int fr, int fq) const {
        KArgs ka = KA(); unsigned char* ws = ka->ws; float* out = ka->out; const float* ssq = (const float*)(ws + kWS_SSQ); const float* qg = ka->in[12] + j * 64; const float* kg = ka->in[13] + j * 64;
        unsigned char* A = ws + kWS_A; bf16_t *Q = (bf16_t*)(A + kA_Q), *KP = (bf16_t*)(A + kA_KP), *VP = (bf16_t*)(A + kA_VP), *RK = (bf16_t*)(A + kA_RK), *RV = (bf16_t*)(A + kA_RV);
        float *okp = out + kO_KP + (size_t)j * 512 * DM, *ovp = out + kO_VP + (size_t)j * 512 * DM, *oks = out + kO_KS + (size_t)j * MS_ROWS * DM, *ovs = out + kO_VS + (size_t)j * MS_ROWS * DM;
        const int t = u.pn >> 2, head = (u.pn & 3) * 4 + wc;
        const int row0 = u.pm * BM + wr * 64 + fr;
        f32x4 g[2][2];
        const float* gp = (t == 0) ? qg : kg;
#pragma unroll
        for (int bj = 0; bj < 2; ++bj)
#pragma unroll
            for (int n = 0; n < 2; ++n) { g[bj][n] = (t < 2) ? *(const f32x4*)(gp + 32 * bj + 8 * fq + 4 * n) : (f32x4){1.f, 1.f, 1.f, 1.f}; if (t == 0) g[bj][n] = g[bj][n] * (0.125f * 1.4426950408889634f); }
#pragma unroll
        for (int ai = 0; ai < 2; ++ai)
#pragma unroll
            for (int m = 0; m < 4; ++m) {
                const int row = row0 + ai * HALF + m * 16;
                const float rs = row_rs(ssq, row);
                f32x4 v[2][2]; float ss = 0.f;
#pragma unroll
                for (int bj = 0; bj < 2; ++bj)
#pragma unroll
                    for (int n = 0; n < 2; ++n) { v[bj][n] = acc[ai][bj][m][n] * rs; const f32x4 x = v[bj][n]; ss += (x[0] * x[0] + x[1] * x[1]) + (x[2] * x[2] + x[3] * x[3]); }
                if (t < 2) {
                    ss += __shfl_xor(ss, 16); ss += __shfl_xor(ss, 32);
                    const float rr = 1.0f / sqrtf(ss * (1.0f / 64.0f) + NEPS);
#pragma unroll
                    for (int bj = 0; bj < 2; ++bj)
#pragma unroll
                        for (int n = 0; n < 2; ++n) v[bj][n] = v[bj][n] * rr * g[bj][n];
                }
#pragma unroll
                for (int bj = 0; bj < 2; ++bj) {
                    const int col = head * 64 + 32 * bj + 8 * fq;
                    const u32x4 w = pack8(v[bj][0], v[bj][1]);
                    if (t == 0) { *(u32x4*)(Q + (size_t)row * DM + col) = w; }
                    else {
                        bf16_t* dstb; float* dstf = nullptr;
                        if (row < MP_ROWS) {
                            dstb = (t == 1 ? KP : VP) + (size_t)row * DM + col;
                            if (row >= MP_ROWS - 512) dstf = (t == 1 ? okp : ovp) + (size_t)(row - (MP_ROWS - 512)) * DM + col;
                        } else {
                            const int sr = row - MP_ROWS, b = sr >> 6, tt = sr & 63;
                            dstb = (t == 1 ? RK : RV) + ((size_t)b * 576 + 512 + tt) * DM + col;
                            dstf = (t == 1 ? oks : ovs) + (size_t)sr * DM + col;
                        }
                        *(u32x4*)dstb = w;
                        if (dstf) { *(f32x4*)dstf = v[bj][0]; *(f32x4*)(dstf + 4) = v[bj][1]; }
                    }
                }
            }
    }
};

struct EpiMIn {
    static constexpr bool PERM = true, AFTER_DRAIN = false;
    int j;
    __device__ __forceinline__ void operator()(const f32x4 (&acc)[2][2][4][2], const Unit& u, int wr, int wc, int fr, int fq) const {
        KArgs ka = KA(); unsigned char* ws = ka->ws; float* out = ka->out; const float* ssq = (const float*)(ws + kWS_SSQ); const float* b_i = ka->in[16] + j * 4; const float* b_f = ka->in[17] + j * 4;
        unsigned char* A = ws + kWS_A; bf16_t *QKP = (bf16_t*)(A + kA_QKP), *V = (bf16_t*)(A + kA_V), *OG = (bf16_t*)(A + kA_OG); float* gates = (float*)(ws + kWS_GATES);
        float *ocp = out + kO_BP + (size_t)j * 3 * 2048, *ocs = out + kO_BS + (size_t)j * 16 * 3 * 2048;
        const int row0 = u.pm * BM + wr * 64 + fr, pn = u.pn, cl0 = wc * 32 + 8 * fq;
        if (pn == 16 && !(wc == 0 && fq == 0)) return;
#pragma unroll
        for (int ai = 0; ai < 2; ++ai)
#pragma unroll
            for (int m = 0; m < 4; ++m) {
                const int row = row0 + ai * HALF + m * 16;
                const float rs = row_rs(ssq, row);
                if (pn == 16) {
                    const f32x4 gi = acc[ai][0][m][0] * rs + *(const f32x4*)b_i, gf = acc[ai][0][m][1] * rs + *(const f32x4*)b_f;
                    f32x4 lf;
#pragma unroll
                    for (int i = 0; i < 4; ++i) lf[i] = fminf(gf[i], 0.f) - log1pf(expf(-fabsf(gf[i])));
                    *(f32x4*)(gates + (size_t)row * 8) = gi; *(f32x4*)(gates + (size_t)row * 8 + 4) = lf;
                    continue;
                }
#pragma unroll
                for (int bj = 0; bj < 2; ++bj) {
                    f32x4 v0 = acc[ai][bj][m][0] * rs, v1 = acc[ai][bj][m][1] * rs;
                    const int cl = cl0 + bj * HALF;
                    if (pn < 8) {
                        const int col = pn * BM + cl;
                        *(u32x4*)(QKP + (size_t)row * 2048 + col) = pack8(v0, v1);
                        float* dstf = nullptr;
                        if (row < MP_ROWS) { if (row >= MP_ROWS - 3) dstf = ocp + (size_t)(row - (MP_ROWS - 3)) * 2048 + col; }
                        else { const int sr = row - MP_ROWS, b = sr >> 6, tt = sr & 63; if (tt >= 61) dstf = ocs + ((size_t)b * 3 + (tt - 61)) * 2048 + col; }
                        if (dstf) { *(f32x4*)dstf = v0; *(f32x4*)(dstf + 4) = v1; }
                    } else if (pn < 12) {
                        *(u32x4*)(V + (size_t)row * DM + (pn - 8) * BM + cl) = pack8(v0, v1);
                    } else {
#pragma unroll
                        for (int i = 0; i < 4; ++i) { v0[i] = 1.0f / (1.0f + __expf(-v0[i])); v1[i] = 1.0f / (1.0f + __expf(-v1[i])); }
                        *(u32x4*)(OG + (size_t)row * DM + (pn - 12) * BM + cl) = pack8(v0, v1);
                    }
                }
            }
    }
};
template <class Epi, class Sched, bool ALIGN_EPI = false, bool SP2 = false>
__device__ __forceinline__ void gemm_phase(PG8_LAS unsigned char* lds, const Gemm g, const Sched& S, const Epi& E) {
    int tid_ = threadIdx.x; asm volatile("" : "+v"(tid_));
    const int tid = tid_, wid = __builtin_amdgcn_readfirstlane(tid >> 6), lane = tid & 63, wr = wid >> 2, wc = wid & 3, fr = lane & 15, fq = lane >> 4;
    const int K = g.K, nt = K / BK;
    unsigned voffA[2], voffB[2];
#pragma unroll
    for (int i = 0; i < 2; ++i) { int R, C; stage_rc(tid * 16 + i * 8192, R, C); const int Rb = Epi::PERM ? ((R & ~31) + perm32(R & 31)) : R;
        voffA[i] = (unsigned)(R * K + C) * 2u; voffB[i] = (unsigned)(Rb * K + C) * 2u; }
    const size_t kstep = (size_t)(BK * 2);
    const size_t hstep = (size_t)HALF * K * 2;
    const size_t tstep = 2 * hstep;
    const unsigned ldsw = (unsigned)wid * 1024u;
    const int aoff = lds_byte(wr * 64 + fr, fq * 8), boff = lds_byte(wc * 32 + fr, fq * 8);
#define PG8_SA(b, h) (((b) * 2 + (h)) * HTB)
#define PG8_SB(b, h) ((4 + (b) * 2 + (h)) * HTB)
#define PG8_STAGE(bufoff, gbase, voff) do { _Pragma("unroll") for (int _i = 0; _i < 2; ++_i) \
        __builtin_amdgcn_global_load_lds((const unsigned*)((const char*)(gbase) + (voff)[_i]), (PG8_LAS unsigned*)(lds + (bufoff) + ldsw + _i * 8192), 16, 0, 0); } while (0)
#define PG8_LDA(dst, b, h) do { _Pragma("unroll") for (int m = 0; m < 4; ++m) _Pragma("unroll") for (int k = 0; k < 2; ++k) dst[m][k] = *(const PG8_LAS bf16x8*)(lds + PG8_SA(b, h) + aoff + m * 2048 + k * 1024); } while (0)
#define PG8_LDB(dst, b, h) do { _Pragma("unroll") for (int n = 0; n < 2; ++n) _Pragma("unroll") for (int k = 0; k < 2; ++k) dst[n][k] = *(const PG8_LAS bf16x8*)(lds + PG8_SB(b, h) + boff + n * 2048 + k * 1024); } while (0)
#define PG8_MMA(ai, bj, At, Bt) do { __builtin_amdgcn_s_setprio(1); _Pragma("unroll") for (int m = 0; m < 4; ++m) _Pragma("unroll") for (int n = 0; n < 2; ++n) _Pragma("unroll") for (int k = 0; k < 2; ++k) \
        acc[ai][bj][m][n] = __builtin_amdgcn_mfma_f32_16x16x32_bf16(Bt[n][k], At[m][k], acc[ai][bj][m][n], 0, 0, 0); __builtin_amdgcn_s_setprio(0); } while (0)
#define PG8_WAIT_V(n) asm volatile("s_waitcnt vmcnt(" #n ")" ::: "memory")
#define PG8_WAIT_L(n) asm volatile("s_waitcnt lgkmcnt(" #n ")" ::: "memory")
#define PG8_BAR __builtin_amdgcn_s_barrier()
#define PG8_SCHED __builtin_amdgcn_sched_barrier(0)
    Unit cur, nxt; int ui = 0;
    if (!S.next(0, cur)) return;
    f32x4 acc[2][2][4][2];
#pragma unroll
    for (int a = 0; a < 2; ++a)
#pragma unroll
        for (int b = 0; b < 2; ++b)
#pragma unroll
            for (int m = 0; m < 4; ++m)
#pragma unroll
                for (int n = 0; n < 2; ++n) acc[a][b][m][n] = (f32x4){0.f, 0.f, 0.f, 0.f};
    bf16x8 At[4][2], B0[2][2], B1[2][2];
    const char* cA = (const char*)g.A + (size_t)cur.pm * tstep; const char* cB = (const char*)g.Bt + (size_t)cur.pn * tstep;
    S.a_ready(cur);
    if constexpr (SP2) {
        PG8_STAGE(PG8_SB(0, 0), cB, voffB); PG8_STAGE(PG8_SB(0, 1), cB + hstep, voffB); PG8_STAGE(PG8_SA(0, 0), cA, voffA); PG8_STAGE(PG8_SA(0, 1), cA + hstep, voffA);
        if (wr == 1) PG8_BAR;
        PG8_WAIT_V(2); PG8_BAR;
        PG8_STAGE(PG8_SB(1, 0), cB + kstep, voffB); PG8_STAGE(PG8_SA(1, 0), cA + kstep, voffA); PG8_STAGE(PG8_SB(1, 1), cB + hstep + kstep, voffB);
        PG8_WAIT_V(6); PG8_BAR;
    } else {
        PG8_STAGE(PG8_SB(0, 0), cB, voffB); PG8_STAGE(PG8_SA(0, 0), cA, voffA); PG8_STAGE(PG8_SB(0, 1), cB + hstep, voffB); PG8_STAGE(PG8_SA(0, 1), cA + hstep, voffA);
        if (wr == 1) PG8_BAR;
        PG8_WAIT_V(4); PG8_BAR;
        PG8_STAGE(PG8_SB(1, 0), cB + kstep, voffB); PG8_STAGE(PG8_SA(1, 0), cA + kstep, voffA); PG8_STAGE(PG8_SB(1, 1), cB + hstep + kstep, voffB);
        PG8_WAIT_V(6); PG8_BAR;
    }
    for (;;) {
        const bool has_next = S.next(ui + 1, nxt);
        const char* nA = has_next ? (const char*)g.A + (size_t)nxt.pm * tstep : cA; const char* nB = has_next ? (const char*)g.Bt + (size_t)nxt.pn * tstep : cB;
        for (int t = 0; t < nt; t += 2) {
            const bool last = (t == nt - 2);
            const char* a1 = cA + (size_t)(t + 1) * kstep;
            const char* a2 = last ? nA : cA + (size_t)(t + 2) * kstep; const char* b2 = last ? nB : cB + (size_t)(t + 2) * kstep;
            const char* a3 = a2 + kstep; const char* b3 = b2 + kstep;
            if (last && has_next) S.a_ready(nxt);
            if constexpr (SP2) {
            PG8_LDB(B0, 0, 0); PG8_LDB(B1, 0, 1); PG8_SCHED; PG8_LDA(At, 0, 0); PG8_STAGE(PG8_SA(1, 1), a1 + hstep, voffA);
            PG8_WAIT_V(8); PG8_WAIT_L(0); PG8_BAR; PG8_MMA(0, 0, At, B0); PG8_MMA(0, 1, At, B1); PG8_BAR; PG8_SCHED;
            PG8_LDA(At, 0, 1); PG8_STAGE(PG8_SB(0, 0), b2, voffB); PG8_STAGE(PG8_SB(0, 1), b2 + hstep, voffB); PG8_STAGE(PG8_SA(0, 0), a2, voffA);
            PG8_WAIT_V(8); PG8_WAIT_L(0); PG8_BAR; PG8_MMA(1, 0, At, B0); PG8_MMA(1, 1, At, B1); PG8_BAR; PG8_SCHED;
            PG8_LDB(B0, 1, 0); PG8_LDB(B1, 1, 1); PG8_SCHED; PG8_LDA(At, 1, 0); PG8_STAGE(PG8_SA(0, 1), a2 + hstep, voffA);
            PG8_WAIT_V(8); PG8_WAIT_L(0); PG8_BAR; PG8_MMA(0, 0, At, B0); PG8_MMA(0, 1, At, B1); PG8_BAR; PG8_SCHED;
            PG8_LDA(At, 1, 1); PG8_STAGE(PG8_SB(1, 0), b3, voffB); PG8_STAGE(PG8_SB(1, 1), b3 + hstep, voffB); PG8_STAGE(PG8_SA(1, 0), a3, voffA);
            PG8_WAIT_V(8); PG8_WAIT_L(0); PG8_BAR; PG8_MMA(1, 0, At, B0); PG8_MMA(1, 1, At, B1); PG8_BAR; PG8_SCHED;
            } else {
            PG8_LDB(B0, 0, 0); PG8_SCHED; PG8_LDA(At, 0, 0); PG8_STAGE(PG8_SA(1, 1), a1 + hstep, voffA);
            PG8_WAIT_L(8); PG8_BAR; PG8_WAIT_L(0); PG8_MMA(0, 0, At, B0); PG8_BAR; PG8_SCHED;
            PG8_LDB(B1, 0, 1); PG8_STAGE(PG8_SB(0, 0), b2, voffB);
            PG8_BAR; PG8_WAIT_L(0); PG8_MMA(0, 1, At, B1); PG8_BAR;
            PG8_LDA(At, 0, 1); PG8_STAGE(PG8_SA(0, 0), a2, voffA);
            PG8_BAR; PG8_WAIT_L(0); PG8_MMA(1, 0, At, B0); PG8_BAR; PG8_SCHED;
            PG8_STAGE(PG8_SB(0, 1), b2 + hstep, voffB);
            PG8_WAIT_V(6); PG8_BAR; PG8_MMA(1, 1, At, B1); PG8_BAR;
            PG8_LDB(B0, 1, 0); PG8_SCHED; PG8_LDA(At, 1, 0); PG8_STAGE(PG8_SA(0, 1), a2 + hstep, voffA);
            PG8_WAIT_L(8); PG8_BAR; PG8_WAIT_L(0); PG8_MMA(0, 0, At, B0); PG8_BAR; PG8_SCHED;
            PG8_LDB(B1, 1, 1); PG8_STAGE(PG8_SB(1, 0), b3, voffB);
            PG8_BAR; PG8_WAIT_L(0); PG8_MMA(0, 1, At, B1); PG8_BAR;
            PG8_LDA(At, 1, 1); PG8_STAGE(PG8_SA(1, 0), a3, voffA);
            PG8_BAR; PG8_WAIT_L(0); PG8_MMA(1, 0, At, B0); PG8_BAR; PG8_SCHED;
            PG8_STAGE(PG8_SB(1, 1), b3 + hstep, voffB);
            PG8_WAIT_V(6); PG8_BAR; PG8_MMA(1, 1, At, B1); PG8_BAR;
            }
        }
        if constexpr (ALIGN_EPI) { if (wr == 0) PG8_BAR; }
        if constexpr (!Epi::AFTER_DRAIN) { E(acc, cur, wr, wc, fr, fq); S.done(cur); }
        if (!has_next) break;
#pragma unroll
        for (int a = 0; a < 2; ++a)
#pragma unroll
            for (int b = 0; b < 2; ++b)
#pragma unroll
                for (int m = 0; m < 4; ++m)
#pragma unroll
                    for (int n = 0; n < 2; ++n) acc[a][b][m][n] = (f32x4){0.f, 0.f, 0.f, 0.f};
        cur = nxt; cA = nA; cB = nB; ++ui;
        if constexpr (ALIGN_EPI) { if (wr == 1) PG8_BAR; }
    }
    PG8_WAIT_V(0);
    if constexpr (!ALIGN_EPI) { if (wr == 0) PG8_BAR; }
    PG8_BAR;
    if constexpr (Epi::AFTER_DRAIN) { E.fused(acc, cur, wr, wc, fr, fq, lds, wid, lane); S.done(cur); }
#undef PG8_SA
#undef PG8_SB
#undef PG8_STAGE
#undef PG8_LDA
#undef PG8_LDB
#undef PG8_MMA
#undef PG8_WAIT_V
#undef PG8_WAIT_L
#undef PG8_BAR
#undef PG8_SCHED
}
}

constexpr int NWAVES = 8;
constexpr int MP = 16384, MS = 1024, MT = 17408, D = 1024, FF = 4096, NQKV = 3072, NMIN = 4352  , NMIN_REAL = 4104;
constexpr int N_MUNITS = 576;
constexpr size_t SLAB_BYTES = 272 * 256 * 2;
constexpr size_t O_Y = 0, O_KP = 17825792, O_VP = 18874368, O_KS = 19922944, O_VS = 22020096, O_CP = 24117248, O_NP = 24641536, O_MP = 24643584, O_BP = 24643592,
                 O_CS = 24655880, O_NS = 33044488, O_MS = 33077256, O_BS = 33077384, O_END = 33273992;
constexpr size_t MiB = 1u << 20;
constexpr size_t WS_CTL = 0, CTL_ZERO_BYTES = 1 * MiB;
constexpr size_t WS_WINA = 2 * MiB, WS_WOA = 14 * MiB, WS_WINB = 18 * MiB, WS_WOB = 35 * MiB, WS_WUP = 39 * MiB, WS_WDN = 71 * MiB;
constexpr size_t WS_XB = 103 * MiB, WS_SSQ = 137 * MiB, WS_GATES = 139 * MiB, WS_STATS = 140 * MiB, WS_A = 141 * MiB;
constexpr size_t A_Q = 0, A_KP = 34 * MiB, A_VP = 66 * MiB, A_O = 98 * MiB, A_RK = 132 * MiB, A_RV = 150 * MiB;
constexpr size_t A_HID = 0;
constexpr size_t A_QKP = 0, A_V = 68 * MiB, A_OG = 102 * MiB, A_QC = 136 * MiB, A_KC = 170 * MiB, A_SLAB = 204 * MiB;
constexpr size_t WS_END = WS_A + A_SLAB + (size_t)N_MUNITS * SLAB_BYTES;
static_assert(WS_END <= 423 * MiB, "d_ws map");
constexpr int CW_BAR = 4096;
constexpr int RING_OFF = 0, RING_BYTES = 131072, EXTRA_OFF = RING_BYTES, EXTRA_BYTES = 12288, LDSCTL_OFF = EXTRA_OFF + EXTRA_BYTES, MISC_OFF = LDSCTL_OFF + 320;
constexpr int LDS_BYTES = 147456;
static_assert(MISC_OFF + 128 <= LDS_BYTES, "LDS map");

#define GAS __attribute__((address_space(1)))
#define LAS __attribute__((address_space(3)))
typedef unsigned short bf16;
typedef unsigned v4u __attribute__((ext_vector_type(4)));
typedef float f32x4 __attribute__((ext_vector_type(4)));
typedef short bf16x8 __attribute__((ext_vector_type(8)));
typedef GAS unsigned gu32;
typedef GAS unsigned long long gu64;
#define RLX_AGENT __ATOMIC_RELAXED, __HIP_MEMORY_SCOPE_AGENT
#define LDS_WAIT() asm volatile("s_waitcnt lgkmcnt(0)" ::: "memory")
#define VM_WAIT() asm volatile("s_waitcnt vmcnt(0)" ::: "memory")
__device__ __forceinline__ unsigned long long rt() { return __builtin_amdgcn_s_memrealtime(); }
__device__ __forceinline__ unsigned f2bf(float f) { unsigned u = __builtin_bit_cast(unsigned, f); return (u + 0x7fffu + ((u >> 16) & 1u)) >> 16; }
__device__ __forceinline__ unsigned pk2(float lo, float hi) { return f2bf(lo) | (f2bf(hi) << 16); }

#define XB_TMO      128
#define XB_XCNT(j)  (256  + 64 * (j))
#define XB_XSUB(j)  (1280 + 64 * (j))
#define XB_XGEN(j)  (2304 + 64 * (j))
#define XB_TOP      3328
#define XB_TOPGEN   3392
#define XCD_BAR_WORDS 3456
#define XB_SPIN_CAP (1u << 18)

__device__ __forceinline__ unsigned xb_ld(unsigned* p)              { return __hip_atomic_load(p, __ATOMIC_RELAXED, __HIP_MEMORY_SCOPE_AGENT); }
__device__ __forceinline__ unsigned xb_add(unsigned* p, unsigned v) { return __hip_atomic_fetch_add(p, v, __ATOMIC_RELAXED, __HIP_MEMORY_SCOPE_AGENT); }
__device__ __forceinline__ unsigned xb_xcc_id() { return (unsigned)__builtin_amdgcn_s_getreg((3 << 11) | 20) & 0xFu; }
#define XB_SPIN(cond, bar) do { unsigned _sp = 0; while (cond) { __builtin_amdgcn_s_sleep(1); \
    if ((++_sp & 255u) == 0u) { if (xb_ld(&(bar)[XB_TMO])) break; if (_sp > XB_SPIN_CAP) { atomicAdd(&(bar)[XB_TMO], 1u); break; } } } } while (0)

struct XcdBarrier {
    unsigned* bar; unsigned x;
    volatile LAS unsigned* st;
};

__device__ __forceinline__ XcdBarrier xcd_barrier_post(unsigned* bar, volatile LAS unsigned* st) {
    XcdBarrier b; b.bar = bar; b.x = (unsigned)__builtin_amdgcn_readfirstlane((int)xb_xcc_id()); b.st = st;
    if (threadIdx.x == 0) (void)xb_add(&bar[XB_XCNT(b.x)], 1u);
    return b;
}
__device__ __forceinline__ void xcd_barrier_complete(unsigned* bar, unsigned x, unsigned& nloc, unsigned& nx) {
    const unsigned G = gridDim.x * gridDim.y * gridDim.z;
    unsigned sum, cnt, mine, sp = 0u;
    for (;;) {
        sum = 0u; cnt = 0u; mine = 0u;
#pragma unroll
        for (unsigned j = 0; j < 16; ++j) { const unsigned c = xb_ld(&bar[XB_XCNT(j)]); sum += c; cnt += (c > 0u) ? 1u : 0u; mine = (j == x) ? c : mine; }
        if (sum == G) break;
        __builtin_amdgcn_s_sleep(1);
        if ((++sp & 255u) == 0u) { if (xb_ld(&bar[XB_TMO])) break; if (sp > XB_SPIN_CAP) { atomicAdd(&bar[XB_TMO], 1u); break; } }
    }
    nloc = mine > 0u ? mine : 1u; nx = cnt > 0u ? cnt : 1u;
}

__device__ __forceinline__ void xcd_barrier(const XcdBarrier& b) {
    asm volatile("s_waitcnt vmcnt(0)" ::: "memory");
    __syncthreads();
    if (threadIdx.x == 0) {
        unsigned* bar = b.bar;
        __builtin_amdgcn_s_waitcnt(0);
        unsigned nloc = b.st[0], nx = b.st[1];
        if (nloc == 0u) { xcd_barrier_complete(bar, b.x, nloc, nx); b.st[0] = nloc; b.st[1] = nx; }
        const unsigned old = xb_add(&bar[XB_XSUB(b.x)], 1u);
        const unsigned gen = old / nloc;
        if (old + 1u == (gen + 1u) * nloc) {
            __builtin_amdgcn_fence(__ATOMIC_RELEASE, "agent");
            asm volatile("s_waitcnt vmcnt(0)" ::: "memory");
            const unsigned og = xb_add(&bar[XB_TOP], 1u);
            const unsigned tg = og / nx;
            if (og + 1u == (tg + 1u) * nx) xb_add(&bar[XB_TOPGEN], 1u);
            else XB_SPIN(xb_ld(&bar[XB_TOPGEN]) == tg, bar);
            __builtin_amdgcn_fence(__ATOMIC_ACQUIRE, "agent");
            xb_add(&bar[XB_XGEN(b.x)], 1u);
            asm volatile("s_waitcnt vmcnt(0)" ::: "memory");
        } else {
            XB_SPIN(xb_ld(&bar[XB_XGEN(b.x)]) == gen, bar);
            __builtin_amdgcn_fence(__ATOMIC_ACQUIRE, "agent");
            asm volatile("s_waitcnt vmcnt(0)" ::: "memory");
        }
    }
    __syncthreads();
}
typedef unsigned v2u __attribute__((ext_vector_type(2)));
typedef float f32x16 __attribute__((ext_vector_type(16)));
typedef short s16x4 __attribute__((ext_vector_type(4)));
#define WAIT_ALL_BAR() asm volatile("s_waitcnt vmcnt(0) lgkmcnt(0)\n\ts_barrier" ::: "memory")
__device__ __forceinline__ float bflo(unsigned w) { return __builtin_bit_cast(float, w << 16); }
__device__ __forceinline__ float bfhi(unsigned w) { return __builtin_bit_cast(float, w & 0xffff0000u); }
__device__ __forceinline__ void glds16(const void* gsrc, unsigned lds_dst) { unsigned keep;
    asm volatile("s_mov_b32 %0, m0\n\ts_mov_b32 m0, %2\n\ts_nop 0\n\tglobal_load_lds_dwordx4 %1, off\n\ts_mov_b32 m0, %0" : "=&s"(keep) : "v"(gsrc), "s"(lds_dst) : "memory"); }
typedef short v4i16_t __attribute__((ext_vector_type(4)));
__device__ __forceinline__ s16x4 vtr(const LAS unsigned char* p) { return __builtin_bit_cast(s16x4, __builtin_amdgcn_ds_read_tr16_b64_v4i16((LAS v4i16_t*)p)); }

struct Frame {
    LAS unsigned char* lds;
    volatile LAS unsigned* MISC;
    gu32* ctl;
    int tid, lane, wave, vcu, G;
};
using pg8::Args; using pg8::KArgs; using pg8::KA;

__device__ __forceinline__ float wave_sum(float v) {
#pragma unroll
    for (int o = 1; o < 64; o <<= 1) v += __shfl_xor(v, o);
    return v;
}
__device__ __forceinline__ void p0_transpose_item(const float* W, int K, int N, bf16* WT, int drow0, const float* g, LAS float* scr, int k0, int n0, int lane) {
    const int n = n0 + (lane & 31);
#pragma unroll 8
    for (int i = 0; i < 32; ++i) { const int kk = 2 * i + (lane >> 5); float w = (n < N) ? W[(size_t)(k0 + kk) * N + n] : 0.f; if (g) w *= g[k0 + kk]; scr[kk * 33 + (lane & 31)] = w; }
    LDS_WAIT(); asm volatile("" ::: "memory");
    const int c = lane & 7;
#pragma unroll
    for (int j = 0; j < 4; ++j) { const int nn = (lane >> 3) + 8 * j; const LAS float* s = scr + (8 * c) * 33 + nn;
        v4u o; o.x = pk2(s[0 * 33], s[1 * 33]); o.y = pk2(s[2 * 33], s[3 * 33]); o.z = pk2(s[4 * 33], s[5 * 33]); o.w = pk2(s[6 * 33], s[7 * 33]);
        *(GAS v4u*)(WT + (size_t)(drow0 + nn) * K + k0 + 8 * c) = o; }
    LDS_WAIT(); asm volatile("" ::: "memory");
}
__device__ __forceinline__ void row_to_bf16(const float* xrow, bf16* orow, float* ssq16, int lane) {
    const GAS f32x4* xr = (const GAS f32x4*)xrow + lane;
    f32x4 v[4]; float s = 0.f;
#pragma unroll
    for (int j = 0; j < 4; ++j) { v[j] = xr[64 * j]; s += (v[j].x * v[j].x + v[j].y * v[j].y) + (v[j].z * v[j].z + v[j].w * v[j].w); }
    GAS unsigned long long* o8 = (GAS unsigned long long*)orow + lane;
#pragma unroll
    for (int j = 0; j < 4; ++j) o8[64 * j] = (unsigned long long)pk2(v[j].x, v[j].y) | ((unsigned long long)pk2(v[j].z, v[j].w) << 32);
    if (ssq16) { s = wave_sum(s); if (lane < 16) ssq16[lane] = (lane == 0) ? s : 0.f; }
}
__device__ __forceinline__ void p0_prologue(Frame& F) {
    KArgs ka = KA();
    LAS float* scr = (LAS float*)(F.lds + RING_OFF + F.wave * 16384);
    const int gw = F.vcu * NWAVES + F.wave, NGW = F.G * NWAVES;
    unsigned char* ws = ka->ws;
    constexpr int NITEMS = 2 * 1536 + 2 * 512 + 2 * 2176 + 2 * 512 + 4 * 2048 + 4 * 2048;
    for (int it = gw; it < NITEMS; it += NGW) {
        int r = it; const float* W; const float* g = nullptr; bf16* WT; int K = 1024, N, nnb; bool perm = false;
        if (r < 3072) { const int j = r / 1536; r -= j * 1536; W = ka->in[10] + (size_t)j * 1024 * 3072; N = 3072; nnb = 96; WT = (bf16*)(ws + WS_WINA) + (size_t)j * 3072 * 1024; g = ka->in[8] + (2 * j) * 1024; perm = true; }
        else if ((r -= 3072) < 1024) { const int j = r / 512; r -= j * 512; W = ka->in[11] + (size_t)j * 1024 * 1024; N = 1024; nnb = 32; WT = (bf16*)(ws + WS_WOA) + (size_t)j * 1024 * 1024; }
        else if ((r -= 1024) < 4352) { const int j = r / 2176; r -= j * 2176; W = ka->in[15] + (size_t)j * 1024 * NMIN_REAL; N = NMIN_REAL; nnb = 136; WT = (bf16*)(ws + WS_WINB) + (size_t)j * NMIN * 1024; g = ka->in[8] + (2 * j + 1) * 1024; }
        else if ((r -= 4352) < 1024) { const int j = r / 512; r -= j * 512; W = ka->in[21] + (size_t)j * 1024 * 1024; N = 1024; nnb = 32; WT = (bf16*)(ws + WS_WOB) + (size_t)j * 1024 * 1024; }
        else if ((r -= 1024) < 8192) { const int j = r / 2048; r -= j * 2048; W = ka->in[22] + (size_t)j * 1024 * 4096; N = 4096; nnb = 128; WT = (bf16*)(ws + WS_WUP) + (size_t)j * 4096 * 1024; g = ka->in[9] + j * 1024; }
        else { r -= 8192; const int j = r / 2048; r -= j * 2048; W = ka->in[23] + (size_t)j * 4096 * 1024; N = 1024; nnb = 32; K = 4096; WT = (bf16*)(ws + WS_WDN) + (size_t)j * 1024 * 4096; }
        const int kb = r / nnb, nb = r % nnb, n0 = 32 * nb;
        int drow0 = n0;
        if (perm) { const int tile = n0 >> 8, rr = n0 & 255, wc = rr >> 6, bj = (rr & 63) >> 5; drow0 = 256 * tile + 128 * bj + 32 * wc; }
        p0_transpose_item(W, K, N, WT, drow0, g, scr, 64 * kb, n0, F.lane);
    }
    bf16* XB = (bf16*)(ws + WS_XB); float* SSQ = (float*)(ws + WS_SSQ);
    for (int m = gw; m < MT; m += NGW) {
        const float* xr = (m < MP) ? ka->in[0] + (size_t)m * D : ka->in[1] + (size_t)(m - MP) * D;
        row_to_bf16(xr, XB + (size_t)m * D, SSQ + (size_t)m * 16, F.lane);
    }
}
__device__ __forceinline__ void cache_to_rings(Frame& F, int j) {
    KArgs ka = KA();
    const int gw = F.vcu * NWAVES + F.wave, NGW = F.G * NWAVES;
    bf16* RK = (bf16*)(ka->ws + WS_A + A_RK); bf16* RV = (bf16*)(ka->ws + WS_A + A_RV);
    for (int r = gw; r < 16384; r += NGW) {
        const int tsr = r >> 13, rr = r & 8191, b = rr >> 9, pos = rr & 511;
        const float* src = (tsr ? ka->in[3] : ka->in[2]) + (((size_t)j * 16 + b) * 512 + pos) * D;
        bf16* dst = (tsr ? RV : RK) + ((size_t)b * 576 + pos) * D;
        row_to_bf16(src, dst, nullptr, F.lane);
    }
}

__device__ __forceinline__ int crow(int r, int hi) { return (r & 3) + 8 * (r >> 2) + 4 * hi; }
constexpr int AT_STAGE = 65536, AT_HEAD = 16384, AT_V = 8192;
constexpr float LOG2E = 1.4426950408889634f;
__device__ __forceinline__ void attn_unit(Frame& F, int cx, int hg, const bf16* Q, const bf16* KP, const bf16* VP, const bf16* RK, const bf16* RV, bf16* O, const float* relb  ) {
    const int lane = F.lane, wid = F.wave, r32 = lane & 31, hi = lane >> 5;
    const int hh = wid >> 1, head = 4 * hg + hh, rh = wid & 1;
    LAS unsigned char* ring = F.lds + RING_OFF;
    LAS float* btab = (LAS float*)(F.lds + EXTRA_OFF);
    const bf16 *Kb, *Vb; long kvrow0; int i0; long qrow0;
    if (cx < 256) { Kb = KP; Vb = VP; kvrow0 = (long)(cx - 8) * 64; i0 = cx < 8 ? 8 - cx : 0; qrow0 = (long)cx * 64; }
    else { const int b = cx - 256; Kb = RK + (size_t)b * 576 * D; Vb = RV + (size_t)b * 576 * D; kvrow0 = 0; i0 = 0; qrow0 = MP + (long)b * 64; }
    for (int x = F.tid; x < 4 * 257; x += NWAVES * 64) { const int h4 = x / 257, e = x % 257; btab[h4 * 260 + e] = relb[(4 * hg + h4) * 257 + e] * LOG2E; }
    const unsigned lds0 = (unsigned)(size_t)ring;
#define AT_DMA(i, st) do { const long r0_ = kvrow0 + 64 * (long)(i); \
        _Pragma("unroll") for (int h4 = 0; h4 < 4; ++h4) { \
            glds16(Kb + (r0_ + lane) * D + (4 * hg + h4) * 64 + wid * 8, (unsigned)__builtin_amdgcn_readfirstlane(lds0 + (st) * AT_STAGE + h4 * AT_HEAD + wid * 1024)); \
            glds16(Vb + (r0_ + 16 * (wid & 3) + (lane >> 2)) * D + (4 * hg + h4) * 64 + (wid >> 2) * 32 + (lane & 3) * 8, (unsigned)__builtin_amdgcn_readfirstlane(lds0 + (st) * AT_STAGE + h4 * AT_HEAD + AT_V + wid * 1024)); } } while (0)
    AT_DMA(i0, 0);
    bf16x8 qr[4];
    const bf16* Qw = Q + (qrow0 + 32 * rh + r32) * D + head * 64;
#pragma unroll
    for (int d0 = 0; d0 < 4; ++d0) qr[d0] = *(const bf16x8*)(Qw + d0 * 16 + hi * 8);
    float mrun = -1e30f, lrun = 0.f; f32x16 o0 = {}, o1 = {};
    const int tq = 32 * rh + r32;
    int st = 0;
    for (int i = i0; i < 9; ++i) {
        WAIT_ALL_BAR();
        if (i < 8) AT_DMA(i + 1, st ^ 1);
        const LAS unsigned char* Ks = ring + st * AT_STAGE + hh * AT_HEAD;
        const LAS unsigned char* Vs = Ks + AT_V;
        f32x16 p0 = {}, p1 = {};
        { const LAS unsigned char* kb = Ks + hi * 1024 + r32 * 16;
#pragma unroll
          for (int d0 = 0; d0 < 4; ++d0) {
              const bf16x8 b0 = *(const LAS bf16x8*)(kb + d0 * 2048), b1 = *(const LAS bf16x8*)(kb + d0 * 2048 + 512);
              p0 = __builtin_amdgcn_mfma_f32_32x32x16_bf16(b0, qr[d0], p0, 0, 0, 0);
              p1 = __builtin_amdgcn_mfma_f32_32x32x16_bf16(b1, qr[d0], p1, 0, 0, 0); } }
        const LAS float* bt = btab + hh * 260;
        if (i < 6) { const float cb = bt[256];
#pragma unroll
            for (int r = 0; r < 16; ++r) { p0[r] += cb; p1[r] += cb; } }
        else {
#pragma unroll
            for (int r = 0; r < 16; ++r) { const int j = 64 * i + crow(r, hi); int d0_ = 512 + tq - j, d1_ = d0_ - 32; d0_ = d0_ > 128 ? 128 : d0_; d1_ = d1_ > 128 ? 128 : d1_;
                p0[r] += bt[d0_ + 128]; p1[r] += bt[d1_ + 128]; } }
        float rm = p0[0];
#pragma unroll
        for (int r = 0; r < 16; ++r) { rm = fmaxf(rm, p0[r]); rm = fmaxf(rm, p1[r]); }
        { auto rr = __builtin_amdgcn_permlane32_swap(__float_as_uint(rm), __float_as_uint(rm), false, false); rm = fmaxf(__uint_as_float(rr[0]), __uint_as_float(rr[1])); }
        const float mn = fmaxf(mrun, rm), alpha = __builtin_amdgcn_exp2f(mrun - mn); mrun = mn;
        float ps = 0.f;
#pragma unroll
        for (int r = 0; r < 16; ++r) { p0[r] = __builtin_amdgcn_exp2f(p0[r] - mn); p1[r] = __builtin_amdgcn_exp2f(p1[r] - mn); ps += p0[r] + p1[r]; }
        lrun = lrun * alpha + ps;
#pragma unroll
        for (int r = 0; r < 16; ++r) { o0[r] *= alpha; o1[r] *= alpha; }
        v4u pw[4];
#pragma unroll
        for (int k = 0; k < 2; ++k) {
            pw[k]     = (v4u){pk2(p0[8 * k], p0[8 * k + 1]), pk2(p0[8 * k + 2], p0[8 * k + 3]), pk2(p0[8 * k + 4], p0[8 * k + 5]), pk2(p0[8 * k + 6], p0[8 * k + 7])};
            pw[2 + k] = (v4u){pk2(p1[8 * k], p1[8 * k + 1]), pk2(p1[8 * k + 2], p1[8 * k + 3]), pk2(p1[8 * k + 4], p1[8 * k + 5]), pk2(p1[8 * k + 6], p1[8 * k + 7])};
        }
        const LAS unsigned char* vb = Vs + ((lane >> 4) & 1) * 32 + (lane & 3) * 8 + (4 * hi + ((lane & 15) >> 2)) * 64;
#pragma unroll
        for (int ks = 0; ks < 4; ++ks) {
            const s16x4 l0 = vtr(vb + ks * 1024), h0 = vtr(vb + ks * 1024 + 512), l1 = vtr(vb + 4096 + ks * 1024), h1 = vtr(vb + 4096 + ks * 1024 + 512);
            const bf16x8 v0 = (bf16x8){l0[0], l0[1], l0[2], l0[3], h0[0], h0[1], h0[2], h0[3]}, v1 = (bf16x8){l1[0], l1[1], l1[2], l1[3], h1[0], h1[1], h1[2], h1[3]};
            const bf16x8 pa = __builtin_bit_cast(bf16x8, pw[ks]);
            o0 = __builtin_amdgcn_mfma_f32_32x32x16_bf16(v0, pa, o0, 0, 0, 0);
            o1 = __builtin_amdgcn_mfma_f32_32x32x16_bf16(v1, pa, o1, 0, 0, 0);
        }
        st ^= 1;
    }
#undef AT_DMA
    { auto rr = __builtin_amdgcn_permlane32_swap(__float_as_uint(lrun), __float_as_uint(lrun), false, false); lrun = __uint_as_float(rr[0]) + __uint_as_float(rr[1]); }
    const float rl = 1.0f / lrun;
    bf16* Ow = O + (qrow0 + tq) * D + head * 64;
#pragma unroll
    for (int g = 0; g < 4; ++g) {
        v2u w0, w1;
        w0.x = pk2(o0[4 * g] * rl, o0[4 * g + 1] * rl); w0.y = pk2(o0[4 * g + 2] * rl, o0[4 * g + 3] * rl);
        w1.x = pk2(o1[4 * g] * rl, o1[4 * g + 1] * rl); w1.y = pk2(o1[4 * g + 2] * rl, o1[4 * g + 3] * rl);
        *(v2u*)(Ow + 8 * g + 4 * hi) = w0; *(v2u*)(Ow + 32 + 8 * g + 4 * hi) = w1;
    }
    WAIT_ALL_BAR();
}
__device__ __forceinline__ void attn_phase(Frame& F, int j) {
    KArgs ka = KA(); unsigned char* A = ka->ws + WS_A;
    const bf16 *Q = (const bf16*)(A + A_Q), *KP = (const bf16*)(A + A_KP), *VP = (const bf16*)(A + A_VP), *RK = (const bf16*)(A + A_RK), *RV = (const bf16*)(A + A_RV);
    bf16* O = (bf16*)(A + A_O);
    const float* relb = ka->in[14] + (size_t)j * 16 * 257;
    for (int u = F.vcu; u < 272 * 4; u += F.G) attn_unit(F, u >> 2, u & 3, Q, KP, VP, RK, RV, O, relb);
}

struct MUnit { int head, ntok, b, isS; long row0; };
__device__ __forceinline__ void munit(int u, MUnit& m) {
    if (u < 512) { m.head = u & 3; m.ntok = 128; m.row0 = (long)(u >> 2) * 128; m.isS = 0; m.b = 0; }
    else { const int v = u - 512; m.head = v & 3; m.b = v >> 2; m.ntok = 64; m.row0 = MP + (long)m.b * 64; m.isS = 1; }
}
#define LBAR() asm volatile("s_waitcnt lgkmcnt(0)\n\ts_barrier" ::: "memory")
__device__ __forceinline__ f32x4 mfma16(bf16x8 a, bf16x8 b, f32x4 c) { return __builtin_amdgcn_mfma_f32_16x16x32_bf16(a, b, c, 0, 0, 0); }
__device__ __forceinline__ bf16x8 trfrag(const LAS unsigned char* p) { const s16x4 lo = vtr(p), hi = vtr(p + 1024); return (bf16x8){lo[0], lo[1], lo[2], lo[3], hi[0], hi[1], hi[2], hi[3]}; }
constexpr int MSTART_OFF = 2048;

__device__ __forceinline__ void mlstm_a_unit(Frame& F, int j, int u) {
    MUnit mu; munit(u, mu); KArgs ka = KA();
    unsigned char* A = ka->ws + WS_A;
    const bf16* QKP = (const bf16*)(A + A_QKP); const bf16* V = (const bf16*)(A + A_V);
    bf16* QC = (bf16*)(A + A_QC); bf16* KC = (bf16*)(A + A_KC);
    bf16* slab = (bf16*)(A + A_SLAB + (size_t)u * SLAB_BYTES);
    const float* gates = (const float*)(ka->ws + WS_GATES); float* stats = (float*)(ka->ws + WS_STATS);
    LAS float* xs = (LAS float*)(F.lds + EXTRA_OFF + 10240);
    LAS unsigned char* Kt = F.lds + RING_OFF; LAS unsigned char* Wv = F.lds + RING_OFF + 65536;
    const int tid = F.tid, lane = F.lane, wid = F.wave, head = mu.head, ntok = mu.ntok; const long row0 = mu.row0;
    if (tid < ntok) { xs[tid] = gates[(row0 + tid) * 8 + head]; xs[128 + tid] = gates[(row0 + tid) * 8 + 4 + head]; }
    LBAR();
    float bt = 0.f, ut = -3.0e38f;
    if (tid < ntok) { for (int r = 0; r <= tid; ++r) bt += xs[128 + r]; ut = xs[tid] - bt; }
    LBAR();
    if (tid < ntok) { xs[128 + tid] = bt; xs[256 + tid] = ut; }
    LBAR();
    float umax = -3.0e38f; for (int r = 0; r < ntok; ++r) umax = fmaxf(umax, xs[256 + r]);
    const float bsum = xs[128 + ntok - 1];
    LBAR();
    if (tid < ntok) xs[256 + tid] = expf(ut - umax);
    if (tid == 0) { stats[u * 2] = bsum; stats[u * 2 + 1] = umax; }
    const int nh = ntok >> 6;
    LBAR();
    for (int hs = 0; hs < nh; ++hs) {
        {
            const int cgi = tid & 63, rseg = tid >> 6, c = cgi & 31; const bool isk = cgi >= 32;
            const int qcol = (isk ? 1024 : 0) + head * 256 + 8 * c;
            float cw[4][8], cb[8];
#pragma unroll
            for (int jj = 0; jj < 4; ++jj) { const f32x4 w0 = *(const f32x4*)(ka->in[18] + ((size_t)j * 4 + jj) * 2048 + qcol), w1 = *(const f32x4*)(ka->in[18] + ((size_t)j * 4 + jj) * 2048 + qcol + 4);
#pragma unroll
                for (int e = 0; e < 4; ++e) { cw[jj][e] = w0[e]; cw[jj][4 + e] = w1[e]; } }
            { const f32x4 w0 = *(const f32x4*)(ka->in[19] + (size_t)j * 2048 + qcol), w1 = *(const f32x4*)(ka->in[19] + (size_t)j * 2048 + qcol + 4);
#pragma unroll
              for (int e = 0; e < 4; ++e) { cb[e] = w0[e]; cb[4 + e] = w1[e]; } }
            float x0[8], x1[8], x2[8];
#pragma unroll
            for (int e = 0; e < 8; ++e) { x0[e] = 0.f; x1[e] = 0.f; x2[e] = 0.f; }
#pragma unroll
            for (int i = -3; i < 8; ++i) {
                const int tt = 64 * hs + 8 * rseg + i;
                float x[8];
                if (tt >= 0 || (!mu.isS && row0 > 0)) {
                    const v4u w = *(const v4u*)(QKP + (size_t)(row0 + tt) * 2048 + qcol);
                    x[0] = bflo(w.x); x[1] = bfhi(w.x); x[2] = bflo(w.y); x[3] = bfhi(w.y); x[4] = bflo(w.z); x[5] = bfhi(w.z); x[6] = bflo(w.w); x[7] = bfhi(w.w);
                } else if (mu.isS) {
                    const float* sp = ka->in[7] + (((size_t)j * 16 + mu.b) * 3 + (3 + tt)) * 2048 + qcol;
                    const f32x4 w0 = *(const f32x4*)sp, w1 = *(const f32x4*)(sp + 4);
#pragma unroll
                    for (int e = 0; e < 4; ++e) { x[e] = w0[e]; x[4 + e] = w1[e]; }
                } else {
#pragma unroll
                    for (int e = 0; e < 8; ++e) x[e] = 0.f;
                }
                if (i >= 0) {
                    float y[8];
#pragma unroll
                    for (int e = 0; e < 8; ++e) { const float s = cb[e] + cw[0][e] * x0[e] + cw[1][e] * x1[e] + cw[2][e] * x2[e] + cw[3][e] * x[e]; float v = s / (1.0f + __expf(-s)); if (isk) v *= 0.0625f; y[e] = v; }
                    v4u o; o.x = pk2(y[0], y[1]); o.y = pk2(y[2], y[3]); o.z = pk2(y[4], y[5]); o.w = pk2(y[6], y[7]);
                    *(v4u*)((isk ? KC : QC) + (size_t)(row0 + tt) * D + head * 256 + 8 * c) = o;
                    if (isk) *(LAS v4u*)(Kt + (c >> 2) * 8192 + (64 * hs + 8 * rseg + i) * 64 + (c & 3) * 16) = o;
                }
#pragma unroll
                for (int e = 0; e < 8; ++e) { x0[e] = x1[e]; x1[e] = x2[e]; x2[e] = x[e]; }
            }
        }
        {
            const int c = tid & 31, kseg = tid >> 5;
#pragma unroll
            for (int i = 0; i < 4; ++i) {
                const int key = 4 * kseg + i; const float w = xs[256 + 64 * hs + key];
                const v4u x = *(const v4u*)(V + (size_t)(row0 + 64 * hs + key) * D + head * 256 + 8 * c);
                v4u o; o.x = pk2(bflo(x.x) * w, bfhi(x.x) * w); o.y = pk2(bflo(x.y) * w, bfhi(x.y) * w); o.z = pk2(bflo(x.z) * w, bfhi(x.z) * w); o.w = pk2(bflo(x.w) * w, bfhi(x.w) * w);
                *(LAS v4u*)(Wv + (c >> 2) * 8192 + (64 * hs + key) * 64 + (c & 3) * 16) = o;
            }
            if (tid < 256) { const int key = tid >> 2, ch = tid & 3; v4u o = (v4u){0u, 0u, 0u, 0u}; if (ch == 0) o.x = f2bf(xs[256 + 64 * hs + key]); *(LAS v4u*)(Wv + 8 * 8192 + (64 * hs + key) * 64 + ch * 16) = o; }
        }
    }
    LBAR();
    f32x4 acc[2][17];
#pragma unroll
    for (int dd = 0; dd < 2; ++dd)
#pragma unroll
        for (int eb = 0; eb < 17; ++eb) acc[dd][eb] = (f32x4){0.f, 0.f, 0.f, 0.f};
    {
        const int g = lane >> 4, q = (lane & 15) >> 2, p = lane & 3;
        for (int ks = 0; ks < 2 * nh; ++ks) {
            const int koff = (32 * ks + 4 * g + q) * 64 + p * 8;
            bf16x8 af[2];
#pragma unroll
            for (int dd = 0; dd < 2; ++dd) { const int db = 2 * wid + dd; af[dd] = trfrag(Kt + (db >> 1) * 8192 + (db & 1) * 32 + koff); }
#pragma unroll
            for (int eb = 0; eb < 17; ++eb) {
                const bf16x8 bfr = trfrag(Wv + (eb >> 1) * 8192 + (eb & 1) * 32 + koff);
                acc[0][eb] = mfma16(af[0], bfr, acc[0][eb]); acc[1][eb] = mfma16(af[1], bfr, acc[1][eb]);
            }
        }
    }
    {
        const int g = lane >> 4, el = lane & 15;
#pragma unroll
        for (int dd = 0; dd < 2; ++dd)
#pragma unroll
            for (int eb = 0; eb < 17; ++eb) {
                const int e = 16 * eb + el, d = 16 * (2 * wid + dd) + 4 * g; const f32x4 v = acc[dd][eb];
                v2u o; o.x = pk2(v[0], v[1]); o.y = pk2(v[2], v[3]);
                *(v2u*)(slab + (size_t)e * 256 + d) = o;
            }
    }
    LBAR();
}

__device__ __forceinline__ void mlstm_b_phase(Frame& F, int j) {
    KArgs ka = KA();
    unsigned char* A = ka->ws + WS_A; unsigned char* slab0 = A + A_SLAB;
    float* stats = (float*)(ka->ws + WS_STATS); float* mstart = stats + MSTART_OFF;
    LAS float* tab = (LAS float*)(F.lds + EXTRA_OFF);
    const int tid = F.tid;
    for (int vb = F.vcu; vb < 256; vb += F.G) {
        if (vb < 136) {
            const int head = vb / 34, vi = (vb % 34) * 512 + tid;
            LBAR();
            if (tid == 0) {
                float m = 0.f;
                for (int J = 0; J < 128; ++J) { const int u = J * 4 + head; const float bs = stats[u * 2], um = stats[u * 2 + 1]; const float mn = bs + fmaxf(m, um);
                    tab[J] = expf(bs + m - mn); tab[128 + J] = expf(bs + um - mn); if (vb % 34 == 0) mstart[u] = m; m = mn; }
                tab[256] = m;
            }
            LBAR();
            f32x4 C = (f32x4){0.f, 0.f, 0.f, 0.f};
            unsigned char* p0 = slab0 + (size_t)head * SLAB_BYTES + (size_t)vi * 8;
            for (int J0 = 0; J0 < 128; J0 += 8) {
                v2u dq[8];
#pragma unroll
                for (int k = 0; k < 8; ++k) dq[k] = *(const v2u*)(p0 + (size_t)(J0 + k) * 4 * SLAB_BYTES);
#pragma unroll
                for (int k = 0; k < 8; ++k) {
                    v2u o; o.x = pk2(C[0], C[1]); o.y = pk2(C[2], C[3]);
                    *(v2u*)(p0 + (size_t)(J0 + k) * 4 * SLAB_BYTES) = o;
                    const float dc = tab[J0 + k], sc = tab[128 + J0 + k];
                    C[0] = dc * C[0] + sc * bflo(dq[k].x); C[1] = dc * C[1] + sc * bfhi(dq[k].x); C[2] = dc * C[2] + sc * bflo(dq[k].y); C[3] = dc * C[3] + sc * bfhi(dq[k].y);
                }
            }
            const int e = vi >> 6, d = (vi & 63) * 4;
            if (e < 256) *(f32x4*)(ka->out + O_CP + (((size_t)j * 4 + head) * 256 + e) * 256 + d) = C;
            else if (e == 256) *(f32x4*)(ka->out + O_NP + ((size_t)j * 4 + head) * 256 + d) = C;
            if (vb % 34 == 0 && tid == 0) ka->out[O_MP + j * 4 + head] = tab[256];
        } else {
            for (int idx = (vb - 136) * 512 + tid; idx < 64 * 17408; idx += 120 * 512) {
                const int v = idx / 17408, vi = idx - v * 17408, b = v >> 2, head = v & 3, u = 512 + v, e = vi >> 6, d = (vi & 63) * 4;
                const size_t sh = ((size_t)j * 16 + b) * 4 + head;
                const float m0 = ka->in[6][sh], bs = stats[u * 2], um = stats[u * 2 + 1], mn = bs + fmaxf(m0, um), dc = expf(bs + m0 - mn), sc = expf(bs + um - mn);
                f32x4 C0 = (f32x4){0.f, 0.f, 0.f, 0.f};
                if (e < 256) C0 = *(const f32x4*)(ka->in[4] + (sh * 256 + e) * 256 + d); else if (e == 256) C0 = *(const f32x4*)(ka->in[5] + sh * 256 + d);
                unsigned char* p = slab0 + (size_t)u * SLAB_BYTES + (size_t)vi * 8;
                const v2u dq = *(const v2u*)p;
                v2u o; o.x = pk2(C0[0], C0[1]); o.y = pk2(C0[2], C0[3]); *(v2u*)p = o;
                f32x4 Ce; Ce[0] = dc * C0[0] + sc * bflo(dq.x); Ce[1] = dc * C0[1] + sc * bfhi(dq.x); Ce[2] = dc * C0[2] + sc * bflo(dq.y); Ce[3] = dc * C0[3] + sc * bfhi(dq.y);
                if (e < 256) *(f32x4*)(ka->out + O_CS + (sh * 256 + e) * 256 + d) = Ce; else if (e == 256) *(f32x4*)(ka->out + O_NS + sh * 256 + d) = Ce;
                if (vi == 0) { ka->out[O_MS + sh] = mn; mstart[u] = m0; }
            }
        }
    }
}

__device__ __forceinline__ void mlstm_c_unit(Frame& F, int j, int u) {
    MUnit mu; munit(u, mu); KArgs ka = KA();
    unsigned char* A = ka->ws + WS_A;
    const bf16* V = (const bf16*)(A + A_V); bf16* OG = (bf16*)(A + A_OG);
    const bf16* QC = (const bf16*)(A + A_QC); const bf16* KC = (const bf16*)(A + A_KC);
    const bf16* slab = (const bf16*)(A + A_SLAB + (size_t)u * SLAB_BYTES);
    const float* gates = (const float*)(ka->ws + WS_GATES); const float* stats = (const float*)(ka->ws + WS_STATS);
    LAS float* xs = (LAS float*)(F.lds + EXTRA_OFF + 10240);
    LAS unsigned char* ring = F.lds + RING_OFF; const unsigned lds0 = (unsigned)(size_t)ring;
    const int tid = F.tid, lane = F.lane, wid = F.wave, head = mu.head, ntok = mu.ntok; const long row0 = mu.row0;
    const int tl = lane & 15, g = lane >> 4, t = 16 * wid + tl;
    const bool active = 16 * wid < ntok;
    const float ms = stats[MSTART_OFF + u];
#pragma unroll
    for (int ct = 0; ct < 4; ++ct)
#pragma unroll
        for (int k = 0; k < 4; ++k) { const int c = wid * 4 + k;
            glds16(slab + (size_t)(64 * ct + lane) * 256 + c * 8, (unsigned)__builtin_amdgcn_readfirstlane(lds0 + ct * 32768 + c * 1024)); }
    if (tid < ntok) { xs[tid] = gates[(row0 + tid) * 8 + head]; xs[128 + tid] = gates[(row0 + tid) * 8 + 4 + head]; }
    LBAR();
    float bt = 0.f, ut = -3.0e38f;
    if (tid < ntok) { for (int r = 0; r <= tid; ++r) bt += xs[128 + r]; ut = xs[tid] - bt; }
    LBAR();
    if (tid < ntok) { xs[128 + tid] = bt; xs[256 + tid] = ut; }
    LBAR();
    if (tid < ntok) { float pm = -3.0e38f; for (int r = 0; r <= tid; ++r) pm = fmaxf(pm, xs[256 + r]); xs[384 + tid] = bt + fmaxf(ms, pm); }
    LBAR();
    if (tid < ntok) xs[256 + tid] = ut * LOG2E;
    float b_t = 0.f, m_t = 0.f;
    if (active) { b_t = xs[128 + t]; m_t = xs[384 + t]; }
    const float a_t = (b_t - m_t) * LOG2E, inter_t = expf(b_t + ms - m_t);
    bf16x8 qf[8];
#pragma unroll
    for (int kd = 0; kd < 8; ++kd) qf[kd] = active ? *(const bf16x8*)(QC + (size_t)(row0 + t) * D + head * 256 + 32 * kd + 8 * g) : (bf16x8){0, 0, 0, 0, 0, 0, 0, 0};
    WAIT_ALL_BAR();
    f32x4 acc[16];
#pragma unroll
    for (int eb = 0; eb < 16; ++eb) acc[eb] = (f32x4){0.f, 0.f, 0.f, 0.f};
    if (active) {
#pragma unroll
        for (int eb = 0; eb < 16; ++eb) {
            const LAS unsigned char* cb = ring + (eb >> 2) * 32768 + g * 1024 + ((eb & 3) * 16 + tl) * 16;
#pragma unroll
            for (int kd = 0; kd < 8; ++kd) acc[eb] = mfma16(*(const LAS bf16x8*)(cb + kd * 4096), qf[kd], acc[eb]);
        }
    }
    WAIT_ALL_BAR();
#define MC_DMA_KV(kt, bk, bv) do { \
        _Pragma("unroll") for (int k = 0; k < 4; ++k) { const int c = wid * 4 + k; \
            glds16(KC + (size_t)(row0 + 64 * (kt) + lane) * D + head * 256 + c * 8, (unsigned)__builtin_amdgcn_readfirstlane(lds0 + (bk) * 32768 + c * 1024)); } \
        _Pragma("unroll") for (int k = 0; k < 4; ++k) { const int pc = wid * 4 + k, cg = pc >> 2, rg = pc & 3; \
            glds16(V + (size_t)(row0 + 64 * (kt) + 16 * rg + (lane >> 2)) * D + head * 256 + cg * 32 + (lane & 3) * 8, (unsigned)__builtin_amdgcn_readfirstlane(lds0 + (bv) * 32768 + pc * 1024)); } } while (0)
#pragma unroll
    for (int k = 0; k < 4; ++k) { const int c = wid * 4 + k; const int rr = 256 + lane > 271 ? 271 : 256 + lane;
        glds16(slab + (size_t)rr * 256 + c * 8, (unsigned)__builtin_amdgcn_readfirstlane(lds0 + c * 1024)); }
    MC_DMA_KV(0, 2, 3);
    WAIT_ALL_BAR();
    float nq = 0.f;
    {
        f32x4 ad = (f32x4){0.f, 0.f, 0.f, 0.f};
        if (active) {
            const LAS unsigned char* cb = ring + g * 1024 + tl * 16;
#pragma unroll
            for (int kd = 0; kd < 8; ++kd) ad = mfma16(*(const LAS bf16x8*)(cb + kd * 4096), qf[kd], ad);
        }
        nq = __shfl(ad[0], tl);
    }
#pragma unroll
    for (int eb = 0; eb < 16; ++eb) acc[eb] = acc[eb] * inter_t;
    float den = inter_t * nq, denp = 0.f;
    WAIT_ALL_BAR();
    const int nkt = ntok >> 6;
    if (nkt > 1) MC_DMA_KV(1, 0, 1);
    for (int kt = 0; kt < nkt; ++kt) {
        if (kt == 1) WAIT_ALL_BAR();
        const LAS unsigned char* bK = ring + (kt == 0 ? 2 : 0) * 32768; const LAS unsigned char* bV = bK + 32768;
        if (active && kt <= (wid >> 2)) {
            f32x4 sacc[4];
#pragma unroll
            for (int sb = 0; sb < 4; ++sb) { sacc[sb] = (f32x4){0.f, 0.f, 0.f, 0.f};
                const LAS unsigned char* kb = bK + g * 1024 + (16 * sb + tl) * 16;
#pragma unroll
                for (int kd = 0; kd < 8; ++kd) sacc[sb] = mfma16(*(const LAS bf16x8*)(kb + kd * 4096), qf[kd], sacc[sb]); }
            unsigned pw[8];
#pragma unroll
            for (int sb = 0; sb < 4; ++sb) {
                const f32x4 c4 = *(const LAS f32x4*)(xs + 256 + 64 * kt + 16 * sb + 4 * g);
                float pv[4];
#pragma unroll
                for (int r = 0; r < 4; ++r) { const int s = 64 * kt + 16 * sb + 4 * g + r; const float w = __builtin_amdgcn_exp2f(fminf(a_t + c4[r], 0.f)); pv[r] = (s <= t) ? sacc[sb][r] * w : 0.f; denp += pv[r]; }
                pw[2 * sb] = pk2(pv[0], pv[1]); pw[2 * sb + 1] = pk2(pv[2], pv[3]);
            }
            const bf16x8 pf0 = __builtin_bit_cast(bf16x8, (v4u){pw[0], pw[1], pw[2], pw[3]}), pf1 = __builtin_bit_cast(bf16x8, (v4u){pw[4], pw[5], pw[6], pw[7]});
            const int q = tl >> 2, p = lane & 3;
            const LAS unsigned char* vb = bV + (4 * g + q) * 64 + p * 8;
#pragma unroll
            for (int eb = 0; eb < 16; ++eb) {
                const LAS unsigned char* ve = vb + (eb >> 1) * 4096 + (eb & 1) * 32;
                acc[eb] = mfma16(trfrag(ve), pf0, acc[eb]);
                acc[eb] = mfma16(trfrag(ve + 32 * 64), pf1, acc[eb]);
            }
        }
    }
#undef MC_DMA_KV
    denp += __shfl_xor(denp, 16); denp += __shfl_xor(denp, 32);
    den += denp;
    const float inv = 1.0f / fmaxf(fabsf(den), expf(-m_t));
    float ss = 0.f;
#pragma unroll
    for (int eb = 0; eb < 16; ++eb) { acc[eb] = acc[eb] * inv; const f32x4 x = acc[eb]; ss += (x[0] * x[0] + x[1] * x[1]) + (x[2] * x[2] + x[3] * x[3]); }
    ss += __shfl_xor(ss, 16); ss += __shfl_xor(ss, 32);
    const float rr = 1.0f / sqrtf(ss * (1.0f / 256.0f) + 1e-6f);
    if (active) {
        const float* hn = ka->in[20] + (size_t)j * 1024 + head * 256;
        bf16* orow = OG + (size_t)(row0 + t) * D + head * 256;
#pragma unroll
        for (int eb = 0; eb < 16; ++eb) {
            const int e0 = 16 * eb + 4 * g; const f32x4 h4 = *(const f32x4*)(hn + e0); const v2u og = *(const v2u*)(orow + e0); const f32x4 x = acc[eb];
            v2u o; o.x = pk2(x[0] * rr * h4[0] * bflo(og.x), x[1] * rr * h4[1] * bfhi(og.x)); o.y = pk2(x[2] * rr * h4[2] * bflo(og.y), x[3] * rr * h4[3] * bfhi(og.y));
            *(v2u*)(orow + e0) = o;
        }
    }
    WAIT_ALL_BAR();
}

__global__ void __launch_bounds__(NWAVES * 64, 2) hybrid_fwd(Args args_unused) {
    extern __shared__ __attribute__((aligned(16))) unsigned char lds[];
    Frame F;
    F.lds = (LAS unsigned char*)lds;
    F.MISC = (volatile LAS unsigned*)(F.lds + MISC_OFF);
#define FRESH() do { int t_ = threadIdx.x; asm volatile("" : "+v"(t_)); F.tid = t_; F.lane = t_ & 63; F.wave = __builtin_amdgcn_readfirstlane(t_ >> 6); } while (0)
    FRESH();
    F.G = gridDim.x; { const int bx = blockIdx.x; F.vcu = (F.G % 8 == 0) ? (bx % 8) * (F.G / 8) + bx / 8 : bx; }
    F.ctl = (gu32*)(KA()->ws + WS_CTL);
    for (int u = F.tid; u < (LDS_BYTES - LDSCTL_OFF) / 4; u += NWAVES * 64) ((LAS unsigned*)(F.lds + LDSCTL_OFF))[u] = 0u;
    __syncthreads();
    (void)xcd_barrier_post((unsigned*)(F.ctl + CW_BAR), F.MISC + 8);
#define GRID_BAR() do { XcdBarrier b_; b_.bar = (unsigned*)((gu32*)(KA()->ws + WS_CTL) + CW_BAR); b_.x = (unsigned)__builtin_amdgcn_readfirstlane((int)xb_xcc_id()); b_.st = F.MISC + 8; xcd_barrier(b_); } while (0)


#ifndef NO_P0
    FRESH(); p0_prologue(F);
#endif
    GRID_BAR();

#pragma unroll 1
    for (int layer = 0; layer < 4; ++layer) {
        const int j = layer >> 1;
#pragma unroll 1
        for (int sub = 0; sub < 2; ++sub) {
            if (sub == 1) {
                unsigned char* ws = KA()->ws;
                pg8::Gemm g{(const bf16*)(ws + WS_XB), (const bf16*)(ws + WS_WUP) + (size_t)layer * FF * D, MT, FF, D}; pg8::StaticOrder S; S.init(MT, FF, F.G, (int)blockIdx.x);
                pg8::EpiUp E{0};
#ifndef NO_UP
                pg8::gemm_phase<pg8::EpiUp, pg8::StaticOrder, true, true>(F.lds + RING_OFF, g, S, E);
#endif
                GRID_BAR();
            } else if ((layer & 1) == 0) {
#ifndef NO_P0
                FRESH(); cache_to_rings(F, j);
#endif
                VM_WAIT(); __syncthreads();
                unsigned char* ws = KA()->ws;
                pg8::Gemm g{(const bf16*)(ws + WS_XB), (const bf16*)(ws + WS_WINA) + (size_t)j * NQKV * D, MT, NQKV, D}; pg8::StaticOrder S; S.init(MT, NQKV, F.G, (int)blockIdx.x);
                pg8::EpiQKV E{j};
#ifndef NO_QKV
                pg8::gemm_phase<pg8::EpiQKV, pg8::StaticOrder, true, true>(F.lds + RING_OFF, g, S, E);
#endif
                GRID_BAR();
#ifndef NO_ATT
                FRESH(); attn_phase(F, j);
#endif
                GRID_BAR();
            } else {
                unsigned char* ws = KA()->ws;
                pg8::Gemm g{(const bf16*)(ws + WS_XB), (const bf16*)(ws + WS_WINB) + (size_t)j * NMIN * D, MT, NMIN, D}; pg8::StaticOrder S; S.init(MT, NMIN, F.G, (int)blockIdx.x);
                pg8::EpiMIn E{j};
#ifndef NO_MIN
                pg8::gemm_phase<pg8::EpiMIn, pg8::StaticOrder, true, true>(F.lds + RING_OFF, g, S, E);
#endif
                GRID_BAR();
#ifndef NO_MA
                FRESH(); for (int u = F.vcu; u < N_MUNITS; u += F.G) mlstm_a_unit(F, j, u);
#endif
                GRID_BAR();
#ifndef NO_MB
                FRESH(); mlstm_b_phase(F, j);
#endif
                GRID_BAR();
#ifndef NO_MC
                FRESH(); for (int u = F.vcu; u < N_MUNITS; u += F.G) mlstm_c_unit(F, j, u);
#endif
                GRID_BAR();
            }
            {
                unsigned char* ws = KA()->ws; unsigned char* A = ws + WS_A;
                const bf16* Aop; const bf16* Bop; int K = D;
                if (sub == 1) { Aop = (const bf16*)(A + A_HID); Bop = (const bf16*)(ws + WS_WDN) + (size_t)layer * D * FF; K = FF; }
                else if ((layer & 1) == 0) { Aop = (const bf16*)(A + A_O); Bop = (const bf16*)(ws + WS_WOA) + (size_t)j * D * D; }
                else { Aop = (const bf16*)(A + A_OG); Bop = (const bf16*)(ws + WS_WOB) + (size_t)j * D * D; }
                const bool first = (layer == 0 && sub == 0);
                pg8::Gemm g{Aop, Bop, MT, D, K}; pg8::StaticOrder S; S.init(MT, D, F.G, (int)blockIdx.x);
                pg8::EpiRes E{first ? 1 : 0};
#ifndef NO_RES
                pg8::gemm_phase<pg8::EpiRes, pg8::StaticOrder, true, true>(F.lds + RING_OFF, g, S, E);
#endif
                if (!(layer == 3 && sub == 1)) GRID_BAR();
            }
        }
    }
#undef GRID_BAR
}

extern "C" void kernel_launch(void* const* d_in, const int* in_sizes, int n_in, void* d_out, int out_size, void* d_ws, size_t ws_size, hipStream_t stream) {
    static int grid = 0;
    if (grid == 0) {
        if (n_in != 24 || (size_t)out_size != O_END || ws_size < WS_END) { fprintf(stderr, "kernel_launch: unexpected shapes: n_in %d out %d ws %zu (need %zu)\n", n_in, out_size, ws_size, (size_t)WS_END); grid = -1; return; }
        int dev = 0, cus = 0, per_cu = 0;
        if (hipGetDevice(&dev) != hipSuccess || hipDeviceGetAttribute(&cus, hipDeviceAttributeMultiprocessorCount, dev) != hipSuccess) { fprintf(stderr, "kernel_launch: device query failed\n"); grid = -1; return; }
        if (hipFuncSetAttribute((const void*)hybrid_fwd, hipFuncAttributeMaxDynamicSharedMemorySize, LDS_BYTES) != hipSuccess) { fprintf(stderr, "kernel_launch: hipFuncSetAttribute failed\n"); grid = -1; return; }
        if (hipOccupancyMaxActiveBlocksPerMultiprocessor(&per_cu, (const void*)hybrid_fwd, NWAVES * 64, LDS_BYTES) != hipSuccess || per_cu < 1)
            fprintf(stderr, "kernel_launch: note: occupancy query reports %d workgroups per CU\n", per_cu);
        (void)hipGetLastError();
        grid = cus;
    }
    if (grid < 0) return;
    if (hipMemsetAsync((char*)d_ws + WS_CTL, 0, CTL_ZERO_BYTES, stream) != hipSuccess) { fprintf(stderr, "kernel_launch: hipMemsetAsync failed\n"); return; }
    Args a{};
    for (int i = 0; i < 24; ++i) a.in[i] = (const float*)d_in[i];
    a.out = (float*)d_out; a.ws = (unsigned char*)d_ws;
    hipLaunchKernelGGL(hybrid_fwd, dim3(grid), dim3(NWAVES * 64), LDS_BYTES, stream, a);
    const hipError_t le = hipPeekAtLastError();
    if (le != hipSuccess) fprintf(stderr, "kernel_launch: launch failed: %s\n", hipGetErrorName(le));
}
```

```cpp
#include <hip/hip_runtime.h>
#include <cstdio>
#include <cstdint>
constexpr int MP = 16384, MS = 1024, MT = 17408, D = 1024, FF = 4096, NQKV = 3072, NMIN = 4352  , NMIN_REAL = 4104;
constexpr int HIDP = 4096 + 64;
constexpr int N_MUNITS = 576;
constexpr size_t SLAB_BYTES = 272 * 256 * 2;
constexpr size_t O_Y = 0, O_KP = 17825792, O_VP = 18874368, O_KS = 19922944, O_VS = 22020096, O_CP = 24117248, O_NP = 24641536, O_MP = 24643584, O_BP = 24643592,
                 O_CS = 24655880, O_NS = 33044488, O_MS = 33077256, O_BS = 33077384, O_END = 33273992;
constexpr size_t MiB = 1u << 20;
constexpr size_t WS_CTL = 0, WS_SSQ = MiB / 2, CTL_ZERO_BYTES = 2 * MiB;
constexpr float SSQ_FIX = 268435456.0f, SSQ_UNFIX = 1.0f / 268435456.0f;
constexpr size_t WS_WINA = 2 * MiB, WS_WOA = 14 * MiB, WS_WINB = 18 * MiB, WS_WOB = 35 * MiB, WS_WUP = 39 * MiB, WS_WDN = 71 * MiB;
constexpr size_t WS_XB = 104 * MiB, WS_GATES = 139 * MiB, WS_STATS = 140 * MiB;
constexpr size_t WS_MIX = 141 * MiB, WS_HID = 175 * MiB, WS_NXT = 320 * MiB, WS_END = 422 * MiB;
constexpr size_t WS_Q = WS_MIX, WS_O = WS_MIX, WS_OG = WS_MIX;
constexpr size_t WS_KP = WS_NXT, WS_VP = WS_NXT + 32 * MiB, WS_RK = WS_NXT + 64 * MiB, WS_RV = WS_NXT + 82 * MiB;
constexpr size_t WS_QKP = WS_NXT, WS_V = WS_NXT + 68 * MiB;
constexpr size_t WS_QC = WS_HID, WS_KC = WS_HID + 34 * MiB, WS_SLAB = WS_HID + 68 * MiB;
static_assert(WS_SLAB + (size_t)N_MUNITS * SLAB_BYTES <= WS_NXT && WS_RV + 18 * MiB <= WS_END && WS_V + 34 * MiB <= WS_END && WS_HID + (size_t)MT * HIDP * 2 <= WS_NXT, "d_ws map");
constexpr int CW_BAR = 4096;
constexpr int RING_OFF = 0, RING_BYTES = 131072, EXTRA_OFF = RING_BYTES, EXTRA_BYTES = 28672  , EPITR_OFF = EXTRA_OFF + 12288, LDSCTL_OFF = EXTRA_OFF + EXTRA_BYTES, MISC_OFF = LDSCTL_OFF + 320, RDYSLOT_OFF = LDSCTL_OFF + 1024  ;
constexpr int LDS_BYTES = 163840;
static_assert(MISC_OFF + 128 <= LDS_BYTES, "LDS map");
constexpr int NWAVES = 8;

namespace pg8 {
#define PG8_LAS __attribute__((address_space(3)))
typedef unsigned short bf16_t;
typedef short bf16x8 __attribute__((ext_vector_type(8)));
typedef float f32x4 __attribute__((ext_vector_type(4)));
typedef unsigned u32x4 __attribute__((ext_vector_type(4)));
constexpr int BM = 256, BK = 64, HALF = 128, HTB = HALF * BK * 2  , STAGE_BYTES = 8 * HTB, NXCD = 8, WGM = 8;

__host__ __device__ __forceinline__ int lds_byte(int r, int c) { const int st = (r >> 4) * 2 + (c >> 5), rr = r & 15, cc = c & 31, ob = rr * 64 + cc * 2; return st * 1024 + (ob ^ (((ob >> 9) & 1) << 5)); }
__host__ __device__ __forceinline__ void stage_rc(int b, int& R, int& C) { const int st = b / 1024, sb = b % 1024, swz = sb ^ (((sb >> 9) & 1) << 5); R = (st >> 1) * 16 + swz / 64; C = (st & 1) * 32 + (swz % 64) / 2; }
__host__ __device__ __forceinline__ int perm32(int rho) { const int n = rho >> 4, i = rho & 15; return 8 * (i >> 2) + 4 * n + (i & 3); }

struct Unit { int pm, pn; };
struct Gemm { const bf16_t* A; const bf16_t* Bt; int M, N, K; };

struct StaticOrder {
    int nM, nN, nwg, G, c;
    __host__ __device__ void init(int M, int N, int G_, int c_) { nM = M / BM; nN = N / BM; nwg = nM * nN; G = G_; c = c_; }
    __host__ __device__ bool next(int i, Unit& u) const {
        const long L = (long)i * G + c; if (L >= nwg) return false;
        int wgid = (int)L; { const int q = nwg / NXCD, r = nwg % NXCD, xcd = wgid % NXCD, off = wgid / NXCD; wgid = (xcd < r ? xcd * (q + 1) : r * (q + 1) + (xcd - r) * q) + off; }
        const int nig = WGM * nN, gid = wgid / nig, fm = gid * WGM, gsz = (nM - fm) < WGM ? (nM - fm) : WGM;
        u.pm = fm + ((wgid % nig) % gsz); u.pn = (wgid % nig) / gsz; return true;
    }
    __device__ __forceinline__ void a_ready(const Unit&) const {}
    __device__ __forceinline__ void done(const Unit&) const {}
};

constexpr int MP_ROWS = MP, MS_ROWS = MS, DM = D;
constexpr size_t BLK_KT = 32768, BLK_AI = 16384;
__host__ __device__ __forceinline__ constexpr int blk_img(int wr, int wcl, int m, int fr, int fq) { return ((4 * wr + m) * 2 + wcl) * 1024 + ((fr * 64 + fq * 16) ^ ((fr >> 3) << 5)); }
constexpr float NEPS = 1e-6f;
struct Args { const float* in[24]; float* out; unsigned char* ws; };
typedef const __attribute__((address_space(4))) Args* KArgs;
__device__ __forceinline__ KArgs KA() { KArgs p = (KArgs)__builtin_amdgcn_kernarg_segment_ptr(); asm volatile("" : "+s"(p)); return p; }
typedef float f32x2_e __attribute__((ext_vector_type(2))); typedef __bf16 bf16x2_e __attribute__((ext_vector_type(2)));
__device__ __forceinline__ unsigned cvt_pk_bf16(float lo, float hi) { f32x2_e v = {lo, hi}; bf16x2_e b = __builtin_convertvector(v, bf16x2_e); return __builtin_bit_cast(unsigned, b); }
__device__ __forceinline__ u32x4 pack8(const f32x4 v0, const f32x4 v1) { u32x4 w; w.x = cvt_pk_bf16(v0[0], v0[1]); w.y = cvt_pk_bf16(v0[2], v0[3]); w.z = cvt_pk_bf16(v1[0], v1[1]); w.w = cvt_pk_bf16(v1[2], v1[3]); return w; }
typedef __amdgpu_buffer_rsrc_t rsrc_t;
__device__ __forceinline__ rsrc_t mk_rsrc(const void* p, unsigned bytes) { return __builtin_amdgcn_make_buffer_rsrc((void*)p, 0, (int)bytes, 0x00020000); }
__device__ __forceinline__ f32x4 bld16(rsrc_t r, unsigned off) { return __builtin_bit_cast(f32x4, __builtin_amdgcn_raw_buffer_load_b128(r, (int)off, 0, 16)); }
__device__ __forceinline__ void bst16(rsrc_t r, unsigned off, u32x4 v, bool wt) { if (wt) __builtin_amdgcn_raw_buffer_store_b128(v, r, (int)off, 0, 16); else __builtin_amdgcn_raw_buffer_store_b128(v, r, (int)off, 0, 0); }
__device__ __forceinline__ void bst16(rsrc_t r, unsigned off, f32x4 v, bool wt) { bst16(r, off, __builtin_bit_cast(u32x4, v), wt); }
__device__ __forceinline__ void epi_tr(PG8_LAS unsigned char* slot, int fr, int fq, const u32x4 in0, const u32x4 in1, u32x4& out0, u32x4& out1) {
    const int lane = fq * 16 + fr, r = lane >> 3, c = lane & 7;
    asm volatile("" ::: "memory");
    *(PG8_LAS u32x4*)(slot + fr * 128 + ((fq ^ (fr & 7)) * 16)) = in0;
    *(PG8_LAS u32x4*)(slot + fr * 128 + (((4 + fq) ^ (fr & 7)) * 16)) = in1;
    asm volatile("s_waitcnt lgkmcnt(0)" ::: "memory");
    out0 = *(const PG8_LAS u32x4*)(slot + r * 128 + ((c ^ (r & 7)) * 16));
    out1 = *(const PG8_LAS u32x4*)(slot + (8 + r) * 128 + ((c ^ (r & 7)) * 16));
    asm volatile("s_waitcnt lgkmcnt(0)" ::: "memory");
}
template <int NAI> __device__ __forceinline__ void row_scales(const unsigned long long* ssqk, int row0, float (&rs)[NAI][4], const PG8_LAS unsigned long long* sl = nullptr, int lrow0 = 0) {
    unsigned long long raw[NAI][4];
    if (sl) {
#pragma unroll
        for (int ai = 0; ai < NAI; ++ai)
#pragma unroll
            for (int m = 0; m < 4; ++m) raw[ai][m] = sl[lrow0 + ai * HALF + m * 16];
    } else {
#pragma unroll
        for (int ai = 0; ai < NAI; ++ai)
#pragma unroll
            for (int m = 0; m < 4; ++m) raw[ai][m] = __hip_atomic_load(ssqk + row0 + ai * HALF + m * 16, __ATOMIC_RELAXED, __HIP_MEMORY_SCOPE_AGENT);
    }
#pragma unroll
    for (int ai = 0; ai < NAI; ++ai)
#pragma unroll
        for (int m = 0; m < 4; ++m) rs[ai][m] = 1.0f / sqrtf((float)raw[ai][m] * (SSQ_UNFIX / 1024.0f) + NEPS);
}

struct EpiRes {
    int last, kout, dry, wt;
    __device__ __forceinline__ void operator()(const f32x4 (&acc)[2][2][4][2], const Unit& u, int wr, int wc, int fr, int fq) const { run<2>(acc, u.pm * BM + wr * 64, u.pn, wc, fr, fq); }
    template <int NAI> __device__ __forceinline__ void run(const f32x4 (&acc)[NAI][2][4][2], int rowbase, int pn, int wc, int fr, int fq) const {
        KArgs ka = KA(); float* out = ka->out; unsigned char* ws = ka->ws; unsigned long long* ssq = (unsigned long long*)(ws + WS_SSQ) + (size_t)kout * MT;
        const rsrc_t rb = mk_rsrc(ws + WS_XB, MT * D * 2u);
        const rsrc_t ro = dry ? mk_rsrc(ws + WS_NXT, MT * D * 4u) : mk_rsrc(out, MT * D * 4u), rx = dry ? mk_rsrc(ws + WS_NXT + 68 * MiB, MT * D * 2u) : rb;
        const int row0 = rowbase + fr, col0 = pn * BM + wc * 32 + 8 * fq;
        const unsigned xo = (unsigned)(rowbase >> 8) * (256u * DM * 2u) + (unsigned)(4 * pn + (wc >> 1)) * (unsigned)BLK_KT + (unsigned)blk_img((rowbase >> 6) & 1, wc & 1, 0, fr, fq);
#pragma unroll
        for (int ai = 0; ai < NAI; ++ai) {
            u32x4 b[4][2];
#pragma unroll
            for (int m = 0; m < 4; ++m)
#pragma unroll
                for (int bj = 0; bj < 2; ++bj) b[m][bj] = __builtin_bit_cast(u32x4, bld16(rb, xo + (unsigned)(2 * bj * (int)BLK_KT + ai * (int)BLK_AI + m * 2048)));
#pragma unroll
            for (int m = 0; m < 4; ++m) {
                const int row = row0 + ai * HALF + m * 16; const unsigned eo = (unsigned)(row * DM + col0);
                float ss = 0.f;
#pragma unroll
                for (int bj = 0; bj < 2; ++bj) {
                    const u32x4 w = b[m][bj];
                    const f32x4 b0 = {__uint_as_float(w.x << 16), __uint_as_float(w.x & 0xffff0000u), __uint_as_float(w.y << 16), __uint_as_float(w.y & 0xffff0000u)};
                    const f32x4 b1 = {__uint_as_float(w.z << 16), __uint_as_float(w.z & 0xffff0000u), __uint_as_float(w.w << 16), __uint_as_float(w.w & 0xffff0000u)};
                    const f32x4 v0 = acc[ai][bj][m][0] + b0, v1 = acc[ai][bj][m][1] + b1;
                    if (last) { bst16(ro, (eo + bj * HALF) * 4u, v0, wt); bst16(ro, (eo + bj * HALF) * 4u + 16u, v1, wt); }
                    else bst16(rx, xo + (unsigned)(2 * bj * (int)BLK_KT + ai * (int)BLK_AI + m * 2048), pack8(v0, v1), wt);
                    ss += (v0[0] * v0[0] + v0[1] * v0[1]) + (v0[2] * v0[2] + v0[3] * v0[3]) + (v1[0] * v1[0] + v1[1] * v1[1]) + (v1[2] * v1[2] + v1[3] * v1[3]);
                }
                ss += __shfl_xor(ss, 16); ss += __shfl_xor(ss, 32);
                if (fq == 0) atomicAdd(ssq + row, (unsigned long long)(ss * SSQ_FIX));
            }
            asm volatile("" ::: "memory");
        }
    }
};

struct EpiUp {
    int kin, wt; const PG8_LAS unsigned long long* sl;
    __device__ __forceinline__ void operator()(const f32x4 (&acc)[2][2][4][2], const Unit& u, int wr, int wc, int fr, int fq) const { run<2>(acc, u.pm * BM + wr * 64, u.pn, wc, fr, fq); }
    template <int NAI> __device__ __forceinline__ void run(const f32x4 (&acc)[NAI][2][4][2], int rowbase, int pn, int wc, int fr, int fq) const {
        KArgs ka = KA(); unsigned char* ws = ka->ws; const unsigned long long* ssq = (const unsigned long long*)(ws + WS_SSQ) + (size_t)kin * MT;
        const rsrc_t rh = mk_rsrc(ws + WS_HID, MT * (unsigned)HIDP * 2u);
        const int row0 = rowbase + fr;
        const unsigned ho = (unsigned)(rowbase >> 8) * (256u * FF * 2u) + (unsigned)(4 * pn + (wc >> 1)) * (unsigned)BLK_KT + (unsigned)blk_img((rowbase >> 6) & 1, wc & 1, 0, fr, fq);
        float rs[NAI][4]; row_scales<NAI>(ssq, row0, rs, sl, (rowbase & 255) + fr);
#pragma unroll
        for (int ai = 0; ai < NAI; ++ai)
#pragma unroll
            for (int m = 0; m < 4; ++m) {
#pragma unroll
                for (int bj = 0; bj < 2; ++bj) {
                    f32x4 v0 = acc[ai][bj][m][0] * rs[ai][m], v1 = acc[ai][bj][m][1] * rs[ai][m];
#pragma unroll
                    for (int i = 0; i < 4; ++i) { const float a = fmaxf(v0[i], 0.f), b = fmaxf(v1[i], 0.f); v0[i] = a * a; v1[i] = b * b; }
                    bst16(rh, ho + (unsigned)(2 * bj * (int)BLK_KT + ai * (int)BLK_AI + m * 2048), pack8(v0, v1), wt);
                }
            }
    }
};

struct EpiQKV {
    int j, kin; const PG8_LAS unsigned long long* sl; PG8_LAS unsigned char* slot;
    __device__ __forceinline__ void operator()(const f32x4 (&acc)[2][2][4][2], const Unit& u, int wr, int wc, int fr, int fq) const { run<2>(acc, u.pm * BM + wr * 64, u.pn, wc, fr, fq); }
    template <int NAI> __device__ __forceinline__ void run(const f32x4 (&acc)[NAI][2][4][2], int rowbase, int pn, int wc, int fr, int fq) const {
        KArgs ka = KA(); unsigned char* ws = ka->ws; float* out = ka->out; const unsigned long long* ssq = (const unsigned long long*)(ws + WS_SSQ) + (size_t)kin * MT; const float* qg = ka->in[12] + j * 64; const float* kg = ka->in[13] + j * 64;
        bf16_t *Q = (bf16_t*)(ws + WS_Q), *KP = (bf16_t*)(ws + WS_KP), *VP = (bf16_t*)(ws + WS_VP), *RK = (bf16_t*)(ws + WS_RK), *RV = (bf16_t*)(ws + WS_RV);
        float *okp = out + O_KP + (size_t)j * 512 * DM, *ovp = out + O_VP + (size_t)j * 512 * DM, *oks = out + O_KS + (size_t)j * MS_ROWS * DM, *ovs = out + O_VS + (size_t)j * MS_ROWS * DM;
        const int t = pn >> 2, head = (pn & 3) * 4 + wc;
        const int row0 = rowbase + fr;
        float rs[NAI][4]; row_scales<NAI>(ssq, row0, rs, sl, (rowbase & 255) + fr);
        f32x4 g[2][2];
        const float* gp = (t == 0) ? qg : kg;
#pragma unroll
        for (int bj = 0; bj < 2; ++bj)
#pragma unroll
            for (int n = 0; n < 2; ++n) { g[bj][n] = (t < 2) ? *(const f32x4*)(gp + 32 * bj + 8 * fq + 4 * n) : (f32x4){1.f, 1.f, 1.f, 1.f}; if (t == 0) g[bj][n] = g[bj][n] * (0.125f * 1.4426950408889634f); }
#pragma unroll
        for (int ai = 0; ai < NAI; ++ai)
#pragma unroll
            for (int m = 0; m < 4; ++m) {
                const int row = row0 + ai * HALF + m * 16;
                f32x4 v[2][2]; float ss = 0.f;
#pragma unroll
                for (int bj = 0; bj < 2; ++bj)
#pragma unroll
                    for (int n = 0; n < 2; ++n) { v[bj][n] = acc[ai][bj][m][n] * rs[ai][m]; const f32x4 x = v[bj][n]; ss += (x[0] * x[0] + x[1] * x[1]) + (x[2] * x[2] + x[3] * x[3]); }
                if (t < 2) {
                    ss += __shfl_xor(ss, 16); ss += __shfl_xor(ss, 32);
                    const float rr = 1.0f / sqrtf(ss * (1.0f / 64.0f) + NEPS);
#pragma unroll
                    for (int bj = 0; bj < 2; ++bj)
#pragma unroll
                        for (int n = 0; n < 2; ++n) v[bj][n] = v[bj][n] * rr * g[bj][n];
                }
                {
                    u32x4 o0, o1; epi_tr(slot, fr, fq, pack8(v[0][0], v[0][1]), pack8(v[1][0], v[1][1]), o0, o1);
                    const int ln = fq * 16 + fr, col = head * 64 + (ln & 7) * 8;
#pragma unroll
                    for (int h = 0; h < 2; ++h) {
                        const int rw = rowbase + ai * HALF + m * 16 + 8 * h + (ln >> 3);
                        bf16_t* dstb;
                        if (t == 0) dstb = Q + (size_t)rw * DM + col;
                        else if (rw < MP_ROWS) dstb = (t == 1 ? KP : VP) + (size_t)rw * DM + col;
                        else { const int sr = rw - MP_ROWS, b = sr >> 6, tt = sr & 63; dstb = (t == 1 ? RK : RV) + ((size_t)b * 576 + 512 + tt) * DM + col; }
                        *(u32x4*)dstb = h ? o1 : o0;
                    }
                }
                if (t != 0 && (row >= MP_ROWS - 512)) {
#pragma unroll
                    for (int bj = 0; bj < 2; ++bj) {
                        const int col = head * 64 + 32 * bj + 8 * fq;
                        float* dstf;
                        if (row < MP_ROWS) dstf = (t == 1 ? okp : ovp) + (size_t)(row - (MP_ROWS - 512)) * DM + col;
                        else dstf = (t == 1 ? oks : ovs) + (size_t)(row - MP_ROWS) * DM + col;
                        *(f32x4*)dstf = v[bj][0]; *(f32x4*)(dstf + 4) = v[bj][1];
                    }
                }
            }
    }
};

struct EpiMIn {
    int j, kin; const PG8_LAS unsigned long long* sl; PG8_LAS unsigned char* slot;
    __device__ __forceinline__ void operator()(const f32x4 (&acc)[2][2][4][2], const Unit& u, int wr, int wc, int fr, int fq) const { run<2>(acc, u.pm * BM + wr * 64, u.pn, wc, fr, fq); }
    template <int NAI> __device__ __forceinline__ void run(const f32x4 (&acc)[NAI][2][4][2], int rowbase, int pn, int wc, int fr, int fq) const {
        KArgs ka = KA(); unsigned char* ws = ka->ws; float* out = ka->out; const unsigned long long* ssq = (const unsigned long long*)(ws + WS_SSQ) + (size_t)kin * MT; const float* b_i = ka->in[16] + j * 4; const float* b_f = ka->in[17] + j * 4;
        bf16_t *QKP = (bf16_t*)(ws + WS_QKP), *V = (bf16_t*)(ws + WS_V), *OG = (bf16_t*)(ws + WS_OG); float* gates = (float*)(ws + WS_GATES);
        float *ocp = out + O_BP + (size_t)j * 3 * 2048, *ocs = out + O_BS + (size_t)j * 16 * 3 * 2048;
        const int row0 = rowbase + fr, cl0 = wc * 32 + 8 * fq;
        if (pn == 16 && !(wc == 0 && fq == 0)) return;
        float rs[NAI][4]; row_scales<NAI>(ssq, row0, rs, sl, (rowbase & 255) + fr);
#pragma unroll
        for (int ai = 0; ai < NAI; ++ai)
#pragma unroll
            for (int m = 0; m < 4; ++m) {
                const int row = row0 + ai * HALF + m * 16;
                if (pn == 16) {
                    const f32x4 gi = acc[ai][0][m][0] * rs[ai][m] + *(const f32x4*)b_i, gf = acc[ai][0][m][1] * rs[ai][m] + *(const f32x4*)b_f;
                    f32x4 lf;
#pragma unroll
                    for (int i = 0; i < 4; ++i) lf[i] = fminf(gf[i], 0.f) - log1pf(expf(-fabsf(gf[i])));
                    *(f32x4*)(gates + (size_t)row * 8) = gi; *(f32x4*)(gates + (size_t)row * 8 + 4) = lf;
                    continue;
                }
                u32x4 wq[2];
#pragma unroll
                for (int bj = 0; bj < 2; ++bj) {
                    f32x4 v0 = acc[ai][bj][m][0] * rs[ai][m], v1 = acc[ai][bj][m][1] * rs[ai][m];
                    if (pn < 8) {
                        const int col = pn * BM + cl0 + bj * HALF;
                        float* dstf = nullptr;
                        if (row < MP_ROWS) { if (row >= MP_ROWS - 3) dstf = ocp + (size_t)(row - (MP_ROWS - 3)) * 2048 + col; }
                        else { const int sr = row - MP_ROWS, b = sr >> 6, tt = sr & 63; if (tt >= 61) dstf = ocs + ((size_t)b * 3 + (tt - 61)) * 2048 + col; }
                        if (dstf) { *(f32x4*)dstf = v0; *(f32x4*)(dstf + 4) = v1; }
                    } else if (pn >= 12) {
#pragma unroll
                        for (int i = 0; i < 4; ++i) { v0[i] = __builtin_amdgcn_rcpf(1.0f + __expf(-v0[i])); v1[i] = __builtin_amdgcn_rcpf(1.0f + __expf(-v1[i])); }
                    }
                    wq[bj] = pack8(v0, v1);
                }
                {
                    u32x4 o0, o1; epi_tr(slot, fr, fq, wq[0], wq[1], o0, o1);
                    const int ln = fq * 16 + fr, cl = wc * 32 + (ln & 3) * 8 + ((ln >> 2) & 1) * HALF;
                    bf16_t* dst = (pn < 8) ? QKP + (size_t)pn * BM + cl : (pn < 12) ? V + (size_t)(pn - 8) * BM + cl : OG + (size_t)(pn - 12) * BM + cl;
                    const int pitch = (pn < 8) ? 2048 : DM;
                    const int rw = rowbase + ai * HALF + m * 16 + (ln >> 3);
                    *(u32x4*)(dst + (size_t)rw * pitch) = o0; *(u32x4*)(dst + (size_t)(rw + 8) * pitch) = o1;
                }
            }
    }
};
}

namespace pg8 {
constexpr int CW_Q = 8192, CW_RDY = 16384;
struct UnitX { const char* A; const char* B; int K, lda, pm, pn, stage; };
__device__ __forceinline__ int chain_nn3(int chain) { return (chain == 4) ? 0 : ((chain & 1) ? 17 : 12); }
__device__ __forceinline__ int chain_scnt(int nN, int q) { return (4 * nN - q + 7) >> 3; }
__device__ __forceinline__ int chain_total(int chain, int q) {
    const int n3 = chain_nn3(chain), t3 = n3 ? chain_scnt(n3, q) + 8 * n3 : 0;
    return chain == 0 ? t3 : (2 + 32) + (8 + 128) + (2 + 32) + t3;
}
__device__ __forceinline__ void chain_decode(int chain, int q, int L, UnitX& u, int& need) {
    KArgs ka = KA(); const unsigned char* ws = ka->ws;
    int s, i, samp = 0;
    if (chain == 0) { s = 3; i = L; }
    else if (L < 34) { s = 0; i = L; samp = 2; }
    else if (L < 172) {
        const int x = L - 34;
        if (x < 56) { s = 1; i = x; samp = 8; } else if (x < 58) { s = 2; i = x - 56; samp = 2; } else { s = 1; i = x - 2; samp = 8; }
    }
    else if (L < 204) { s = 2; i = L - 172 + 2; samp = 2; }
    else { s = 3; i = L - 204; }
    const int l = chain - 1, lin = chain;
    int nN, K = 1024; const unsigned char *A, *B;
    if (s == 0)      { nN = 4;  A = ws + WS_MIX; B = ws + ((l & 1) ? WS_WOB : WS_WOA) + (size_t)(l >> 1) * 1024 * 1024 * 2; }
    else if (s == 1) { nN = 16; A = ws + WS_XB;  B = ws + WS_WUP + (size_t)l * 4096 * 1024 * 2; }
    else if (s == 2) { nN = 4;  A = ws + WS_HID; B = ws + WS_WDN + (size_t)l * HIDP * 1024 * 2; K = 4096; }
    else             { nN = (lin & 1) ? 17 : 12; A = ws + WS_XB; B = (lin & 1) ? ws + WS_WINB + (size_t)(lin >> 1) * 4352 * 1024 * 2 : ws + WS_WINA + (size_t)(lin >> 1) * 3072 * 1024 * 2; samp = chain_scnt(nN, q); }
    if (i < samp) { const int e = q + 8 * i, sp = e / nN; u.pm = 64 + sp; u.pn = e - sp * nN; }
    else { const int ip = i - samp, gsz = 4 * nN, g = ip >= gsz ? 1 : 0, r = ip - g * gsz; u.pm = q + 8 * (4 * g + (r & 3)); u.pn = r >> 2; }
    u.K = K; u.stage = s; u.lda = (s == 2) ? HIDP : K;
    u.A = (const char*)A + (size_t)u.pm * 256 * K * 2; u.B = (const char*)B + (size_t)u.pn * 256 * K * 2;
    need = (s == 1) ? 32 : (s == 2) ? 128 : (s == 3 && chain > 0) ? 32 : 0;
}
__device__ __forceinline__ int chain_kin(int chain, int stage, bool dry) { return stage == 1 ? (dry ? 6 : 2 * chain - 1) : (stage == 3 ? 2 * chain : -1); }
__device__ __forceinline__ void chain_epilogue(int chain, bool dry, bool wt, const PG8_LAS unsigned long long* sl, PG8_LAS unsigned char* slot, const UnitX& u, const f32x4 (&acc)[2][2][4][2], int wr, int wc, int fr, int fq) {
    const int rowbase = u.pm * BM + wr * 64;
    if (u.stage == 0 || u.stage == 2) { EpiRes E{(chain == 4 && u.stage == 2 && !dry) ? 1 : 0, dry ? 9 : 2 * chain - 1 + (u.stage >> 1), dry ? 1 : 0, wt ? 1 : 0}; E.run<2>(acc, rowbase, u.pn, wc, fr, fq); }
    else if (u.stage == 1) { EpiUp E{chain_kin(chain, 1, dry), wt ? 1 : 0, sl}; E.run<2>(acc, rowbase, u.pn, wc, fr, fq); }
    else if (chain & 1) { EpiMIn E{chain >> 1, 2 * chain, sl, slot}; E.run<2>(acc, rowbase, u.pn, wc, fr, fq); }
    else { EpiQKV E{chain >> 1, 2 * chain, sl, slot}; E.run<2>(acc, rowbase, u.pn, wc, fr, fq); }
}

__device__ __forceinline__ void gemm_chain(PG8_LAS unsigned char* lds, volatile PG8_LAS unsigned* bx  , PG8_LAS unsigned char* rslot  , PG8_LAS unsigned long long* sslot  , const int chain, const int cchain  , const bool safe  ) {
    int tid_ = threadIdx.x; asm volatile("" : "+v"(tid_));
    const int tid = tid_, wid = __builtin_amdgcn_readfirstlane(tid >> 6), lane = tid & 63, wr = wid >> 2, wc = wid & 3, fr = lane & 15, fq = lane >> 4;
    unsigned* const ctl = (unsigned*)KA()->ws;
    unsigned* const qw = ctl + CW_Q + 64 * 8 * cchain;
    unsigned* const rdy = ctl + CW_RDY + (size_t)cchain * 3 * 68 * 64;
#define CH_VOFF(LA_, BLK_, vA_, vB_) do { _Pragma("unroll") for (int i_ = 0; i_ < 2; ++i_) { int R_, C_; stage_rc(tid * 16 + i_ * 8192, R_, C_); const int Rb_ = (R_ & ~31) + perm32(R_ & 31); \
        vA_[i_] = (BLK_) ? (unsigned)(tid * 16 + i_ * 8192) : (unsigned)(R_ * (LA_) + C_) * 2u; vB_[i_] = (unsigned)(tid * 16 + i_ * 8192); (void)Rb_; } } while (0)
    const size_t kstep = (size_t)(BK * 2);
    const unsigned ldsw = (unsigned)wid * 1024u;
    const int aoff = lds_byte(wr * 64 + fr, fq * 8), boff = lds_byte(wc * 32 + fr, fq * 8);
#ifndef PG8_A_AUX
#define PG8_A_AUX 16
#endif
#define PG8_SA(b, h) (((b) * 2 + (h)) * HTB)
#define PG8_SB(b, h) ((4 + (b) * 2 + (h)) * HTB)
#define PG8_STAGE_A(bufoff, gbase, voff) do { _Pragma("unroll") for (int _i = 0; _i < 2; ++_i) \
        __builtin_amdgcn_global_load_lds((const unsigned*)((const char*)(gbase) + (voff)[_i]), (PG8_LAS unsigned*)(lds + (bufoff) + ldsw + _i * 8192), 16, 0, PG8_A_AUX); } while (0)
#define PG8_STAGE_B(bufoff, gbase, voff) do { _Pragma("unroll") for (int _i = 0; _i < 2; ++_i) \
        __builtin_amdgcn_global_load_lds((const unsigned*)((const char*)(gbase) + (voff)[_i]), (PG8_LAS unsigned*)(lds + (bufoff) + ldsw + _i * 8192), 16, 0, 0); } while (0)
#define PG8_LDA(dst, b, h) do { _Pragma("unroll") for (int m = 0; m < 4; ++m) _Pragma("unroll") for (int k = 0; k < 2; ++k) dst[m][k] = *(const PG8_LAS bf16x8*)(lds + PG8_SA(b, h) + aoff + m * 2048 + k * 1024); } while (0)
#define PG8_LDB(dst, b, h) do { _Pragma("unroll") for (int n = 0; n < 2; ++n) _Pragma("unroll") for (int k = 0; k < 2; ++k) dst[n][k] = *(const PG8_LAS bf16x8*)(lds + PG8_SB(b, h) + boff + n * 2048 + k * 1024); } while (0)
#define PG8_MMA(ai, bj, At, Bt) do { __builtin_amdgcn_s_setprio(1); _Pragma("unroll") for (int m = 0; m < 4; ++m) _Pragma("unroll") for (int n = 0; n < 2; ++n) _Pragma("unroll") for (int k = 0; k < 2; ++k) \
        acc[ai][bj][m][n] = __builtin_amdgcn_mfma_f32_16x16x32_bf16(Bt[n][k], At[m][k], acc[ai][bj][m][n], 0, 0, 0); __builtin_amdgcn_s_setprio(0); } while (0)
#define PG8_WAIT_V(n) asm volatile("s_waitcnt vmcnt(" #n ")" ::: "memory")
#define PG8_WAIT_L(n) asm volatile("s_waitcnt lgkmcnt(" #n ")" ::: "memory")
#define PG8_BAR __builtin_amdgcn_s_barrier()
#define PG8_SCHED __builtin_amdgcn_sched_barrier(0)
#define PG8_ZERO_ACC() do { _Pragma("unroll") for (int a = 0; a < 2; ++a) _Pragma("unroll") for (int b = 0; b < 2; ++b) _Pragma("unroll") for (int m = 0; m < 4; ++m) _Pragma("unroll") for (int n = 0; n < 2; ++n) acc[a][b][m][n] = (f32x4){0.f, 0.f, 0.f, 0.f}; } while (0)
    unsigned pend = 0u; int par = 0, need_n = 0, upar = 0;
#define CH_SSQ(u) do { upar ^= 1; const int k_ = chain_kin(chain, u.stage, cchain != chain); if (k_ >= 0 && wid == 1) { const unsigned long long* s_ = (const unsigned long long*)(KA()->ws + WS_SSQ) + (size_t)k_ * MT + u.pm * 256 + 2 * lane; \
        _Pragma("unroll") for (int i_ = 0; i_ < 2; ++i_) __builtin_amdgcn_global_load_lds((const unsigned*)(s_ + 128 * i_), (PG8_LAS unsigned*)(sslot + 256 * upar + 128 * i_), 16, 0, 16); } } while (0)
    int qown = (int)(__builtin_amdgcn_s_getreg((3 << 11) | 20) & 7u);
    const int maxsteal = safe ? 7 : 0;
    int qcur = qown, qtried = 0;
#ifndef CH_POP_ASM
#define CH_POP_ASM 0
#endif
#if CH_POP_ASM
#define CH_POP_ISSUE() do { if (wid == 0) { unsigned one_ = 1u; const unsigned* qa_ = qw + 64 * qcur; asm volatile("global_atomic_add %0, %1, %2, off sc0" : "=v"(pend) : "v"(qa_), "v"(one_) : "memory"); } } while (0)
#define CH_POP_WAIT() asm volatile("s_waitcnt vmcnt(8)" : "+v"(pend) :: "memory")
#else
#define CH_POP_ISSUE() do { if (wid == 0 && lane == 0) pend = __hip_atomic_fetch_add(qw + 64 * qcur, 1u, __ATOMIC_RELAXED, __HIP_MEMORY_SCOPE_AGENT); } while (0)
#define CH_POP_WAIT() do {} while (0)
#endif
#ifdef PROBE_NODEP
#define PROBE_NODEP_HOOK() do { if (cchain != chain) need_n = 0; } while (0)
#else
#define PROBE_NODEP_HOOK() do {} while (0)
#endif
#define CH_POP_TAKE(u, ok) do { \
        if (wid == 0) { CH_POP_WAIT(); unsigned L_ = (unsigned)__builtin_amdgcn_readfirstlane((int)pend); int q_ = qcur; \
            while (L_ >= (unsigned)chain_total(chain, q_) && qtried < maxsteal) { ++qtried; qcur = (qcur + 1) & 7; q_ = qcur; \
                unsigned t_ = 0u; if (lane == 0) t_ = __hip_atomic_fetch_add(qw + 64 * q_, 1u, __ATOMIC_RELAXED, __HIP_MEMORY_SCOPE_AGENT); L_ = (unsigned)__builtin_amdgcn_readfirstlane((int)t_); } \
            if (lane == 0) { bx[par * 2] = L_; bx[par * 2 + 1] = (unsigned)q_; } } \
        asm volatile("s_waitcnt lgkmcnt(0)\n\ts_barrier" ::: "memory"); \
        const int Lb_ = __builtin_amdgcn_readfirstlane((int)bx[par * 2]), qb_ = __builtin_amdgcn_readfirstlane((int)bx[par * 2 + 1]); par ^= 1;     ok = Lb_ < chain_total(chain, qb_); \
        if (ok) { chain_decode(chain, qb_, Lb_, u, need_n); PROBE_NODEP_HOOK(); \
            if (need_n && wid == 0) __builtin_amdgcn_global_load_lds(rdy + (size_t)((u.stage - 1) * 68 + u.pm) * 64, (PG8_LAS unsigned*)(rslot + 256 * par), 4, 0, 16); } } while (0)
#define CH_READY(u) do { if (need_n) { \
        if (wid == 0) { unsigned c_ = 0u, sp_ = 0u; \
            for (;;) { c_ = (unsigned)__builtin_amdgcn_readfirstlane((int)__hip_atomic_load(rdy + (size_t)((u.stage - 1) * 68 + u.pm) * 64, __ATOMIC_RELAXED, __HIP_MEMORY_SCOPE_AGENT)); \
                if (c_ >= (unsigned)need_n || ++sp_ > (1u << 20)) break; __builtin_amdgcn_s_sleep(2); } } \
        asm volatile("" ::: "memory"); __builtin_amdgcn_s_barrier(); asm volatile("" ::: "memory"); } } while (0)
#ifdef PROBE_UPOK
#define PROBE_TRY(u, ok) do { if (u.stage == 1) ok = true; } while (0)
#else
#define PROBE_TRY(u, ok) do {} while (0)
#endif
#define CH_TRY(u, ok) do { ok = true; if (need_n) { \
        const unsigned c_ = (unsigned)__builtin_amdgcn_readfirstlane((int)*(volatile PG8_LAS unsigned*)(rslot + 256 * par)); ok = c_ >= (unsigned)need_n; PROBE_TRY(u, ok); } } while (0)
#ifdef PROBE_NODRAIN
#define CH_DRAIN() do {} while (0)
#else
#define CH_DRAIN() asm volatile("s_waitcnt vmcnt(0)" ::: "memory")
#endif
#define CH_DONE(u) do { if (u.stage < 3 && !(chain == 4 && u.stage == 2)) { CH_DRAIN();        \
        if (lane == 0) __hip_atomic_fetch_add(rdy + (size_t)(u.stage * 68 + u.pm) * 64, 1u, __ATOMIC_RELAXED, __HIP_MEMORY_SCOPE_AGENT); } } while (0)

    UnitX cur, nxt; bool have;
    CH_POP_ISSUE(); asm volatile("s_waitcnt vmcnt(0)" : "+v"(pend) :: "memory"); CH_POP_TAKE(cur, have);
    if (!have) return;
    f32x4 acc[2][2][4][2];
    bf16x8 At[4][2], B0[2][2], B1[2][2];
    for (;;) {
        PG8_ZERO_ACC();
        const char* cA = cur.A; const char* cB = cur.B;
#define KST(blk_) ((blk_) ? (unsigned)BLK_KT : (unsigned)(BK * 2))
#define HA(blk_, la_) ((blk_) ? (unsigned)BLK_AI : ((unsigned)(la_) << 8))
#define HB(la_) ((unsigned)BLK_AI)
        bool cblk = cur.stage != 0;
        unsigned voffA[2], voffB[2];
        CH_VOFF(cur.lda, cblk, voffA, voffB);
        CH_READY(cur);
        CH_SSQ(cur);
        PG8_STAGE_B(PG8_SB(0, 0), cB, voffB); PG8_STAGE_B(PG8_SB(0, 1), cB + HB(cur.lda), voffB); PG8_STAGE_A(PG8_SA(0, 0), cA, voffA); PG8_STAGE_A(PG8_SA(0, 1), cA + HA(cblk, cur.lda), voffA);
        if (wr == 1) PG8_BAR;
        PG8_WAIT_V(2); PG8_BAR;
        PG8_STAGE_B(PG8_SB(1, 0), cB + BLK_KT, voffB); PG8_STAGE_A(PG8_SA(1, 0), cA + KST(cblk), voffA); PG8_STAGE_B(PG8_SB(1, 1), cB + HB(cur.lda) + BLK_KT, voffB);
        PG8_WAIT_V(6); PG8_BAR;
        bool brk = false;
        for (;;) {
            bool chainon = false;
            const char* nA = cA; const char* nB = cB;
            int nLA = cur.lda; bool nblk = cblk;
            const int nt = cur.K / BK;
#ifdef PROBE_TIME
#define PT_NOW(v_) do { v_ = PROBE_TIME == 1 ? __builtin_amdgcn_s_memrealtime() : __builtin_amdgcn_s_memtime(); asm volatile("s_waitcnt lgkmcnt(0)" : "+s"(v_) :: "memory"); } while (0)
            const bool ptm_ = wid == 0 && __builtin_amdgcn_workgroup_id_x() == PROBE_WG && (PROBE_STAGE < 0 || cur.stage == PROBE_STAGE) && chain == PROBE_CH && cchain == chain;
            unsigned long long pt0_ = 0; if (ptm_ && PROBE_SEG == 1) PT_NOW(pt0_);
#endif
            for (int t = 0; t < nt; t += 2) {
                if (t == nt - 6) CH_POP_ISSUE();
                if (t == nt - 4) { bool has_next; CH_POP_TAKE(nxt, has_next);
                    brk = has_next && nxt.pm == cur.pm && nxt.stage == cur.stage + 1;
                    chainon = has_next && !brk;
                    if (chainon) { nA = nxt.A; nB = nxt.B; nLA = nxt.lda; nblk = nxt.stage != 0; } }
                const bool last = (t == nt - 2);
                if (last && chainon) { bool ok_; CH_TRY(nxt, ok_);
                    if (!ok_) { chainon = false; brk = true; nA = cA; nB = cB; nLA = cur.lda; nblk = cblk; } }
                const unsigned kstA = KST(cblk), hA = HA(cblk, cur.lda);
                const char* a1 = cA + (size_t)((unsigned)(t + 1) * kstA);
                const char* a2 = last ? nA : cA + (size_t)((unsigned)(t + 2) * kstA); const char* b2 = last ? nB : cB + (size_t)(t + 2) * BLK_KT;
                const char* a3 = a2 + (last ? KST(nblk) : kstA); const char* b3 = b2 + BLK_KT;
                const unsigned h2A = last ? HA(nblk, nLA) : hA, h2B = last ? HB(nLA) : HB(cur.lda);
                unsigned vA2[2], vB2[2];
                if (last) CH_VOFF(nLA, nblk, vA2, vB2);
                else {
#pragma unroll
                    for (int i = 0; i < 2; ++i) { vA2[i] = voffA[i]; vB2[i] = voffB[i]; } }
                PG8_LDB(B0, 0, 0); PG8_LDB(B1, 0, 1); PG8_SCHED; PG8_LDA(At, 0, 0); PG8_STAGE_A(PG8_SA(1, 1), a1 + hA, voffA);
                PG8_WAIT_V(8); PG8_WAIT_L(0); PG8_BAR; PG8_MMA(0, 0, At, B0); PG8_MMA(0, 1, At, B1); PG8_BAR; PG8_SCHED;
                PG8_LDA(At, 0, 1); PG8_STAGE_B(PG8_SB(0, 0), b2, vB2); PG8_STAGE_B(PG8_SB(0, 1), b2 + h2B, vB2); PG8_STAGE_A(PG8_SA(0, 0), a2, vA2);
                PG8_WAIT_V(8); PG8_WAIT_L(0); PG8_BAR; PG8_MMA(1, 0, At, B0); PG8_MMA(1, 1, At, B1); PG8_BAR; PG8_SCHED;
                PG8_LDB(B0, 1, 0); PG8_LDB(B1, 1, 1); PG8_SCHED; PG8_LDA(At, 1, 0); PG8_STAGE_A(PG8_SA(0, 1), a2 + h2A, vA2);
                PG8_WAIT_V(8); PG8_WAIT_L(0); PG8_BAR; PG8_MMA(0, 0, At, B0); PG8_MMA(0, 1, At, B1); PG8_BAR; PG8_SCHED;
                PG8_LDA(At, 1, 1); PG8_STAGE_B(PG8_SB(1, 0), b3, vB2); PG8_STAGE_B(PG8_SB(1, 1), b3 + h2B, vB2); PG8_STAGE_A(PG8_SA(1, 0), a3, vA2);
                PG8_WAIT_V(8); PG8_WAIT_L(0); PG8_BAR; PG8_MMA(1, 0, At, B0); PG8_MMA(1, 1, At, B1); PG8_BAR; PG8_SCHED;
            }
#ifdef PROBE_TIME
            if (ptm_) { if (PROBE_SEG == 1) { unsigned long long pt1_; PT_NOW(pt1_); if (lane == 0) bx[44] = bx[44] + (unsigned)(pt1_ - pt0_); }
                if (lane == 0) bx[45] = bx[45] + (unsigned)nt; }
#endif
            if (wr == 0) PG8_BAR;
#ifdef PROBE_TIME
            if (ptm_ && PROBE_SEG == 2) PT_NOW(pt0_);
#endif
#ifdef PROBE_NOEPI
            if (cchain != chain) { _Pragma("unroll") for (int a_ = 0; a_ < 2; ++a_) _Pragma("unroll") for (int b_ = 0; b_ < 2; ++b_) _Pragma("unroll") for (int m_ = 0; m_ < 4; ++m_)
                asm volatile("" :: "v"(acc[a_][b_][m_][0]), "v"(acc[a_][b_][m_][1])); }
            else
#endif
#ifdef PROBE_ST
            if (cchain != chain) {
                const rsrc_t rq_ = mk_rsrc(KA()->ws + WS_MIX, MT * 1024u * 2u);
                const unsigned qo_ = (PROBE_ST == 1 ? (unsigned)(cur.pm * 256 + wr * 64 + fr) * 1024u + (cur.pn & 3) * 256 + wc * 32 + 8 * fq : (unsigned)((cur.pm * 4 + (cur.pn & 3)) * 8 + wid) * 8192u + lane * 8) * 2u;
                _Pragma("unroll") for (int a_ = 0; a_ < 2; ++a_) _Pragma("unroll") for (int m_ = 0; m_ < 4; ++m_) _Pragma("unroll") for (int b_ = 0; b_ < 2; ++b_) {
                    const u32x4 w_ = pack8(acc[a_][b_][m_][0], acc[a_][b_][m_][1]);
                    bst16(rq_, qo_ + 2u * (PROBE_ST == 1 ? (a_ * 128 + m_ * 16) * 1024 + b_ * 128 : (a_ * 8 + m_ * 2 + b_) * 512), w_, false);
                }
            } else
#endif
            chain_epilogue(chain, cchain != chain, safe || cur.pm >= 64, sslot + 256 * upar, lds + (EPITR_OFF - RING_OFF) + wid * 2048, cur, acc, wr, wc, fr, fq);
            CH_DONE(cur);
#ifdef PROBE_TIME
            if (ptm_ && PROBE_SEG == 2) { unsigned long long pt1_; PT_NOW(pt1_); if (lane == 0) bx[44] = bx[44] + (unsigned)(pt1_ - pt0_); }
#endif
            if (!chainon) break;
            PG8_ZERO_ACC();
            cur = nxt; cA = nA; cB = nB; cblk = nblk;
            CH_VOFF(cur.lda, cblk, voffA, voffB);
            CH_SSQ(cur);
            if (wr == 1) PG8_BAR;
        }
        PG8_WAIT_V(0);
        PG8_BAR;
        if (!brk) break;
        cur = nxt;
    }
#undef PG8_SA
#undef PG8_SB
#undef PG8_STAGE_A
#undef PG8_STAGE_B
#undef PG8_LDA
#undef PG8_LDB
#undef PG8_MMA
#undef PG8_WAIT_V
#undef PG8_WAIT_L
#undef PG8_BAR
#undef PG8_SCHED
#undef PG8_ZERO_ACC
#undef CH_POP_ISSUE
#undef CH_POP_WAIT
#undef CH_POP_TAKE
#undef CH_VOFF
#undef CH_SSQ
#undef CH_TRY
#undef KST
#undef HA
#undef HB
#undef CH_READY
#undef CH_DONE
}
}

#define GAS __attribute__((address_space(1)))
#define LAS __attribute__((address_space(3)))
typedef unsigned short bf16;
typedef unsigned v4u __attribute__((ext_vector_type(4)));
typedef float f32x4 __attribute__((ext_vector_type(4)));
typedef short bf16x8 __attribute__((ext_vector_type(8)));
typedef GAS unsigned gu32;
typedef GAS unsigned long long gu64;
#define RLX_AGENT __ATOMIC_RELAXED, __HIP_MEMORY_SCOPE_AGENT
#define LDS_WAIT() asm volatile("s_waitcnt lgkmcnt(0)" ::: "memory")
#define VM_WAIT() asm volatile("s_waitcnt vmcnt(0)" ::: "memory")
__device__ __forceinline__ unsigned long long rt() { return __builtin_amdgcn_s_memrealtime(); }
__device__ __forceinline__ unsigned f2bf(float f) { unsigned u = __builtin_bit_cast(unsigned, f); return (u + 0x7fffu + ((u >> 16) & 1u)) >> 16; }
typedef float f32x2_t __attribute__((ext_vector_type(2))); typedef __bf16 bf16x2_t __attribute__((ext_vector_type(2)));
__device__ __forceinline__ unsigned pk2(float lo, float hi) { f32x2_t v = {lo, hi}; bf16x2_t b = __builtin_convertvector(v, bf16x2_t); return __builtin_bit_cast(unsigned, b); }

#define XB_TMO      128
#define XB_XCNT(j)  (256  + 64 * (j))
#define XB_XSUB(j)  (1280 + 64 * (j))
#define XB_XGEN(j)  (2304 + 64 * (j))
#define XB_TOP      3328
#define XB_TOPGEN   3392
#define XCD_BAR_WORDS 3456
#define XB_SPIN_CAP (1u << 18)

__device__ __forceinline__ unsigned xb_ld(unsigned* p)              { return __hip_atomic_load(p, __ATOMIC_RELAXED, __HIP_MEMORY_SCOPE_AGENT); }
__device__ __forceinline__ unsigned xb_add(unsigned* p, unsigned v) { return __hip_atomic_fetch_add(p, v, __ATOMIC_RELAXED, __HIP_MEMORY_SCOPE_AGENT); }
__device__ __forceinline__ unsigned xb_xcc_id() { return (unsigned)__builtin_amdgcn_s_getreg((3 << 11) | 20) & 0xFu; }
#define XB_SPIN(cond, bar) do { unsigned _sp = 0; while (cond) { __builtin_amdgcn_s_sleep(1); \
    if ((++_sp & 255u) == 0u) { if (xb_ld(&(bar)[XB_TMO])) break; if (_sp > XB_SPIN_CAP) { atomicAdd(&(bar)[XB_TMO], 1u); break; } } } } while (0)

struct XcdBarrier {
    unsigned* bar; unsigned x;
    volatile LAS unsigned* st;
};

__device__ __forceinline__ XcdBarrier xcd_barrier_post(unsigned* bar, volatile LAS unsigned* st) {
    XcdBarrier b; b.bar = bar; b.x = (unsigned)__builtin_amdgcn_readfirstlane((int)xb_xcc_id()); b.st = st;
    if (threadIdx.x == 0) (void)xb_add(&bar[XB_XCNT(b.x)], 1u);
    return b;
}
__device__ __forceinline__ void xcd_barrier_complete(unsigned* bar, unsigned x, unsigned& nloc, unsigned& nx) {
    const unsigned G = gridDim.x * gridDim.y * gridDim.z;
    unsigned sum, cnt, mine, sp = 0u;
    for (;;) {
        sum = 0u; cnt = 0u; mine = 0u;
#pragma unroll
        for (unsigned j = 0; j < 16; ++j) { const unsigned c = xb_ld(&bar[XB_XCNT(j)]); sum += c; cnt += (c > 0u) ? 1u : 0u; mine = (j == x) ? c : mine; }
        if (sum == G) break;
        __builtin_amdgcn_s_sleep(1);
        if ((++sp & 255u) == 0u) { if (xb_ld(&bar[XB_TMO])) break; if (sp > XB_SPIN_CAP) { atomicAdd(&bar[XB_TMO], 1u); break; } }
    }
    nloc = mine > 0u ? mine : 1u; nx = cnt > 0u ? cnt : 1u;
}

__device__ __forceinline__ void xcd_barrier(const XcdBarrier& b) {
    asm volatile("s_waitcnt vmcnt(0)" ::: "memory");
    __syncthreads();
    if (threadIdx.x == 0) {
        unsigned* bar = b.bar;
        __builtin_amdgcn_s_waitcnt(0);
        unsigned nloc = b.st[0], nx = b.st[1];
        if (nloc == 0u) { xcd_barrier_complete(bar, b.x, nloc, nx); b.st[0] = nloc; b.st[1] = nx; }
        const unsigned old = xb_add(&bar[XB_XSUB(b.x)], 1u);
        const unsigned gen = old / nloc;
        if (old + 1u == (gen + 1u) * nloc) {
            __builtin_amdgcn_fence(__ATOMIC_RELEASE, "agent");
            asm volatile("s_waitcnt vmcnt(0)" ::: "memory");
            const unsigned og = xb_add(&bar[XB_TOP], 1u);
            const unsigned tg = og / nx;
            if (og + 1u == (tg + 1u) * nx) xb_add(&bar[XB_TOPGEN], 1u);
            else XB_SPIN(xb_ld(&bar[XB_TOPGEN]) == tg, bar);
            __builtin_amdgcn_fence(__ATOMIC_ACQUIRE, "agent");
            xb_add(&bar[XB_XGEN(b.x)], 1u);
            asm volatile("s_waitcnt vmcnt(0)" ::: "memory");
        } else {
            XB_SPIN(xb_ld(&bar[XB_XGEN(b.x)]) == gen, bar);
            __builtin_amdgcn_fence(__ATOMIC_ACQUIRE, "agent");
            asm volatile("s_waitcnt vmcnt(0)" ::: "memory");
        }
    }
    __syncthreads();
}
typedef unsigned v2u __attribute__((ext_vector_type(2)));
typedef float f32x16 __attribute__((ext_vector_type(16)));
typedef short s16x4 __attribute__((ext_vector_type(4)));
#define WAIT_ALL_BAR() asm volatile("s_waitcnt vmcnt(0) lgkmcnt(0)\n\ts_barrier" ::: "memory")
__device__ __forceinline__ float bflo(unsigned w) { return __builtin_bit_cast(float, w << 16); }
__device__ __forceinline__ float bfhi(unsigned w) { return __builtin_bit_cast(float, w & 0xffff0000u); }
__device__ __forceinline__ void glds16(const void* gsrc, unsigned lds_dst) { unsigned keep;
    asm volatile("s_mov_b32 %0, m0\n\ts_mov_b32 m0, %2\n\ts_nop 0\n\tglobal_load_lds_dwordx4 %1, off\n\ts_mov_b32 m0, %0" : "=&s"(keep) : "v"(gsrc), "s"(lds_dst) : "memory"); }
typedef short v4i16_t __attribute__((ext_vector_type(4)));
__device__ __forceinline__ s16x4 vtr(const LAS unsigned char* p) { return __builtin_bit_cast(s16x4, __builtin_amdgcn_ds_read_tr16_b64_v4i16((LAS v4i16_t*)p)); }
#define LBAR() asm volatile("s_waitcnt lgkmcnt(0)\n\ts_barrier" ::: "memory")

struct Frame {
    LAS unsigned char* lds;
    volatile LAS unsigned* MISC;
    gu32* ctl;
    int tid, lane, wave, vcu, G;
};
using pg8::Args; using pg8::KArgs; using pg8::KA;

__device__ __forceinline__ float wave_sum(float v) {
#pragma unroll
    for (int o = 1; o < 64; o <<= 1) v += __shfl_xor(v, o);
    return v;
}
__device__ __forceinline__ void p0_transpose_item(const float* W, int K, int N, bf16* WT, int drow0, const float* g, LAS float* scr, int k0, int n0, int lane, int ldt) {
    const int n4 = 4 * (lane & 7), kr = lane >> 3; const bool ok = (n0 + n4) < N;
    f32x4 wv[8]; float gv[8];
#pragma unroll
    for (int i = 0; i < 8; ++i) { const int kk = 8 * i + kr; wv[i] = *(const GAS f32x4*)(W + (size_t)(k0 + kk) * N + (ok ? n0 + n4 : 0)); gv[i] = g ? g[k0 + kk] : 1.f; }
#pragma unroll
    for (int i = 0; i < 8; ++i) { const int kk = 8 * i + kr; const f32x4 x = ok ? wv[i] * gv[i] : (f32x4){0.f, 0.f, 0.f, 0.f};
        scr[kk * 33 + n4] = x[0]; scr[kk * 33 + n4 + 1] = x[1]; scr[kk * 33 + n4 + 2] = x[2]; scr[kk * 33 + n4 + 3] = x[3]; }
    LDS_WAIT(); asm volatile("" ::: "memory");
    const int c = lane & 7;
#pragma unroll
    for (int j = 0; j < 4; ++j) { const int nn = (lane >> 3) + 8 * j; const LAS float* s = scr + (8 * c) * 33 + nn;
        v4u o; o.x = pk2(s[0 * 33], s[1 * 33]); o.y = pk2(s[2 * 33], s[3 * 33]); o.z = pk2(s[4 * 33], s[5 * 33]); o.w = pk2(s[6 * 33], s[7 * 33]);
        const int nl = (drow0 & 255) + nn, rb = nl & 127, R = (rb & ~31) + 16 * ((nn >> 2) & 1) + 4 * (nn >> 3) + (nn & 3), ob = (R & 15) * 64 + (c & 3) * 16;
        *(GAS v4u*)((GAS unsigned char*)WT + ((size_t)((drow0 >> 8) * (ldt >> 6) + (k0 >> 6)) * 2 + (nl >> 7)) * 16384 + ((R >> 4) * 2 + (c >> 2)) * 1024 + (ob ^ (((ob >> 9) & 1) << 5))) = o; }
    LDS_WAIT(); asm volatile("" ::: "memory");
}
__device__ __forceinline__ void row_to_bf16(const float* xrow, bf16* orow, unsigned long long* ssq16, int lane) {
    const GAS f32x4* xr = (const GAS f32x4*)xrow + lane;
    f32x4 v[4]; float s = 0.f;
#pragma unroll
    for (int j = 0; j < 4; ++j) { v[j] = xr[64 * j]; s += (v[j].x * v[j].x + v[j].y * v[j].y) + (v[j].z * v[j].z + v[j].w * v[j].w); }
    GAS unsigned long long* o8 = (GAS unsigned long long*)orow + lane;
#pragma unroll
    for (int j = 0; j < 4; ++j) o8[64 * j] = (unsigned long long)pk2(v[j].x, v[j].y) | ((unsigned long long)pk2(v[j].z, v[j].w) << 32);
    if (ssq16) { s = wave_sum(s); if (lane == 0) ssq16[0] = (unsigned long long)(s * SSQ_FIX); }
}
__device__ __forceinline__ void p0_prologue(Frame& F) {
    KArgs ka = KA();
    LAS float* scr = (LAS float*)(F.lds + RING_OFF + F.wave * 16384);
    const int gw = F.vcu * NWAVES + F.wave, NGW = F.G * NWAVES;
    unsigned char* ws = ka->ws;
    constexpr int NITEMS = 2 * 1536 + 2 * 512 + 2 * 2176 + 2 * 512 + 4 * 2048 + 4 * 2048;
    for (int it = gw; it < NITEMS; it += NGW) {
        int r = it; const float* W; const float* g = nullptr; bf16* WT; int K = 1024, N, nnb, ldt = 1024; bool perm = false;
        if (r < 3072) { const int j = r / 1536; r -= j * 1536; W = ka->in[10] + (size_t)j * 1024 * 3072; N = 3072; nnb = 96; WT = (bf16*)(ws + WS_WINA) + (size_t)j * 3072 * 1024; g = ka->in[8] + (2 * j) * 1024; perm = true; }
        else if ((r -= 3072) < 1024) { const int j = r / 512; r -= j * 512; W = ka->in[11] + (size_t)j * 1024 * 1024; N = 1024; nnb = 32; WT = (bf16*)(ws + WS_WOA) + (size_t)j * 1024 * 1024; }
        else if ((r -= 1024) < 4352) { const int j = r / 2176; r -= j * 2176; W = ka->in[15] + (size_t)j * 1024 * NMIN_REAL; N = NMIN_REAL; nnb = 136; WT = (bf16*)(ws + WS_WINB) + (size_t)j * NMIN * 1024; g = ka->in[8] + (2 * j + 1) * 1024; }
        else if ((r -= 4352) < 1024) { const int j = r / 512; r -= j * 512; W = ka->in[21] + (size_t)j * 1024 * 1024; N = 1024; nnb = 32; WT = (bf16*)(ws + WS_WOB) + (size_t)j * 1024 * 1024; }
        else if ((r -= 1024) < 8192) { const int j = r / 2048; r -= j * 2048; W = ka->in[22] + (size_t)j * 1024 * 4096; N = 4096; nnb = 128; WT = (bf16*)(ws + WS_WUP) + (size_t)j * 4096 * 1024; g = ka->in[9] + j * 1024; }
        else { r -= 8192; const int j = r / 2048; r -= j * 2048; W = ka->in[23] + (size_t)j * 4096 * 1024; N = 1024; nnb = 32; K = 4096; ldt = 4096; WT = (bf16*)(ws + WS_WDN) + (size_t)j * 1024 * HIDP; }
        const int kb = r / nnb, nb = r % nnb, n0 = 32 * nb;
        int drow0 = n0;
        if (perm) { const int tile = n0 >> 8, rr = n0 & 255, wc = rr >> 6, bj = (rr & 63) >> 5; drow0 = 256 * tile + 128 * bj + 32 * wc; }
        p0_transpose_item(W, K, N, WT, drow0, g, scr, 64 * kb, n0, F.lane, ldt);
    }
    bf16* XB = (bf16*)(ws + WS_XB); unsigned long long* SSQ = (unsigned long long*)(ws + WS_SSQ);
    for (int m = gw; m < MT; m += NGW) {
        const float* xr = (m < MP) ? ka->in[0] + (size_t)m * D : ka->in[1] + (size_t)(m - MP) * D;
        const int r = m & 255; float s = 0.f;
        unsigned char* pb = (unsigned char*)XB + (size_t)(m >> 8) * (256 * D * 2) + (size_t)(r >> 7) * pg8::BLK_AI;
#pragma unroll
        for (int h = 0; h < 2; ++h) {
            const int g = F.lane + 64 * h;
            const f32x4 v0 = *(const GAS f32x4*)(xr + 8 * g), v1 = *(const GAS f32x4*)(xr + 8 * g + 4);
            s += ((v0.x * v0.x + v0.y * v0.y) + (v0.z * v0.z + v0.w * v0.w)) + ((v1.x * v1.x + v1.y * v1.y) + (v1.z * v1.z + v1.w * v1.w));
            v4u o; o.x = pk2(v0.x, v0.y); o.y = pk2(v0.z, v0.w); o.z = pk2(v1.x, v1.y); o.w = pk2(v1.z, v1.w);
            *(GAS v4u*)(pb + (size_t)(g >> 3) * pg8::BLK_KT + pg8::blk_img((r >> 6) & 1, (g >> 2) & 1, (r >> 4) & 3, r & 15, g & 3)) = o;
        }
        s = wave_sum(s); if (F.lane == 0) SSQ[m] = (unsigned long long)(s * SSQ_FIX);
    }
}
__device__ __forceinline__ void cache_to_rings(Frame& F, int j) {
    KArgs ka = KA();
    const unsigned xcd = __builtin_amdgcn_s_getreg((3 << 11) | 20) & 7u;
    unsigned* ctr = (unsigned*)ka->ws + pg8::CW_Q + 64 * 8 * (5 + j) + 64 * xcd;
    bf16* RK = (bf16*)(ka->ws + WS_RK); bf16* RV = (bf16*)(ka->ws + WS_RV);
    unsigned nx = 0u; if (F.lane == 0) nx = __hip_atomic_fetch_add(ctr, 8u, __ATOMIC_RELAXED, __HIP_MEMORY_SCOPE_AGENT);
    for (;;) {
        const unsigned rl = (unsigned)__builtin_amdgcn_readfirstlane((int)nx);
        if (rl >= 2048u) break;
        if (F.lane == 0) nx = __hip_atomic_fetch_add(ctr, 8u, __ATOMIC_RELAXED, __HIP_MEMORY_SCOPE_AGENT);
#pragma unroll 1
        for (int hb = 0; hb < 2; ++hb) {
        const unsigned r0 = xcd * 2048u + rl + 4u * hb;
        f32x4 v[4][4];
#pragma unroll
        for (int k = 0; k < 4; ++k) {
            const int r = (int)r0 + k, tsr = r >> 13, rr = r & 8191, b = rr >> 9, pos = rr & 511;
            const GAS f32x4* xr = (const GAS f32x4*)((tsr ? ka->in[3] : ka->in[2]) + (((size_t)j * 16 + b) * 512 + pos) * D) + F.lane;
#pragma unroll
            for (int q = 0; q < 4; ++q) v[k][q] = xr[64 * q];
        }
#pragma unroll
        for (int k = 0; k < 4; ++k) {
            const int r = (int)r0 + k, tsr = r >> 13, rr = r & 8191, b = rr >> 9, pos = rr & 511;
            GAS unsigned long long* o8 = (GAS unsigned long long*)((tsr ? RV : RK) + ((size_t)b * 576 + pos) * D) + F.lane;
#pragma unroll
            for (int q = 0; q < 4; ++q) o8[64 * q] = (unsigned long long)pk2(v[k][q].x, v[k][q].y) | ((unsigned long long)pk2(v[k][q].z, v[k][q].w) << 32);
        }
        }
    }
}


__device__ __forceinline__ int crow(int r, int hi) { return (r & 3) + 8 * (r >> 2) + 4 * hi; }
constexpr int AT_STAGE = 32768, AT_HEAD = 8192, AT_V = 4096;
constexpr float LOG2E = 1.4426950408889634f;
__device__ __forceinline__ void attn_unit(Frame& F, int cx, int hg, const bf16* Q, const bf16* KP, const bf16* VP, const bf16* RK, const bf16* RV, bf16* O, const float* relb  , const bool newtab) {
    const int lane = F.lane, wid = F.wave, r32 = lane & 31, hi = lane >> 5;
    const int hh = wid >> 1, head = 4 * hg + hh, rh = wid & 1;
#ifdef PROBE_ATT
    unsigned long long pa0_ = 0; const bool pam_ = blockIdx.x == PROBE_WG && F.tid == 0;
    if (pam_ && (PROBE_ATT == 1 || PROBE_ATT == 3)) pa0_ = __builtin_amdgcn_s_memrealtime();
#endif
    LAS unsigned char* ring = F.lds + RING_OFF;
    LAS float* btab = (LAS float*)(F.lds + EXTRA_OFF);
    const bf16 *Kb, *Vb; long kvrow0; int it0; long qrow0;
    if (cx < 256) { Kb = KP; Vb = VP; kvrow0 = (long)(cx - 8) * 64; it0 = cx < 8 ? 2 * (8 - cx) : 0; qrow0 = (long)cx * 64; }
    else { const int b = cx - 256; Kb = RK + (size_t)b * 576 * D; Vb = RV + (size_t)b * 576 * D; kvrow0 = 0; it0 = 0; qrow0 = MP + (long)b * 64; }
    const unsigned lds0 = (unsigned)(size_t)ring;
    const bf16* src0; long srcstep;
    if ((wid & 1) == 0) { src0 = Kb + (kvrow0 + (lane >> 2)) * D + (4 * hg + hh) * 64 + ((lane & 3) ^ ((lane >> 4) & 3)) * 8; srcstep = 0; }
    else { src0 = Vb + (kvrow0 + (lane >> 2)) * D + (4 * hg + hh) * 64 + (lane & 3) * 8; srcstep = 0; }
    const unsigned dst0 = lds0 + hh * AT_HEAD + (wid & 1) * AT_V;
#define AT_DMA(it) do { const bf16* s_ = src0 + (long)(it) * 32 * D; const unsigned d_ = dst0 + ((it) & 3) * AT_STAGE; \
        _Pragma("unroll") for (int p = 0; p < 4; ++p) glds16(s_ + (long)(p & 1) * 16 * D + (p >> 1) * 32, (unsigned)__builtin_amdgcn_readfirstlane(d_ + p * 1024)); } while (0)
    AT_DMA(it0); AT_DMA(it0 + 1);
    (void)srcstep;
    bf16x8 qr[4];
    const bf16* Qw = Q + (qrow0 + 32 * rh + r32) * D + head * 64;
#pragma unroll
    for (int d0 = 0; d0 < 4; ++d0) qr[d0] = *(const bf16x8*)(Qw + d0 * 16 + hi * 8);
    if (newtab && wid < 4) {
        const float* rb = relb + (4 * hg + wid) * 257; const float* qg = KA()->in[12] + ((relb - KA()->in[14]) / (16 * 257)) * 64; const float* kg = KA()->in[13] + ((relb - KA()->in[14]) / (16 * 257)) * 64;
        float bm = -3.0e38f, bv[6];
#pragma unroll
        for (int i = 0; i < 6; ++i) { const int e = lane + 64 * i; bv[i] = rb[e < 257 ? e : 256]; bm = fmaxf(bm, bv[i]); }
        float gq = fabsf(qg[lane]), gk = fabsf(kg[lane]);
#pragma unroll
        for (int o = 1; o < 64; o <<= 1) { bm = fmaxf(bm, __shfl_xor(bm, o)); gq = fmaxf(gq, __shfl_xor(gq, o)); gk = fmaxf(gk, __shfl_xor(gk, o)); }
        const float M = LOG2E * (8.2f * gq * gk + bm) + 0.25f;
#pragma unroll
        for (int i = 0; i < 6; ++i) { const int e = lane + 64 * i; if (e < 324) btab[wid * 324 + e] = bv[i] * LOG2E - M; }
    }
    float lrun = 0.f; f32x16 o0 = {}, o1 = {};
    const int tq = 32 * rh + r32;
    const LAS float* bt = btab + hh * 324;
#ifdef PROBE_ATT
    if (pam_ && PROBE_ATT == 3) { F.MISC[60] = F.MISC[60] + (unsigned)(__builtin_amdgcn_s_memrealtime() - pa0_); F.MISC[61] = F.MISC[61] + 1u; }
    if (pam_ && PROBE_ATT == 2) pa0_ = __builtin_amdgcn_s_memrealtime();
#endif
    for (int it = it0; it < 18; it += 2) {
        asm volatile("s_waitcnt vmcnt(0) lgkmcnt(0)\n\ts_barrier" ::: "memory");
        if (it + 2 < 18) { AT_DMA(it + 2); AT_DMA(it + 3); }
        f32x16 p0[2];
        if (it < 12) { const float cb = bt[256];
#pragma unroll
            for (int s = 0; s < 2; ++s)
#pragma unroll
                for (int r = 0; r < 16; ++r) p0[s][r] = cb; }
        else {
#pragma unroll
            for (int s = 0; s < 2; ++s) { const LAS float* bl = bt + (128 + 512 + tq - 32 * (it + s) - 4 * hi - 27);
#pragma unroll
                for (int r = 0; r < 16; ++r) p0[s][r] = bl[27 - ((r & 3) + 8 * (r >> 2))]; } }
#pragma unroll
        for (int s = 0; s < 2; ++s) { const LAS unsigned char* kb = ring + ((it + s) & 3) * AT_STAGE + hh * AT_HEAD + (r32 >> 4) * 1024 + (r32 & 15) * 64;
            const int ks0 = (hi ^ ((r32 >> 2) & 3)) * 16;
#pragma unroll
          for (int d0 = 0; d0 < 4; ++d0) p0[s] = __builtin_amdgcn_mfma_f32_32x32x16_bf16(*(const LAS bf16x8*)(kb + (d0 >> 1) * 2048 + (ks0 ^ ((d0 & 1) * 32))), qr[d0], p0[s], 0, 0, 0); }
        float ps = 0.f;
#pragma unroll
        for (int s = 0; s < 2; ++s)
#pragma unroll
            for (int r = 0; r < 16; ++r) { p0[s][r] = __builtin_amdgcn_exp2f(p0[s][r]); ps += p0[s][r]; }
        lrun += ps;
#pragma unroll
        for (int s = 0; s < 2; ++s) {
            v4u pw[2];
#pragma unroll
            for (int k = 0; k < 2; ++k) pw[k] = (v4u){pk2(p0[s][8 * k], p0[s][8 * k + 1]), pk2(p0[s][8 * k + 2], p0[s][8 * k + 3]), pk2(p0[s][8 * k + 4], p0[s][8 * k + 5]), pk2(p0[s][8 * k + 6], p0[s][8 * k + 7])};
            const LAS unsigned char* vb = ring + ((it + s) & 3) * AT_STAGE + hh * AT_HEAD + AT_V + ((lane >> 4) & 1) * 32 + (lane & 3) * 8 + (4 * hi + ((lane & 15) >> 2)) * 64;
#pragma unroll
            for (int ks = 0; ks < 2; ++ks) {
                const s16x4 l0 = vtr(vb + ks * 1024), h0 = vtr(vb + ks * 1024 + 512), l1 = vtr(vb + 2048 + ks * 1024), h1 = vtr(vb + 2048 + ks * 1024 + 512);
                const bf16x8 v0 = (bf16x8){l0[0], l0[1], l0[2], l0[3], h0[0], h0[1], h0[2], h0[3]}, v1 = (bf16x8){l1[0], l1[1], l1[2], l1[3], h1[0], h1[1], h1[2], h1[3]};
                const bf16x8 pa = __builtin_bit_cast(bf16x8, pw[ks]);
                o0 = __builtin_amdgcn_mfma_f32_32x32x16_bf16(v0, pa, o0, 0, 0, 0);
                o1 = __builtin_amdgcn_mfma_f32_32x32x16_bf16(v1, pa, o1, 0, 0, 0);
            }
        }
    }
#undef AT_DMA
#ifdef PROBE_ATT
    if (pam_ && PROBE_ATT == 2) { F.MISC[60] = F.MISC[60] + (unsigned)(__builtin_amdgcn_s_memrealtime() - pa0_); F.MISC[61] = F.MISC[61] + 1u; }
#endif
    { auto rr = __builtin_amdgcn_permlane32_swap(__float_as_uint(lrun), __float_as_uint(lrun), false, false); lrun = __uint_as_float(rr[0]) + __uint_as_float(rr[1]); }
    const float rl = 1.0f / lrun;
    WAIT_ALL_BAR();
    {
        LAS unsigned char* scr = ring + wid * 4096;
        LAS unsigned char* wp = scr + r32 * 128 + hi * 8;
#pragma unroll
        for (int g = 0; g < 4; ++g) {
            v2u w0, w1;
            w0.x = pk2(o0[4 * g] * rl, o0[4 * g + 1] * rl); w0.y = pk2(o0[4 * g + 2] * rl, o0[4 * g + 3] * rl);
            w1.x = pk2(o1[4 * g] * rl, o1[4 * g + 1] * rl); w1.y = pk2(o1[4 * g + 2] * rl, o1[4 * g + 3] * rl);
            *(LAS v2u*)(wp + ((g ^ (r32 & 7)) * 16)) = w0; *(LAS v2u*)(wp + (((4 + g) ^ (r32 & 7)) * 16)) = w1;
        }
        asm volatile("s_waitcnt lgkmcnt(0)" ::: "memory");
        bf16* Ob = O + (qrow0 + 32 * rh + (lane >> 3)) * D + head * 64 + (lane & 7) * 8;
#pragma unroll
        for (int i = 0; i < 4; ++i) {
            const int r = 8 * i + (lane >> 3);
            const v4u w = *(const LAS v4u*)(scr + r * 128 + (((lane & 7) ^ (r & 7)) * 16));
            *(v4u*)(Ob + (size_t)(8 * i) * D) = w;
        }
    }
    WAIT_ALL_BAR();
#ifdef PROBE_ATT
    if (pam_ && PROBE_ATT == 1) { F.MISC[60] = F.MISC[60] + (unsigned)(__builtin_amdgcn_s_memrealtime() - pa0_); F.MISC[61] = F.MISC[61] + 1u; }
#endif
}
__device__ __forceinline__ void attn_phase(Frame& F, int j) {
    KArgs ka = KA(); unsigned char* ws = ka->ws;
    const bf16 *Q = (const bf16*)(ws + WS_Q), *KP = (const bf16*)(ws + WS_KP), *VP = (const bf16*)(ws + WS_VP), *RK = (const bf16*)(ws + WS_RK), *RV = (const bf16*)(ws + WS_RV);
    bf16* O = (bf16*)(ws + WS_O);
    const float* relb = ka->in[14] + (size_t)j * 16 * 257;
    const int x = F.vcu >> 5, c = F.vcu & 31;
    int hgprev = -1;
#pragma unroll 1
    for (int i = 0; ; ++i) {
        int cx, hg;
        if (F.G == 256) { if (i < 4) { cx = 32 * x + 16 * (i & 1) + (c >> 1); hg = 2 * (i >> 1) + (c & 1); } else if (i == 4 && c < 8) { cx = 256 + 2 * x + (c >> 2); hg = c & 3; } else break; }
        else { const int u = F.vcu + i * F.G; if (u >= 272 * 4) break; cx = u >> 2; hg = u & 3; }
        attn_unit(F, cx, hg, Q, KP, VP, RK, RV, O, relb, hg != hgprev); hgprev = hg;
    }
}

struct MUnit { int head, ntok, b, isS; long row0; };
__device__ __forceinline__ void munit(int u, MUnit& m) {
    if (u < 512) { m.head = u & 3; m.ntok = 128; m.row0 = (long)(u >> 2) * 128; m.isS = 0; m.b = 0; }
    else { const int v = u - 512; m.head = v & 3; m.b = v >> 2; m.ntok = 64; m.row0 = MP + (long)m.b * 64; m.isS = 1; }
}
__device__ __forceinline__ f32x4 mfma16(bf16x8 a, bf16x8 b, f32x4 c) { return __builtin_amdgcn_mfma_f32_16x16x32_bf16(a, b, c, 0, 0, 0); }
__device__ __forceinline__ bf16x8 trfrag(const LAS unsigned char* p) { const s16x4 lo = vtr(p), hi = vtr(p + 1024); return (bf16x8){lo[0], lo[1], lo[2], lo[3], hi[0], hi[1], hi[2], hi[3]}; }
constexpr int MSTART_OFF = 2048;


__device__ __forceinline__ void gate_scans(LAS float* xs, int tid, int ntok, float& bt, float& ut, float& pm) {
    const int lane = tid & 63; const bool on = tid < 128;
    float b = on ? xs[128 + (tid < ntok ? tid : 0)] : 0.f; if (tid >= ntok) b = 0.f;
#pragma unroll
    for (int o = 1; o < 64; o <<= 1) { const float y = __shfl_up(b, o); if (lane >= o) b += y; }
    if (on && lane == 63) xs[512 + (tid >> 6)] = b;
    LBAR();
    if (on && tid >= 64) b += xs[512];
    const float ig = (tid < ntok) ? xs[tid] : 0.f;
    float u = (tid < ntok) ? ig - b : -3.0e38f, m = u;
#pragma unroll
    for (int o = 1; o < 64; o <<= 1) { const float y = __shfl_up(m, o); if (lane >= o) m = fmaxf(m, y); }
    if (on && lane == 63) xs[514 + (tid >> 6)] = m;
    LBAR();
    if (on && tid >= 64) m = fmaxf(m, xs[514]);
    if (tid < ntok) { xs[128 + tid] = b; xs[256 + tid] = u; xs[384 + tid] = m; }
    bt = b; ut = u; pm = m;
}

__device__ __forceinline__ int slab_off(int e, int d) { return e < 256 ? (e >> 6) * 32768 + (d >> 3) * 1024 + (e & 63) * 16 + (d & 7) * 2 : 131072 + (d >> 3) * 256 + (e - 256) * 16 + (d & 7) * 2; }
__device__ __forceinline__ void slab_ed(int vi, int& e, int& d) {
    const int off = vi * 8;
    if (off < 131072) { e = (off >> 15) * 64 + ((off >> 4) & 63); d = ((off >> 10) & 31) * 8 + ((off >> 3) & 1) * 4; }
    else { const int t = off - 131072; e = 256 + ((t >> 4) & 15); d = (t >> 8) * 8 + ((t >> 3) & 1) * 4; }
}
__device__ __forceinline__ void mlstm_a_unit(Frame& F, int j, int u) {
    MUnit mu; munit(u, mu); KArgs ka = KA();
#ifdef PROBE_MA
    unsigned pm_last_ = 0; const bool pmm_ = blockIdx.x == PROBE_WG && F.tid == 0 && u < 512;
#define PM_MARK(k_) do { if (pmm_) { const unsigned now_ = (unsigned)__builtin_amdgcn_s_memrealtime(); if ((k_) > 0 && ((k_) - 1 == PROBE_MA || PROBE_MA == 9)) F.MISC[60] = F.MISC[60] + (now_ - pm_last_); if ((k_) == 4) F.MISC[61] = F.MISC[61] + 1u; pm_last_ = now_; } } while (0)
    PM_MARK(0);
#endif
    unsigned char* ws = ka->ws;
    const bf16* QKP = (const bf16*)(ws + WS_QKP); const bf16* V = (const bf16*)(ws + WS_V);
    bf16* QC = (bf16*)(ws + WS_QC); bf16* KC = (bf16*)(ws + WS_KC);
    bf16* slab = (bf16*)(ws + WS_SLAB + (size_t)u * SLAB_BYTES);
    const float* gates = (const float*)(ka->ws + WS_GATES); float* stats = (float*)(ka->ws + WS_STATS);
    LAS float* xs = (LAS float*)(F.lds + EXTRA_OFF + 9216);
    LAS unsigned char* Kt = F.lds + RING_OFF; LAS unsigned char* Wv = F.lds + RING_OFF + 65536;
    const int tid = F.tid, lane = F.lane, wid = F.wave, head = mu.head, ntok = mu.ntok; const long row0 = mu.row0;
    if (tid < ntok) { xs[tid] = gates[(row0 + tid) * 8 + head]; xs[128 + tid] = gates[(row0 + tid) * 8 + 4 + head]; }
    LBAR();
    float bt, ut, pmx; gate_scans(xs, tid, ntok, bt, ut, pmx);
    LBAR();
    const float umax = xs[384 + ntok - 1], bsum = xs[128 + ntok - 1];
    LBAR();
    if (tid < ntok) xs[256 + tid] = expf(ut - umax);
    if (tid == 0) { stats[u * 2] = bsum; stats[u * 2 + 1] = umax; }
    const int nh = ntok >> 6;
    const int cgi = tid & 63, rseg = tid >> 6, c = cgi & 31; const bool isk = cgi >= 32;
    const int qcol = (isk ? 1024 : 0) + head * 256 + 8 * c;
    const int vc = tid & 31, kseg = tid >> 5;
    float cw[4][8], cb[8];
#pragma unroll
    for (int jj = 0; jj < 4; ++jj) { const f32x4 w0 = *(const f32x4*)(ka->in[18] + ((size_t)j * 4 + jj) * 2048 + qcol), w1 = *(const f32x4*)(ka->in[18] + ((size_t)j * 4 + jj) * 2048 + qcol + 4);
#pragma unroll
        for (int e = 0; e < 4; ++e) { cw[jj][e] = w0[e]; cw[jj][4 + e] = w1[e]; } }
    { const f32x4 w0 = *(const f32x4*)(ka->in[19] + (size_t)j * 2048 + qcol), w1 = *(const f32x4*)(ka->in[19] + (size_t)j * 2048 + qcol + 4);
#pragma unroll
      for (int e = 0; e < 4; ++e) { cb[e] = w0[e]; cb[4 + e] = w1[e]; } }
    LBAR();
#ifdef PROBE_MA
    PM_MARK(1);
#endif
    for (int hs = 0; hs < nh; ++hs) {
        v4u xr[11], vr[4];
#pragma unroll
        for (int i = 0; i < 11; ++i) { const long gr = row0 + 64 * hs + 8 * rseg + i - 3; xr[i] = *(const v4u*)(QKP + (size_t)(gr < 0 ? 0 : gr) * 2048 + qcol); }
#pragma unroll
        for (int i = 0; i < 4; ++i) vr[i] = *(const v4u*)(V + (size_t)(row0 + 64 * hs + 4 * kseg + i) * D + head * 256 + 8 * vc);
        {
            float x0[8], x1[8], x2[8];
#pragma unroll
            for (int e = 0; e < 8; ++e) { x0[e] = 0.f; x1[e] = 0.f; x2[e] = 0.f; }
#pragma unroll
            for (int i = -3; i < 8; ++i) {
                const int tt = 64 * hs + 8 * rseg + i;
                float x[8];
                {
                    const long gr = row0 + tt; const v4u w = xr[i + 3];
                    x[0] = bflo(w.x); x[1] = bfhi(w.x); x[2] = bflo(w.y); x[3] = bfhi(w.y); x[4] = bflo(w.z); x[5] = bfhi(w.z); x[6] = bflo(w.w); x[7] = bfhi(w.w);
                    if (i < 0) {
                        const int ts = tt < -3 ? -3 : (tt > -1 ? -1 : tt);
                        const float* sp = ka->in[7] + (((size_t)j * 16 + mu.b) * 3 + (3 + ts)) * 2048 + qcol;
                        const f32x4 w0 = *(const f32x4*)sp, w1 = *(const f32x4*)(sp + 4);
                        const bool useS = mu.isS && tt < 0, zero = !mu.isS && gr < 0;
#pragma unroll
                        for (int e = 0; e < 4; ++e) { x[e] = useS ? w0[e] : (zero ? 0.f : x[e]); x[4 + e] = useS ? w1[e] : (zero ? 0.f : x[4 + e]); }
                    }
                }
                if (i >= 0) {
                    float y[8];
#pragma unroll
                    for (int e = 0; e < 8; ++e) { const float s = cb[e] + cw[0][e] * x0[e] + cw[1][e] * x1[e] + cw[2][e] * x2[e] + cw[3][e] * x[e]; float v = s * __builtin_amdgcn_rcpf(1.0f + __expf(-s)); if (isk) v *= 0.0625f; y[e] = v; }
                    v4u o; o.x = pk2(y[0], y[1]); o.y = pk2(y[2], y[3]); o.z = pk2(y[4], y[5]); o.w = pk2(y[6], y[7]);
                    *(v4u*)((isk ? KC : QC) + (size_t)(row0 + tt) * D + head * 256 + 8 * c) = o;
                    if (isk) *(LAS v4u*)(Kt + (c >> 2) * 8192 + (64 * hs + 8 * rseg + i) * 64 + (c & 3) * 16) = o;
                }
#pragma unroll
                for (int e = 0; e < 8; ++e) { x0[e] = x1[e]; x1[e] = x2[e]; x2[e] = x[e]; }
            }
        }
        {
#pragma unroll
            for (int i = 0; i < 4; ++i) {
                const int key = 4 * kseg + i; const float w = xs[256 + 64 * hs + key];
                const v4u x = vr[i];
                v4u o; o.x = pk2(bflo(x.x) * w, bfhi(x.x) * w); o.y = pk2(bflo(x.y) * w, bfhi(x.y) * w); o.z = pk2(bflo(x.z) * w, bfhi(x.z) * w); o.w = pk2(bflo(x.w) * w, bfhi(x.w) * w);
                *(LAS v4u*)(Wv + (vc >> 2) * 8192 + (64 * hs + key) * 64 + (vc & 3) * 16) = o;
            }
            if (tid < 256) { const int key = tid >> 2, ch = tid & 3; v4u o = (v4u){0u, 0u, 0u, 0u}; if (ch == 0) o.x = f2bf(xs[256 + 64 * hs + key]); *(LAS v4u*)(Wv + 8 * 8192 + (64 * hs + key) * 64 + ch * 16) = o; }
        }
    }
    LBAR();
#ifdef PROBE_MA
    PM_MARK(2);
#endif
    f32x4 acc[2][17];
#pragma unroll
    for (int dd = 0; dd < 2; ++dd)
#pragma unroll
        for (int eb = 0; eb < 17; ++eb) acc[dd][eb] = (f32x4){0.f, 0.f, 0.f, 0.f};
    {
        const int g = lane >> 4, q = (lane & 15) >> 2, p = lane & 3;
        for (int ks = 0; ks < 2 * nh; ++ks) {
            const int koff = (32 * ks + 4 * g + q) * 64 + p * 8;
            bf16x8 af[2];
#pragma unroll
            for (int dd = 0; dd < 2; ++dd) { const int db = 2 * wid + dd; af[dd] = trfrag(Kt + (db >> 1) * 8192 + (db & 1) * 32 + koff); }
#pragma unroll
            for (int eb = 0; eb < 17; ++eb) {
                const bf16x8 bfr = trfrag(Wv + (eb >> 1) * 8192 + (eb & 1) * 32 + koff);
                acc[0][eb] = mfma16(af[0], bfr, acc[0][eb]); acc[1][eb] = mfma16(af[1], bfr, acc[1][eb]);
            }
        }
    }
#ifdef PROBE_MA
    PM_MARK(3);
#endif
    {
        const int g = lane >> 4, el = lane & 15;
        unsigned char* sb1 = (unsigned char*)slab + el * 16 + (g & 1) * 8 + wid * 4096 + (g >> 1) * 1024;
        unsigned char* sb2 = (unsigned char*)slab + 131072 + el * 16 + (g & 1) * 8 + wid * 1024 + (g >> 1) * 256;
#pragma unroll
        for (int dd = 0; dd < 2; ++dd)
#pragma unroll
            for (int eb = 0; eb < 17; ++eb) {
                const f32x4 v = acc[dd][eb];
                v2u o; o.x = pk2(v[0], v[1]); o.y = pk2(v[2], v[3]);
                *(v2u*)(eb < 16 ? sb1 + (eb >> 2) * 32768 + (eb & 3) * 256 + dd * 2048 : sb2 + dd * 512) = o;
            }
    }
    LBAR();
#ifdef PROBE_MA
    PM_MARK(4);
#endif
}

__device__ __forceinline__ void mlstm_b_phase(Frame& F, int j, bool dry = false) {
    KArgs ka = KA();
    unsigned char* A = ka->ws; unsigned char* slab0 = A + WS_SLAB;
    float* stats = (float*)(ka->ws + WS_STATS); float* mstart = stats + MSTART_OFF;
    LAS float* tab = (LAS float*)(F.lds + EXTRA_OFF);
    const int tid = F.tid;
    for (int vb = F.vcu; vb < 256; vb += F.G) {
        if (vb < 136) {
            const int head = vb / 34, vi = (vb % 34) * 512 + tid;
            LBAR();
            if (tid < 128) { const int u = tid * 4 + head; tab[272 + tid] = stats[u * 2]; tab[400 + tid] = stats[u * 2 + 1]; }
            LBAR();
            if (tid == 0) { float m = 0.f; for (int J = 0; J < 128; ++J) { tab[528 + J] = m; m = tab[272 + J] + fmaxf(m, tab[400 + J]); } tab[256] = m; }
            LBAR();
            if (tid < 128) { const float bs = tab[272 + tid], um = tab[400 + tid], m = tab[528 + tid], mn = bs + fmaxf(m, um);
                tab[tid] = expf(bs + m - mn); tab[128 + tid] = expf(bs + um - mn); if (vb % 34 == 0 && !dry) mstart[tid * 4 + head] = m; }
            LBAR();
            f32x4 C = (f32x4){0.f, 0.f, 0.f, 0.f};
            unsigned char* p0 = slab0 + (size_t)head * SLAB_BYTES + (size_t)vi * 8;
            for (int J0 = 0; J0 < 128; J0 += 16) {
                v2u dq[16];
#pragma unroll
                for (int k = 0; k < 16; ++k) dq[k] = *(const v2u*)(p0 + (size_t)(J0 + k) * 4 * SLAB_BYTES);
#pragma unroll
                for (int k = 0; k < 16; ++k) {
                    v2u o; o.x = pk2(C[0], C[1]); o.y = pk2(C[2], C[3]);
                    *(v2u*)(dry ? A + WS_QKP + (size_t)((J0 + k) & 63) * MiB + (size_t)vi * 8 : p0 + (size_t)(J0 + k) * 4 * SLAB_BYTES) = o;
                    const float dc = tab[J0 + k], sc = tab[128 + J0 + k];
                    C[0] = dc * C[0] + sc * bflo(dq[k].x); C[1] = dc * C[1] + sc * bfhi(dq[k].x); C[2] = dc * C[2] + sc * bflo(dq[k].y); C[3] = dc * C[3] + sc * bfhi(dq[k].y);
                }
            }
            int e, d; slab_ed(vi, e, d);
            if (!dry) {
            if (e < 256) *(f32x4*)(ka->out + O_CP + (((size_t)j * 4 + head) * 256 + e) * 256 + d) = C;
            else if (e == 256) *(f32x4*)(ka->out + O_NP + ((size_t)j * 4 + head) * 256 + d) = C;
            if (vb % 34 == 0 && tid == 0) ka->out[O_MP + j * 4 + head] = tab[256];
            }
        } else {
            constexpr int SN = 64 * 17408, SS = 120 * 512;
            for (int idx0 = (vb - 136) * 512 + tid; idx0 < SN; idx0 += 4 * SS) {
                int vi_[4], u_[4], e_[4]; size_t sh_[4]; bool ok_[4]; f32x4 C0_[4], N0_[4]; v2u dq_[4]; float m0_[4], bs_[4], um_[4]; unsigned char* p_[4];
#pragma unroll
                for (int k = 0; k < 4; ++k) {
                    const int idx = idx0 + k * SS; ok_[k] = idx < SN; const int ic = ok_[k] ? idx : 0;
                    const int v = ic / 17408, vi = ic - v * 17408, b = v >> 2, head = v & 3; vi_[k] = vi; u_[k] = 512 + v; int d; slab_ed(vi, e_[k], d);
                    sh_[k] = ((size_t)j * 16 + b) * 4 + head;
                    m0_[k] = ka->in[6][sh_[k]]; bs_[k] = stats[u_[k] * 2]; um_[k] = stats[u_[k] * 2 + 1];
                    C0_[k] = *(const f32x4*)(ka->in[4] + (sh_[k] * 256 + (e_[k] < 256 ? e_[k] : 0)) * 256 + d);
                    N0_[k] = *(const f32x4*)(ka->in[5] + sh_[k] * 256 + d);
                    p_[k] = slab0 + (size_t)u_[k] * SLAB_BYTES + (size_t)vi * 8;
                    dq_[k] = *(const v2u*)p_[k];
                }
#pragma unroll
                for (int k = 0; k < 4; ++k) if (ok_[k]) {
                    int e, d; slab_ed(vi_[k], e, d); const size_t sh = sh_[k];
                    const float m0 = m0_[k], bs = bs_[k], um = um_[k], mn = bs + fmaxf(m0, um), dc = expf(bs + m0 - mn), sc = expf(bs + um - mn);
                    const f32x4 C0 = e < 256 ? C0_[k] : (e == 256 ? N0_[k] : (f32x4){0.f, 0.f, 0.f, 0.f});
                    const v2u dq = dq_[k];
                    v2u o; o.x = pk2(C0[0], C0[1]); o.y = pk2(C0[2], C0[3]); if (!dry) *(v2u*)p_[k] = o;
                    f32x4 Ce; Ce[0] = dc * C0[0] + sc * bflo(dq.x); Ce[1] = dc * C0[1] + sc * bfhi(dq.x); Ce[2] = dc * C0[2] + sc * bflo(dq.y); Ce[3] = dc * C0[3] + sc * bfhi(dq.y);
                    if (!dry) { if (e < 256) *(f32x4*)(ka->out + O_CS + (sh * 256 + e) * 256 + d) = Ce; else if (e == 256) *(f32x4*)(ka->out + O_NS + sh * 256 + d) = Ce;
                        if (vi_[k] == 0) { ka->out[O_MS + sh] = mn; mstart[u_[k]] = m0; } }
                    else if (Ce[0] == 1.2345e30f) ka->out[0] = Ce[1];
                }
            }
        }
    }
}

__device__ __forceinline__ void mlstm_c_unit(Frame& F, int j, int u, bool dry = false) {
#ifdef PROBE_MC
    unsigned pc_last_ = 0; const bool pcm_ = blockIdx.x == PROBE_WG && F.tid == 0 && u < 512;
#define PC_MARK(k_) do { if (pcm_) { const unsigned now_ = (unsigned)__builtin_amdgcn_s_memrealtime(); if ((k_) > 0 && ((k_) - 1 == PROBE_MC || PROBE_MC == 9)) F.MISC[60] = F.MISC[60] + (now_ - pc_last_); if ((k_) == 6) F.MISC[61] = F.MISC[61] + 1u; pc_last_ = now_; } } while (0)
    PC_MARK(0);
#endif
    MUnit mu; munit(u, mu); KArgs ka = KA();
    unsigned char* A = ka->ws;
    const bf16* V = (const bf16*)(A + WS_V); bf16* OG = (bf16*)(A + WS_OG);
    const bf16* QC = (const bf16*)(A + WS_QC); const bf16* KC = (const bf16*)(A + WS_KC);
    const bf16* slab = (const bf16*)(A + WS_SLAB + (size_t)u * SLAB_BYTES);
    const float* gates = (const float*)(ka->ws + WS_GATES); const float* stats = (const float*)(ka->ws + WS_STATS);
    LAS float* xs = (LAS float*)(F.lds + EXTRA_OFF + 9216);
    LAS unsigned char* ring = F.lds + RING_OFF; const unsigned lds0 = (unsigned)(size_t)ring;
    const int tid = F.tid, lane = F.lane, wid = F.wave, head = mu.head, ntok = mu.ntok; const long row0 = mu.row0;
    const int tl = lane & 15, g = lane >> 4, t = 16 * wid + tl;
    const bool active = 16 * wid < ntok;
    const float ms = stats[MSTART_OFF + u];
#pragma unroll
    for (int ct = 0; ct < 4; ++ct)
#pragma unroll
        for (int k = 0; k < 4; ++k) { const int c = wid * 4 + k;
            glds16((const unsigned char*)slab + ct * 32768 + c * 1024 + lane * 16, (unsigned)__builtin_amdgcn_readfirstlane(lds0 + ct * 32768 + c * 1024)); }
    bf16x8 qf[8];
#pragma unroll
    for (int kd = 0; kd < 8; ++kd) qf[kd] = *(const bf16x8*)(QC + (size_t)(row0 + (active ? t : 0)) * D + head * 256 + 32 * kd + 8 * g);
    if (tid < ntok) { xs[tid] = gates[(row0 + tid) * 8 + head]; xs[128 + tid] = gates[(row0 + tid) * 8 + 4 + head]; }
    LBAR();
    float bt, ut, pmx; gate_scans(xs, tid, ntok, bt, ut, pmx);
    if (tid < ntok) { xs[384 + tid] = bt + fmaxf(ms, pmx); xs[256 + tid] = ut * LOG2E; }
    LBAR();
    float b_t = 0.f, m_t = 0.f;
    if (active) { b_t = xs[128 + t]; m_t = xs[384 + t]; }
    const float a_t = (b_t - m_t) * LOG2E, inter_t = expf(b_t + ms - m_t);
    WAIT_ALL_BAR();
#ifdef PROBE_MC
    PC_MARK(1);
#endif
    f32x4 acc[16];
#pragma unroll
    for (int eb = 0; eb < 16; ++eb) acc[eb] = (f32x4){0.f, 0.f, 0.f, 0.f};
    if (active) {
#pragma unroll
        for (int eb = 0; eb < 16; ++eb) {
            const LAS unsigned char* cb = ring + (eb >> 2) * 32768 + g * 1024 + ((eb & 3) * 16 + tl) * 16;
#pragma unroll
            for (int kd = 0; kd < 8; ++kd) acc[eb] = mfma16(*(const LAS bf16x8*)(cb + kd * 4096), qf[kd], acc[eb]);
        }
    }
    WAIT_ALL_BAR();
#ifdef PROBE_MC
    PC_MARK(2);
#endif
#define MC_DMA_KV(kt, bk, bv) do { \
        _Pragma("unroll") for (int k = 0; k < 4; ++k) { const int pc = wid * 4 + k;        \
            glds16(KC + (size_t)(row0 + 64 * (kt) + 16 * k + (lane >> 2)) * D + head * 256 + wid * 32 + ((lane & 3) ^ ((lane >> 4) & 3)) * 8, (unsigned)__builtin_amdgcn_readfirstlane(lds0 + (bk) * 32768 + pc * 1024)); } \
        _Pragma("unroll") for (int k = 0; k < 4; ++k) { const int pc = wid * 4 + k, cg = pc >> 2, rg = pc & 3; \
            glds16(V + (size_t)(row0 + 64 * (kt) + 16 * rg + (lane >> 2)) * D + head * 256 + cg * 32 + (lane & 3) * 8, (unsigned)__builtin_amdgcn_readfirstlane(lds0 + (bv) * 32768 + pc * 1024)); } } while (0)
#pragma unroll
    for (int k = 0; k < 4; ++k) { const int c = wid * 4 + k; const int rr = lane > 15 ? 15 : lane;
        glds16((const unsigned char*)slab + 131072 + c * 256 + rr * 16, (unsigned)__builtin_amdgcn_readfirstlane(lds0 + c * 1024)); }
    MC_DMA_KV(0, 2, 3);
    WAIT_ALL_BAR();
#ifdef PROBE_MC
    PC_MARK(3);
#endif
    float nq = 0.f;
    {
        f32x4 ad = (f32x4){0.f, 0.f, 0.f, 0.f};
        if (active) {
            const LAS unsigned char* cb = ring + g * 1024 + tl * 16;
#pragma unroll
            for (int kd = 0; kd < 8; ++kd) ad = mfma16(*(const LAS bf16x8*)(cb + kd * 4096), qf[kd], ad);
        }
        nq = __shfl(ad[0], tl);
    }
#pragma unroll
    for (int eb = 0; eb < 16; ++eb) acc[eb] = acc[eb] * inter_t;
    float den = inter_t * nq, denp = 0.f;
    WAIT_ALL_BAR();
#ifdef PROBE_MC
    PC_MARK(4);
#endif
    const int nkt = ntok >> 6;
    if (nkt > 1) MC_DMA_KV(1, 0, 1);
    for (int kt = 0; kt < nkt; ++kt) {
        if (kt == 1) WAIT_ALL_BAR();
        const LAS unsigned char* bK = ring + (kt == 0 ? 2 : 0) * 32768; const LAS unsigned char* bV = bK + 32768;
        if (active && kt <= (wid >> 2)) {
            f32x4 sacc[4];
#pragma unroll
            for (int sb = 0; sb < 4; ++sb) { sacc[sb] = (f32x4){0.f, 0.f, 0.f, 0.f};
                const LAS unsigned char* kb = bK + sb * 1024 + tl * 64 + ((g ^ ((tl >> 2) & 3)) * 16);
#pragma unroll
                for (int kd = 0; kd < 8; ++kd) sacc[sb] = mfma16(*(const LAS bf16x8*)(kb + kd * 4096), qf[kd], sacc[sb]); }
            unsigned pw[8];
#pragma unroll
            for (int sb = 0; sb < 4; ++sb) {
                const f32x4 c4 = *(const LAS f32x4*)(xs + 256 + 64 * kt + 16 * sb + 4 * g);
                float pv[4];
#pragma unroll
                for (int r = 0; r < 4; ++r) { const int s = 64 * kt + 16 * sb + 4 * g + r; const float w = __builtin_amdgcn_exp2f(fminf(a_t + c4[r], 0.f)); pv[r] = (s <= t) ? sacc[sb][r] * w : 0.f; denp += pv[r]; }
                pw[2 * sb] = pk2(pv[0], pv[1]); pw[2 * sb + 1] = pk2(pv[2], pv[3]);
            }
            const bf16x8 pf0 = __builtin_bit_cast(bf16x8, (v4u){pw[0], pw[1], pw[2], pw[3]}), pf1 = __builtin_bit_cast(bf16x8, (v4u){pw[4], pw[5], pw[6], pw[7]});
            const int q = tl >> 2, p = lane & 3;
            const LAS unsigned char* vb = bV + (4 * g + q) * 64 + p * 8;
#pragma unroll
            for (int eb = 0; eb < 16; ++eb) {
                const LAS unsigned char* ve = vb + (eb >> 1) * 4096 + (eb & 1) * 32;
                acc[eb] = mfma16(trfrag(ve), pf0, acc[eb]);
                acc[eb] = mfma16(trfrag(ve + 32 * 64), pf1, acc[eb]);
            }
        }
    }
#undef MC_DMA_KV
#ifdef PROBE_MC
    PC_MARK(5);
#endif
    denp += __shfl_xor(denp, 16); denp += __shfl_xor(denp, 32);
    den += denp;
    const float inv = 1.0f / fmaxf(fabsf(den), expf(-m_t));
    float ss = 0.f;
#pragma unroll
    for (int eb = 0; eb < 16; ++eb) { acc[eb] = acc[eb] * inv; const f32x4 x = acc[eb]; ss += (x[0] * x[0] + x[1] * x[1]) + (x[2] * x[2] + x[3] * x[3]); }
    ss += __shfl_xor(ss, 16); ss += __shfl_xor(ss, 32);
    const float rr = 1.0f / sqrtf(ss * (1.0f / 256.0f) + 1e-6f);
    if (active) {
        const float* hn = ka->in[20] + (size_t)j * 1024 + head * 256;
        LAS unsigned char* scr = ring + (nkt > 1 ? 2 : 0) * 32768 + wid * 8192;
        bf16* gbase = (dry ? (bf16*)(A + WS_QKP) : OG) + (size_t)(row0 + 16 * wid + (lane >> 5)) * D + head * 256 + (lane & 31) * 8;
        const bf16* gin = OG + (size_t)(row0 + 16 * wid + (lane >> 5)) * D + head * 256 + (lane & 31) * 8;
        v4u gv[8];
#pragma unroll
        for (int i = 0; i < 8; ++i) gv[i] = *(const v4u*)(gin + (size_t)(2 * i) * D);
#pragma unroll
        for (int i = 0; i < 8; ++i) { const int r = 2 * i + (lane >> 5); *(LAS v4u*)(scr + r * 512 + (((lane & 31) ^ r) * 16)) = gv[i]; }
        asm volatile("s_waitcnt lgkmcnt(0)" ::: "memory");
        LAS unsigned char* lp = scr + tl * 512 + (g & 1) * 8;
#pragma unroll
        for (int eb = 0; eb < 16; ++eb) {
            const int e0 = 16 * eb + 4 * g; const f32x4 h4 = *(const f32x4*)(hn + e0); const f32x4 x = acc[eb];
            LAS v2u* p = (LAS v2u*)(lp + (((2 * eb + (g >> 1)) ^ tl) * 16));
            const v2u og = *p;
            v2u o; o.x = pk2(x[0] * rr * h4[0] * bflo(og.x), x[1] * rr * h4[1] * bfhi(og.x)); o.y = pk2(x[2] * rr * h4[2] * bflo(og.y), x[3] * rr * h4[3] * bfhi(og.y));
            *p = o;
        }
        asm volatile("s_waitcnt lgkmcnt(0)" ::: "memory");
#pragma unroll
        for (int i = 0; i < 8; ++i) { const int r = 2 * i + (lane >> 5); *(v4u*)(gbase + (size_t)(2 * i) * D) = *(const LAS v4u*)(scr + r * 512 + (((lane & 31) ^ r) * 16)); }
    }
    WAIT_ALL_BAR();
#ifdef PROBE_MC
    PC_MARK(6);
#endif
}


__global__ void __launch_bounds__(NWAVES * 64, 2) hybrid_fwd(Args args_unused) {
    extern __shared__ __attribute__((aligned(16))) unsigned char lds[];
    Frame F;
    F.lds = (LAS unsigned char*)lds;
    F.MISC = (volatile LAS unsigned*)(F.lds + MISC_OFF);
#define FRESH() do { int t_ = threadIdx.x; asm volatile("" : "+v"(t_)); F.tid = t_; F.lane = t_ & 63; F.wave = __builtin_amdgcn_readfirstlane(t_ >> 6); \
        unsigned l_ = (unsigned)(size_t)(LAS unsigned char*)lds; asm volatile("" : "+s"(l_)); F.lds = (LAS unsigned char*)(size_t)l_; F.MISC = (volatile LAS unsigned*)(F.lds + MISC_OFF); } while (0)
    FRESH();
    F.G = gridDim.x; { const int bx = blockIdx.x; F.vcu = (F.G % 8 == 0) ? (bx % 8) * (F.G / 8) + bx / 8 : bx; }
    F.ctl = (gu32*)(KA()->ws + WS_CTL);
    for (int u = F.tid; u < (LDS_BYTES - LDSCTL_OFF) / 4; u += NWAVES * 64) ((LAS unsigned*)(F.lds + LDSCTL_OFF))[u] = 0u;
    __syncthreads();
    (void)xcd_barrier_post((unsigned*)(F.ctl + CW_BAR), F.MISC + 8);
#define GRID_BAR() do { FRESH(); XcdBarrier b_; b_.bar = (unsigned*)((gu32*)(KA()->ws + WS_CTL) + CW_BAR); b_.x = (unsigned)__builtin_amdgcn_readfirstlane((int)xb_xcc_id()); b_.st = F.MISC + 8; xcd_barrier(b_); } while (0)

#ifndef PROBE_ONECH
#define PROBE_ONECH -1
#endif
#ifdef PROBE_PHC
#define PT_MARK(cls_) do { if (blockIdx.x == PROBE_WG && threadIdx.x == 0) { const unsigned now_ = (unsigned)__builtin_amdgcn_s_memrealtime(); if ((cls_) == PROBE_PHC || (PROBE_PHC == 9 && (cls_) >= 0)) F.MISC[60] = F.MISC[60] + (now_ - F.MISC[62]); F.MISC[62] = now_; F.MISC[61] = 1u; } } while (0)
#else
#define PT_MARK(cls_) do {} while (0)
#endif
    PT_MARK(-1);
#ifdef PROBE_LAST
    if (blockIdx.x == 0 && threadIdx.x == 0) { const unsigned long long st_ = __builtin_amdgcn_s_memrealtime(); __hip_atomic_store((unsigned long long*)((gu32*)(KA()->ws + WS_CTL) + 12000), st_, __ATOMIC_RELAXED, __HIP_MEMORY_SCOPE_AGENT); }
#endif
    FRESH(); p0_prologue(F);
    GRID_BAR(); PT_MARK(0);
#ifdef PROBE_BARS
    for (int pb_ = 0; pb_ < PROBE_BARS; ++pb_) { GRID_BAR(); }
#endif
#ifdef DUP_P0
    FRESH(); p0_prologue(F);
    GRID_BAR();
#endif
    { if (threadIdx.x == 0) { unsigned full = (F.G == 256) ? 1u : 0u; const unsigned* bw = (const unsigned*)((gu32*)(KA()->ws + WS_CTL) + CW_BAR);
          for (int jx = 0; jx < 16; ++jx) { const unsigned cnt = __hip_atomic_load(bw + XB_XCNT(jx), __ATOMIC_RELAXED, __HIP_MEMORY_SCOPE_AGENT); if (jx < 8 ? cnt != 32u : cnt != 0u) full = 0u; }
          F.MISC[10] = full; }
      __syncthreads(); }
#ifdef FORCE_SAFE
    const bool safe_mode = __builtin_amdgcn_readfirstlane((int)F.MISC[10]) != 12345;
#else
    const bool safe_mode = __builtin_amdgcn_readfirstlane((int)F.MISC[10]) == 0;
#endif
#pragma unroll 1
#ifdef PROBE_DUPCH
    for (int pc = -PROBE_NDUP; pc < 5; ++pc) {
        const int chain = pc < 0 ? PROBE_DUPCH : pc; const int j = chain >> 1;
        FRESH(); pg8::gemm_chain(F.lds + RING_OFF, F.MISC + 16, F.lds + RDYSLOT_OFF, (LAS unsigned long long*)(F.lds + EXTRA_OFF), chain, pc < 0 ? 5 - (pc + 1) : chain, safe_mode);
        if (pc < 0) { GRID_BAR(); continue; }
#else
    for (int chain = 0; chain < 5; ++chain) {
        const int j = chain >> 1;
#if defined(PROBE_TIME) && PROBE_SEG == 3
        unsigned long long pc0_ = PROBE_TIME == 1 ? __builtin_amdgcn_s_memrealtime() : __builtin_amdgcn_s_memtime();
#endif
        FRESH(); pg8::gemm_chain(F.lds + RING_OFF, F.MISC + 16, F.lds + RDYSLOT_OFF, (LAS unsigned long long*)(F.lds + EXTRA_OFF), chain, chain, safe_mode);
#if defined(PROBE_TIME) && PROBE_SEG == 3
        if (chain == PROBE_CH && blockIdx.x == PROBE_WG && threadIdx.x == 0) { const unsigned long long pc1_ = PROBE_TIME == 1 ? __builtin_amdgcn_s_memrealtime() : __builtin_amdgcn_s_memtime(); F.MISC[60] = F.MISC[60] + (unsigned)(pc1_ - pc0_); }
#endif
#endif
        if (chain == 4) break;
        if ((chain & 1) == 0) { FRESH(); cache_to_rings(F, j); }
        GRID_BAR(); PT_MARK((PROBE_ONECH < 0 || chain == PROBE_ONECH) ? 1 : 7);
        if ((chain & 1) == 0) {
            FRESH(); attn_phase(F, j);
#ifdef DUP_ATT
            GRID_BAR(); FRESH(); attn_phase(F, j);
#endif
            GRID_BAR(); PT_MARK(2);
        } else {
            FRESH(); for (int u = F.vcu; u < N_MUNITS; u += F.G) mlstm_a_unit(F, j, u);
            GRID_BAR(); PT_MARK(3);
#ifdef DUP_MA
            FRESH(); for (int u = F.vcu; u < N_MUNITS; u += F.G) mlstm_a_unit(F, j, u);
            GRID_BAR();
#endif
#ifdef DUP_MB
            FRESH(); mlstm_b_phase(F, j, true);
            GRID_BAR();
#endif
            FRESH(); mlstm_b_phase(F, j);
            GRID_BAR(); PT_MARK(4);
#ifdef DUP_MC
            FRESH(); for (int u = F.vcu; u < N_MUNITS; u += F.G) mlstm_c_unit(F, j, u, true);
            GRID_BAR();
#endif
            FRESH(); for (int u = F.vcu; u < N_MUNITS; u += F.G) mlstm_c_unit(F, j, u);
            GRID_BAR(); PT_MARK(5);
        }
    }
    PT_MARK(1);
#if defined(PROBE_TIME) || defined(PROBE_PHC) || defined(PROBE_ATT) || defined(PROBE_MA) || defined(PROBE_MC)
    if (blockIdx.x == PROBE_WG && threadIdx.x == 0) { const unsigned tot = F.MISC[60], cnt = F.MISC[61];
        const unsigned long long wait_ticks = cnt ? (unsigned long long)((float)tot * (float)(PROBE_SCALE * 100.0) / (float)cnt) : 0ull;
        const unsigned long long t0 = __builtin_amdgcn_s_memrealtime(); while (__builtin_amdgcn_s_memrealtime() - t0 < wait_ticks) __builtin_amdgcn_s_sleep(8); }
#endif
#ifdef PROBE_LAST
    if (threadIdx.x == 0) { unsigned* cw_ = (unsigned*)KA()->ws + 12064; const unsigned n_ = __hip_atomic_fetch_add(cw_, 1u, __ATOMIC_RELAXED, __HIP_MEMORY_SCOPE_AGENT);
        if (n_ == gridDim.x - 1) { const unsigned long long st_ = __hip_atomic_load((unsigned long long*)((gu32*)(KA()->ws + WS_CTL) + 12000), __ATOMIC_RELAXED, __HIP_MEMORY_SCOPE_AGENT);
            const unsigned long long t0 = __builtin_amdgcn_s_memrealtime(); const unsigned long long wait_ticks = (unsigned long long)((float)(t0 - st_) * (float)PROBE_SCALE);
            while (__builtin_amdgcn_s_memrealtime() - t0 < wait_ticks) __builtin_amdgcn_s_sleep(8); } }
#endif
#undef GRID_BAR
}

extern "C" void kernel_launch(void* const* d_in, const int* in_sizes, int n_in, void* d_out, int out_size, void* d_ws, size_t ws_size, hipStream_t stream) {
    static int grid = 0;
    if (grid == 0) {
        if (n_in != 24 || (size_t)out_size != O_END || ws_size < WS_END) { fprintf(stderr, "kernel_launch: unexpected shapes: n_in %d out %d ws %zu (need %zu)\n", n_in, out_size, ws_size, (size_t)WS_END); grid = -1; return; }
        int dev = 0, cus = 0, per_cu = 0;
        if (hipGetDevice(&dev) != hipSuccess || hipDeviceGetAttribute(&cus, hipDeviceAttributeMultiprocessorCount, dev) != hipSuccess) { fprintf(stderr, "kernel_launch: device query failed\n"); grid = -1; return; }
        if (hipFuncSetAttribute((const void*)hybrid_fwd, hipFuncAttributeMaxDynamicSharedMemorySize, LDS_BYTES) != hipSuccess) { fprintf(stderr, "kernel_launch: hipFuncSetAttribute failed\n"); grid = -1; return; }
        if (hipOccupancyMaxActiveBlocksPerMultiprocessor(&per_cu, (const void*)hybrid_fwd, NWAVES * 64, LDS_BYTES) != hipSuccess || per_cu < 1)
            fprintf(stderr, "kernel_launch: note: occupancy query reports %d workgroups per CU\n", per_cu);
        (void)hipGetLastError();
        grid = cus;
    }
    if (grid < 0) return;
    if (hipMemsetAsync((char*)d_ws + WS_CTL, 0, CTL_ZERO_BYTES, stream) != hipSuccess) { fprintf(stderr, "kernel_launch: hipMemsetAsync failed\n"); return; }
    Args a{};
    for (int i = 0; i < 24; ++i) a.in[i] = (const float*)d_in[i];
    a.out = (float*)d_out; a.ws = (unsigned char*)d_ws;
    hipLaunchKernelGGL(hybrid_fwd, dim3(grid), dim3(NWAVES * 64), LDS_BYTES, stream, a);
    const hipError_t le = hipPeekAtLastError();
    if (le != hipSuccess) fprintf(stderr, "kernel_launch: launch failed: %s\n", hipGetErrorName(le));
}
```

```cpp
#include <hip/hip_runtime.h>
#include <cstdio>
#include <cstdint>
constexpr int MP = 16384, MS = 1024, MT = 17408, D = 1024, FF = 4096, NQKV = 3072, NMIN = 4352  , NMIN_REAL = 4104;
constexpr int HIDP = 4096 + 64;
constexpr int N_MUNITS = 576;
constexpr size_t SLAB_BYTES = 272 * 256 * 2;
constexpr size_t O_Y = 0, O_KP = 17825792, O_VP = 18874368, O_KS = 19922944, O_VS = 22020096, O_CP = 24117248, O_NP = 24641536, O_MP = 24643584, O_BP = 24643592,
                 O_CS = 24655880, O_NS = 33044488, O_MS = 33077256, O_BS = 33077384, O_END = 33273992;
constexpr size_t MiB = 1u << 20;
constexpr size_t WS_CTL = 0, WS_SSQ = MiB / 2, CTL_ZERO_BYTES = 2 * MiB;
constexpr float SSQ_FIX = 268435456.0f, SSQ_UNFIX = 1.0f / 268435456.0f;
constexpr size_t WS_WINA = 2 * MiB, WS_WOA = 14 * MiB, WS_WINB = 18 * MiB, WS_WOB = 35 * MiB, WS_WUP = 39 * MiB, WS_WDN = 71 * MiB;
constexpr size_t WS_XB = 104 * MiB, WS_GATES = 139 * MiB, WS_STATS = 140 * MiB;
constexpr size_t WS_MIX = 141 * MiB, WS_HID = 175 * MiB, WS_NXT = 320 * MiB, WS_END = 422 * MiB;
constexpr size_t WS_Q = WS_MIX, WS_O = WS_MIX, WS_OG = WS_MIX;
constexpr size_t WS_KP = WS_NXT, WS_VP = WS_NXT + 32 * MiB, WS_RK = WS_NXT + 64 * MiB, WS_RV = WS_NXT + 82 * MiB;
constexpr size_t WS_QKP = WS_NXT, WS_V = WS_NXT + 68 * MiB;
constexpr size_t WS_QC = WS_HID, WS_KC = WS_HID + 34 * MiB, WS_SLAB = WS_HID + 68 * MiB;
static_assert(WS_SLAB + (size_t)N_MUNITS * SLAB_BYTES <= WS_NXT && WS_RV + 18 * MiB <= WS_END && WS_V + 34 * MiB <= WS_END && WS_HID + (size_t)MT * HIDP * 2 <= WS_NXT, "d_ws map");
constexpr int CW_BAR = 4096;
constexpr int RING_OFF = 0, RING_BYTES = 131072, EXTRA_OFF = RING_BYTES, EXTRA_BYTES = 28672  , EPITR_OFF = EXTRA_OFF + 12288, LDSCTL_OFF = EXTRA_OFF + EXTRA_BYTES, MISC_OFF = LDSCTL_OFF + 320, RDYSLOT_OFF = LDSCTL_OFF + 1024  ;
constexpr int LDS_BYTES = 163840;
static_assert(MISC_OFF + 128 <= LDS_BYTES, "LDS map");
constexpr int NWAVES = 8;

namespace pg8 {
#define PG8_LAS __attribute__((address_space(3)))
typedef unsigned short bf16_t;
typedef short bf16x8 __attribute__((ext_vector_type(8)));
typedef float f32x4 __attribute__((ext_vector_type(4)));
typedef unsigned u32x4 __attribute__((ext_vector_type(4)));
constexpr int BM = 256, BK = 64, HALF = 128, HTB = HALF * BK * 2  , STAGE_BYTES = 8 * HTB, NXCD = 8, WGM = 8;

__host__ __device__ __forceinline__ int lds_byte(int r, int c) { const int st = (r >> 4) * 2 + (c >> 5), rr = r & 15, cc = c & 31, ob = rr * 64 + cc * 2; return st * 1024 + (ob ^ (((ob >> 9) & 1) << 5)); }
__host__ __device__ __forceinline__ void stage_rc(int b, int& R, int& C) { const int st = b / 1024, sb = b % 1024, swz = sb ^ (((sb >> 9) & 1) << 5); R = (st >> 1) * 16 + swz / 64; C = (st & 1) * 32 + (swz % 64) / 2; }
__host__ __device__ __forceinline__ int perm32(int rho) { const int n = rho >> 4, i = rho & 15; return 8 * (i >> 2) + 4 * n + (i & 3); }

struct Unit { int pm, pn; };
struct Gemm { const bf16_t* A; const bf16_t* Bt; int M, N, K; };

struct StaticOrder {
    int nM, nN, nwg, G, c;
    __host__ __device__ void init(int M, int N, int G_, int c_) { nM = M / BM; nN = N / BM; nwg = nM * nN; G = G_; c = c_; }
    __host__ __device__ bool next(int i, Unit& u) const {
        const long L = (long)i * G + c; if (L >= nwg) return false;
        int wgid = (int)L; { const int q = nwg / NXCD, r = nwg % NXCD, xcd = wgid % NXCD, off = wgid / NXCD; wgid = (xcd < r ? xcd * (q + 1) : r * (q + 1) + (xcd - r) * q) + off; }
        const int nig = WGM * nN, gid = wgid / nig, fm = gid * WGM, gsz = (nM - fm) < WGM ? (nM - fm) : WGM;
        u.pm = fm + ((wgid % nig) % gsz); u.pn = (wgid % nig) / gsz; return true;
    }
    __device__ __forceinline__ void a_ready(const Unit&) const {}
    __device__ __forceinline__ void done(const Unit&) const {}
};

constexpr int MP_ROWS = MP, MS_ROWS = MS, DM = D;
constexpr size_t BLK_KT = 32768, BLK_AI = 16384;
__host__ __device__ __forceinline__ constexpr int blk_img(int wr, int wcl, int m, int fr, int fq) { return ((4 * wr + m) * 2 + wcl) * 1024 + ((fr * 64 + fq * 16) ^ ((fr >> 3) << 5)); }
constexpr float NEPS = 1e-6f;
struct Args { const float* in[24]; float* out; unsigned char* ws; };
typedef const __attribute__((address_space(4))) Args* KArgs;
__device__ __forceinline__ KArgs KA() { KArgs p = (KArgs)__builtin_amdgcn_kernarg_segment_ptr(); asm volatile("" : "+s"(p)); return p; }
typedef float f32x2_e __attribute__((ext_vector_type(2))); typedef __bf16 bf16x2_e __attribute__((ext_vector_type(2)));
__device__ __forceinline__ unsigned cvt_pk_bf16(float lo, float hi) { f32x2_e v = {lo, hi}; bf16x2_e b = __builtin_convertvector(v, bf16x2_e); return __builtin_bit_cast(unsigned, b); }
__device__ __forceinline__ u32x4 pack8(const f32x4 v0, const f32x4 v1) { u32x4 w; w.x = cvt_pk_bf16(v0[0], v0[1]); w.y = cvt_pk_bf16(v0[2], v0[3]); w.z = cvt_pk_bf16(v1[0], v1[1]); w.w = cvt_pk_bf16(v1[2], v1[3]); return w; }
typedef __amdgpu_buffer_rsrc_t rsrc_t;
__device__ __forceinline__ rsrc_t mk_rsrc(const void* p, unsigned bytes) { return __builtin_amdgcn_make_buffer_rsrc((void*)p, 0, (int)bytes, 0x00020000); }
__device__ __forceinline__ f32x4 bld16(rsrc_t r, unsigned off) { return __builtin_bit_cast(f32x4, __builtin_amdgcn_raw_buffer_load_b128(r, (int)off, 0, 16)); }
__device__ __forceinline__ void bst16(rsrc_t r, unsigned off, u32x4 v, bool wt) { if (wt) __builtin_amdgcn_raw_buffer_store_b128(v, r, (int)off, 0, 16); else __builtin_amdgcn_raw_buffer_store_b128(v, r, (int)off, 0, 0); }
__device__ __forceinline__ void bst16(rsrc_t r, unsigned off, f32x4 v, bool wt) { bst16(r, off, __builtin_bit_cast(u32x4, v), wt); }
__device__ __forceinline__ void epi_tr(PG8_LAS unsigned char* slot, int fr, int fq, const u32x4 in0, const u32x4 in1, u32x4& out0, u32x4& out1) {
    const int lane = fq * 16 + fr, r = lane >> 3, c = lane & 7;
    asm volatile("" ::: "memory");
    *(PG8_LAS u32x4*)(slot + fr * 128 + ((fq ^ (fr & 7)) * 16)) = in0;
    *(PG8_LAS u32x4*)(slot + fr * 128 + (((4 + fq) ^ (fr & 7)) * 16)) = in1;
    asm volatile("s_waitcnt lgkmcnt(0)" ::: "memory");
    out0 = *(const PG8_LAS u32x4*)(slot + r * 128 + ((c ^ (r & 7)) * 16));
    out1 = *(const PG8_LAS u32x4*)(slot + (8 + r) * 128 + ((c ^ (r & 7)) * 16));
    asm volatile("s_waitcnt lgkmcnt(0)" ::: "memory");
}
template <int NAI> __device__ __forceinline__ void row_scales(const unsigned long long* ssqk, int row0, float (&rs)[NAI][4], const PG8_LAS unsigned long long* sl = nullptr, int lrow0 = 0) {
    unsigned long long raw[NAI][4];
    if (sl) {
#pragma unroll
        for (int ai = 0; ai < NAI; ++ai)
#pragma unroll
            for (int m = 0; m < 4; ++m) raw[ai][m] = sl[lrow0 + ai * HALF + m * 16];
    } else {
#pragma unroll
        for (int ai = 0; ai < NAI; ++ai)
#pragma unroll
            for (int m = 0; m < 4; ++m) raw[ai][m] = __hip_atomic_load(ssqk + row0 + ai * HALF + m * 16, __ATOMIC_RELAXED, __HIP_MEMORY_SCOPE_AGENT);
    }
#pragma unroll
    for (int ai = 0; ai < NAI; ++ai)
#pragma unroll
        for (int m = 0; m < 4; ++m) rs[ai][m] = 1.0f / sqrtf((float)raw[ai][m] * (SSQ_UNFIX / 1024.0f) + NEPS);
}

struct EpiRes {
    int last, kout, dry, wt;
    __device__ __forceinline__ void operator()(const f32x4 (&acc)[2][2][4][2], const Unit& u, int wr, int wc, int fr, int fq) const { run<2>(acc, u.pm * BM + wr * 64, u.pn, wc, fr, fq); }
    template <int NAI> __device__ __forceinline__ void run(const f32x4 (&acc)[NAI][2][4][2], int rowbase, int pn, int wc, int fr, int fq) const {
        KArgs ka = KA(); float* out = ka->out; unsigned char* ws = ka->ws; unsigned long long* ssq = (unsigned long long*)(ws + WS_SSQ) + (size_t)kout * MT;
        const rsrc_t rb = mk_rsrc(ws + WS_XB, MT * D * 2u);
        const rsrc_t ro = dry ? mk_rsrc(ws + WS_NXT, MT * D * 4u) : mk_rsrc(out, MT * D * 4u), rx = dry ? mk_rsrc(ws + WS_NXT + 68 * MiB, MT * D * 2u) : rb;
        const int row0 = rowbase + fr, col0 = pn * BM + wc * 32 + 8 * fq;
        const unsigned xo = (unsigned)(rowbase >> 8) * (256u * DM * 2u) + (unsigned)(4 * pn + (wc >> 1)) * (unsigned)BLK_KT + (unsigned)blk_img((rowbase >> 6) & 1, wc & 1, 0, fr, fq);
#pragma unroll
        for (int ai = 0; ai < NAI; ++ai) {
            u32x4 b[4][2];
#pragma unroll
            for (int m = 0; m < 4; ++m)
#pragma unroll
                for (int bj = 0; bj < 2; ++bj) b[m][bj] = __builtin_bit_cast(u32x4, bld16(rb, xo + (unsigned)(2 * bj * (int)BLK_KT + ai * (int)BLK_AI + m * 2048)));
#pragma unroll
            for (int m = 0; m < 4; ++m) {
                const int row = row0 + ai * HALF + m * 16; const unsigned eo = (unsigned)(row * DM + col0);
                float ss = 0.f;
#pragma unroll
                for (int bj = 0; bj < 2; ++bj) {
                    const u32x4 w = b[m][bj];
                    const f32x4 b0 = {__uint_as_float(w.x << 16), __uint_as_float(w.x & 0xffff0000u), __uint_as_float(w.y << 16), __uint_as_float(w.y & 0xffff0000u)};
                    const f32x4 b1 = {__uint_as_float(w.z << 16), __uint_as_float(w.z & 0xffff0000u), __uint_as_float(w.w << 16), __uint_as_float(w.w & 0xffff0000u)};
                    const f32x4 v0 = acc[ai][bj][m][0] + b0, v1 = acc[ai][bj][m][1] + b1;
                    if (last) { bst16(ro, (eo + bj * HALF) * 4u, v0, wt); bst16(ro, (eo + bj * HALF) * 4u + 16u, v1, wt); }
                    else bst16(rx, xo + (unsigned)(2 * bj * (int)BLK_KT + ai * (int)BLK_AI + m * 2048), pack8(v0, v1), wt);
                    ss += (v0[0] * v0[0] + v0[1] * v0[1]) + (v0[2] * v0[2] + v0[3] * v0[3]) + (v1[0] * v1[0] + v1[1] * v1[1]) + (v1[2] * v1[2] + v1[3] * v1[3]);
                }
                ss += __shfl_xor(ss, 16); ss += __shfl_xor(ss, 32);
                if (fq == 0) atomicAdd(ssq + row, (unsigned long long)(ss * SSQ_FIX));
            }
            asm volatile("" ::: "memory");
        }
    }
};

struct EpiUp {
    int kin, wt; const PG8_LAS unsigned long long* sl;
    __device__ __forceinline__ void operator()(const f32x4 (&acc)[2][2][4][2], const Unit& u, int wr, int wc, int fr, int fq) const { run<2>(acc, u.pm * BM + wr * 64, u.pn, wc, fr, fq); }
    template <int NAI> __device__ __forceinline__ void run(const f32x4 (&acc)[NAI][2][4][2], int rowbase, int pn, int wc, int fr, int fq) const {
        KArgs ka = KA(); unsigned char* ws = ka->ws; const unsigned long long* ssq = (const unsigned long long*)(ws + WS_SSQ) + (size_t)kin * MT;
        const rsrc_t rh = mk_rsrc(ws + WS_HID, MT * (unsigned)HIDP * 2u);
        const int row0 = rowbase + fr;
        const unsigned ho = (unsigned)(rowbase >> 8) * (256u * FF * 2u) + (unsigned)(4 * pn + (wc >> 1)) * (unsigned)BLK_KT + (unsigned)blk_img((rowbase >> 6) & 1, wc & 1, 0, fr, fq);
        float rs[NAI][4]; row_scales<NAI>(ssq, row0, rs, sl, (rowbase & 255) + fr);
#pragma unroll
        for (int ai = 0; ai < NAI; ++ai)
#pragma unroll
            for (int m = 0; m < 4; ++m) {
#pragma unroll
                for (int bj = 0; bj < 2; ++bj) {
                    f32x4 v0 = acc[ai][bj][m][0] * rs[ai][m], v1 = acc[ai][bj][m][1] * rs[ai][m];
#pragma unroll
                    for (int i = 0; i < 4; ++i) { const float a = fmaxf(v0[i], 0.f), b = fmaxf(v1[i], 0.f); v0[i] = a * a; v1[i] = b * b; }
                    bst16(rh, ho + (unsigned)(2 * bj * (int)BLK_KT + ai * (int)BLK_AI + m * 2048), pack8(v0, v1), wt);
                }
            }
    }
};

struct EpiQKV {
    int j, kin; const PG8_LAS unsigned long long* sl; PG8_LAS unsigned char* slot;
    __device__ __forceinline__ void operator()(const f32x4 (&acc)[2][2][4][2], const Unit& u, int wr, int wc, int fr, int fq) const { run<2>(acc, u.pm * BM + wr * 64, u.pn, wc, fr, fq); }
    template <int NAI> __device__ __forceinline__ void run(const f32x4 (&acc)[NAI][2][4][2], int rowbase, int pn, int wc, int fr, int fq) const {
        KArgs ka = KA(); unsigned char* ws = ka->ws; float* out = ka->out; const unsigned long long* ssq = (const unsigned long long*)(ws + WS_SSQ) + (size_t)kin * MT; const float* qg = ka->in[12] + j * 64; const float* kg = ka->in[13] + j * 64;
        bf16_t *Q = (bf16_t*)(ws + WS_Q), *KP = (bf16_t*)(ws + WS_KP), *VP = (bf16_t*)(ws + WS_VP), *RK = (bf16_t*)(ws + WS_RK), *RV = (bf16_t*)(ws + WS_RV);
        float *okp = out + O_KP + (size_t)j * 512 * DM, *ovp = out + O_VP + (size_t)j * 512 * DM, *oks = out + O_KS + (size_t)j * MS_ROWS * DM, *ovs = out + O_VS + (size_t)j * MS_ROWS * DM;
        const int t = pn >> 2, head = (pn & 3) * 4 + wc;
        const int row0 = rowbase + fr;
        float rs[NAI][4]; row_scales<NAI>(ssq, row0, rs, sl, (rowbase & 255) + fr);
        f32x4 g[2][2];
        const float* gp = (t == 0) ? qg : kg;
#pragma unroll
        for (int bj = 0; bj < 2; ++bj)
#pragma unroll
            for (int n = 0; n < 2; ++n) { g[bj][n] = (t < 2) ? *(const f32x4*)(gp + 32 * bj + 8 * fq + 4 * n) : (f32x4){1.f, 1.f, 1.f, 1.f}; if (t == 0) g[bj][n] = g[bj][n] * (0.125f * 1.4426950408889634f); }
#pragma unroll
        for (int ai = 0; ai < NAI; ++ai)
#pragma unroll
            for (int m = 0; m < 4; ++m) {
                const int row = row0 + ai * HALF + m * 16;
                f32x4 v[2][2]; float ss = 0.f;
#pragma unroll
                for (int bj = 0; bj < 2; ++bj)
#pragma unroll
                    for (int n = 0; n < 2; ++n) { v[bj][n] = acc[ai][bj][m][n] * rs[ai][m]; const f32x4 x = v[bj][n]; ss += (x[0] * x[0] + x[1] * x[1]) + (x[2] * x[2] + x[3] * x[3]); }
                if (t < 2) {
                    ss += __shfl_xor(ss, 16); ss += __shfl_xor(ss, 32);
                    const float rr = 1.0f / sqrtf(ss * (1.0f / 64.0f) + NEPS);
#pragma unroll
                    for (int bj = 0; bj < 2; ++bj)
#pragma unroll
                        for (int n = 0; n < 2; ++n) v[bj][n] = v[bj][n] * rr * g[bj][n];
                }
                {
                    u32x4 o0, o1; epi_tr(slot, fr, fq, pack8(v[0][0], v[0][1]), pack8(v[1][0], v[1][1]), o0, o1);
                    const int ln = fq * 16 + fr, col = head * 64 + (ln & 7) * 8;
#pragma unroll
                    for (int h = 0; h < 2; ++h) {
                        const int rw = rowbase + ai * HALF + m * 16 + 8 * h + (ln >> 3);
                        bf16_t* dstb;
                        if (t == 0) dstb = Q + (size_t)rw * DM + col;
                        else if (rw < MP_ROWS) dstb = (t == 1 ? KP : VP) + (size_t)rw * DM + col;
                        else { const int sr = rw - MP_ROWS, b = sr >> 6, tt = sr & 63; dstb = (t == 1 ? RK : RV) + ((size_t)b * 576 + 512 + tt) * DM + col; }
                        *(u32x4*)dstb = h ? o1 : o0;
                    }
                }
                if (t != 0 && (row >= MP_ROWS - 512)) {
#pragma unroll
                    for (int bj = 0; bj < 2; ++bj) {
                        const int col = head * 64 + 32 * bj + 8 * fq;
                        float* dstf;
                        if (row < MP_ROWS) dstf = (t == 1 ? okp : ovp) + (size_t)(row - (MP_ROWS - 512)) * DM + col;
                        else dstf = (t == 1 ? oks : ovs) + (size_t)(row - MP_ROWS) * DM + col;
                        *(f32x4*)dstf = v[bj][0]; *(f32x4*)(dstf + 4) = v[bj][1];
                    }
                }
            }
    }
};

struct EpiMIn {
    int j, kin; const PG8_LAS unsigned long long* sl; PG8_LAS unsigned char* slot;
    __device__ __forceinline__ void operator()(const f32x4 (&acc)[2][2][4][2], const Unit& u, int wr, int wc, int fr, int fq) const { run<2>(acc, u.pm * BM + wr * 64, u.pn, wc, fr, fq); }
    template <int NAI> __device__ __forceinline__ void run(const f32x4 (&acc)[NAI][2][4][2], int rowbase, int pn, int wc, int fr, int fq) const {
        KArgs ka = KA(); unsigned char* ws = ka->ws; float* out = ka->out; const unsigned long long* ssq = (const unsigned long long*)(ws + WS_SSQ) + (size_t)kin * MT; const float* b_i = ka->in[16] + j * 4; const float* b_f = ka->in[17] + j * 4;
        bf16_t *QKP = (bf16_t*)(ws + WS_QKP), *V = (bf16_t*)(ws + WS_V), *OG = (bf16_t*)(ws + WS_OG); float* gates = (float*)(ws + WS_GATES);
        float *ocp = out + O_BP + (size_t)j * 3 * 2048, *ocs = out + O_BS + (size_t)j * 16 * 3 * 2048;
        const int row0 = rowbase + fr, cl0 = wc * 32 + 8 * fq;
        if (pn == 16 && !(wc == 0 && fq == 0)) return;
        float rs[NAI][4]; row_scales<NAI>(ssq, row0, rs, sl, (rowbase & 255) + fr);
#pragma unroll
        for (int ai = 0; ai < NAI; ++ai)
#pragma unroll
            for (int m = 0; m < 4; ++m) {
                const int row = row0 + ai * HALF + m * 16;
                if (pn == 16) {
                    const f32x4 gi = acc[ai][0][m][0] * rs[ai][m] + *(const f32x4*)b_i, gf = acc[ai][0][m][1] * rs[ai][m] + *(const f32x4*)b_f;
                    f32x4 lf;
#pragma unroll
                    for (int i = 0; i < 4; ++i) lf[i] = fminf(gf[i], 0.f) - log1pf(expf(-fabsf(gf[i])));
                    *(f32x4*)(gates + (size_t)row * 8) = gi; *(f32x4*)(gates + (size_t)row * 8 + 4) = lf;
                    continue;
                }
                u32x4 wq[2];
#pragma unroll
                for (int bj = 0; bj < 2; ++bj) {
                    f32x4 v0 = acc[ai][bj][m][0] * rs[ai][m], v1 = acc[ai][bj][m][1] * rs[ai][m];
                    if (pn < 8) {
                        const int col = pn * BM + cl0 + bj * HALF;
                        float* dstf = nullptr;
                        if (row < MP_ROWS) { if (row >= MP_ROWS - 3) dstf = ocp + (size_t)(row - (MP_ROWS - 3)) * 2048 + col; }
                        else { const int sr = row - MP_ROWS, b = sr >> 6, tt = sr & 63; if (tt >= 61) dstf = ocs + ((size_t)b * 3 + (tt - 61)) * 2048 + col; }
                        if (dstf) { *(f32x4*)dstf = v0; *(f32x4*)(dstf + 4) = v1; }
                    } else if (pn >= 12) {
#pragma unroll
                        for (int i = 0; i < 4; ++i) { v0[i] = __builtin_amdgcn_rcpf(1.0f + __expf(-v0[i])); v1[i] = __builtin_amdgcn_rcpf(1.0f + __expf(-v1[i])); }
                    }
                    wq[bj] = pack8(v0, v1);
                }
                {
                    u32x4 o0, o1; epi_tr(slot, fr, fq, wq[0], wq[1], o0, o1);
                    const int ln = fq * 16 + fr, cl = wc * 32 + (ln & 3) * 8 + ((ln >> 2) & 1) * HALF;
                    bf16_t* dst = (pn < 8) ? QKP + (size_t)pn * BM + cl : (pn < 12) ? V + (size_t)(pn - 8) * BM + cl : OG + (size_t)(pn - 12) * BM + cl;
                    const int pitch = (pn < 8) ? 2048 : DM;
                    const int rw = rowbase + ai * HALF + m * 16 + (ln >> 3);
                    *(u32x4*)(dst + (size_t)rw * pitch) = o0; *(u32x4*)(dst + (size_t)(rw + 8) * pitch) = o1;
                }
            }
    }
};
}

namespace pg8 {
constexpr int CW_Q = 8192, CW_RDY = 16384;
struct UnitX { const char* A; const char* B; int K, lda, pm, pn, stage; };
__device__ __forceinline__ int chain_nn3(int chain) { return (chain == 4) ? 0 : ((chain & 1) ? 17 : 12); }
__device__ __forceinline__ int chain_scnt(int nN, int q) { return (4 * nN - q + 7) >> 3; }
__device__ __forceinline__ int chain_total(int chain, int q) {
    const int n3 = chain_nn3(chain), t3 = n3 ? chain_scnt(n3, q) + 8 * n3 : 0;
    return chain == 0 ? t3 : (2 + 32) + (8 + 128) + (2 + 32) + t3;
}
__device__ __forceinline__ void chain_decode(int chain, int q, int L, UnitX& u, int& need) {
    KArgs ka = KA(); const unsigned char* ws = ka->ws;
    int s, i, samp = 0;
    if (chain == 0) { s = 3; i = L; }
    else if (L < 34) { s = 0; i = L; samp = 2; }
    else if (L < 172) {
        const int x = L - 34;
        if (x < 56) { s = 1; i = x; samp = 8; } else if (x < 58) { s = 2; i = x - 56; samp = 2; } else { s = 1; i = x - 2; samp = 8; }
    }
    else if (L < 204) { s = 2; i = L - 172 + 2; samp = 2; }
    else { s = 3; i = L - 204; }
    const int l = chain - 1, lin = chain;
    int nN, K = 1024; const unsigned char *A, *B;
    if (s == 0)      { nN = 4;  A = ws + WS_MIX; B = ws + ((l & 1) ? WS_WOB : WS_WOA) + (size_t)(l >> 1) * 1024 * 1024 * 2; }
    else if (s == 1) { nN = 16; A = ws + WS_XB;  B = ws + WS_WUP + (size_t)l * 4096 * 1024 * 2; }
    else if (s == 2) { nN = 4;  A = ws + WS_HID; B = ws + WS_WDN + (size_t)l * HIDP * 1024 * 2; K = 4096; }
    else             { nN = (lin & 1) ? 17 : 12; A = ws + WS_XB; B = (lin & 1) ? ws + WS_WINB + (size_t)(lin >> 1) * 4352 * 1024 * 2 : ws + WS_WINA + (size_t)(lin >> 1) * 3072 * 1024 * 2; samp = chain_scnt(nN, q); }
    if (i < samp) { const int e = q + 8 * i, sp = e / nN; u.pm = 64 + sp; u.pn = e - sp * nN; }
    else { const int ip = i - samp, gsz = 4 * nN, g = ip >= gsz ? 1 : 0, r = ip - g * gsz; u.pm = q + 8 * (4 * g + (r & 3)); u.pn = r >> 2; }
    u.K = K; u.stage = s; u.lda = (s == 2) ? HIDP : K;
    u.A = (const char*)A + (size_t)u.pm * 256 * K * 2; u.B = (const char*)B + (size_t)u.pn * 256 * K * 2;
    need = (s == 1) ? 32 : (s == 2) ? 128 : (s == 3 && chain > 0) ? 32 : 0;
}
__device__ __forceinline__ int chain_kin(int chain, int stage, bool dry) { return stage == 1 ? (dry ? 6 : 2 * chain - 1) : (stage == 3 ? 2 * chain : -1); }
__device__ __forceinline__ void chain_epilogue(int chain, bool dry, bool wt, const PG8_LAS unsigned long long* sl, PG8_LAS unsigned char* slot, const UnitX& u, const f32x4 (&acc)[2][2][4][2], int wr, int wc, int fr, int fq) {
    const int rowbase = u.pm * BM + wr * 64;
    if (u.stage == 0 || u.stage == 2) { EpiRes E{(chain == 4 && u.stage == 2 && !dry) ? 1 : 0, dry ? 9 : 2 * chain - 1 + (u.stage >> 1), dry ? 1 : 0, wt ? 1 : 0}; E.run<2>(acc, rowbase, u.pn, wc, fr, fq); }
    else if (u.stage == 1) { EpiUp E{chain_kin(chain, 1, dry), wt ? 1 : 0, sl}; E.run<2>(acc, rowbase, u.pn, wc, fr, fq); }
    else if (chain & 1) { EpiMIn E{chain >> 1, 2 * chain, sl, slot}; E.run<2>(acc, rowbase, u.pn, wc, fr, fq); }
    else { EpiQKV E{chain >> 1, 2 * chain, sl, slot}; E.run<2>(acc, rowbase, u.pn, wc, fr, fq); }
}

__device__ __forceinline__ void gemm_chain(PG8_LAS unsigned char* lds, volatile PG8_LAS unsigned* bx  , PG8_LAS unsigned char* rslot  , PG8_LAS unsigned long long* sslot  , const int chain, const int cchain  , const bool safe  ) {
    int tid_ = threadIdx.x; asm volatile("" : "+v"(tid_));
    const int tid = tid_, wid = __builtin_amdgcn_readfirstlane(tid >> 6), lane = tid & 63, wr = wid >> 2, wc = wid & 3, fr = lane & 15, fq = lane >> 4;
    unsigned* const ctl = (unsigned*)KA()->ws;
    unsigned* const qw = ctl + CW_Q + 64 * 8 * cchain;
    unsigned* const rdy = ctl + CW_RDY + (size_t)cchain * 3 * 68 * 64;
#define CH_VOFF(LA_, BLK_, vA_, vB_) do { _Pragma("unroll") for (int i_ = 0; i_ < 2; ++i_) { int R_, C_; stage_rc(tid * 16 + i_ * 8192, R_, C_); const int Rb_ = (R_ & ~31) + perm32(R_ & 31); \
        vA_[i_] = (BLK_) ? (unsigned)(tid * 16 + i_ * 8192) : (unsigned)(R_ * (LA_) + C_) * 2u; vB_[i_] = (unsigned)(tid * 16 + i_ * 8192); (void)Rb_; } } while (0)
    const size_t kstep = (size_t)(BK * 2);
    const unsigned ldsw = (unsigned)wid * 1024u;
    const int aoff = lds_byte(wr * 64 + fr, fq * 8), boff = lds_byte(wc * 32 + fr, fq * 8);
#ifndef PG8_A_AUX
#define PG8_A_AUX 16
#endif
#define PG8_SA(b, h) (((b) * 2 + (h)) * HTB)
#define PG8_SB(b, h) ((4 + (b) * 2 + (h)) * HTB)
#define PG8_STAGE_A(bufoff, gbase, voff) do { _Pragma("unroll") for (int _i = 0; _i < 2; ++_i) \
        __builtin_amdgcn_global_load_lds((const unsigned*)((const char*)(gbase) + (voff)[_i]), (PG8_LAS unsigned*)(lds + (bufoff) + ldsw + _i * 8192), 16, 0, PG8_A_AUX); } while (0)
#define PG8_STAGE_B(bufoff, gbase, voff) do { _Pragma("unroll") for (int _i = 0; _i < 2; ++_i) \
        __builtin_amdgcn_global_load_lds((const unsigned*)((const char*)(gbase) + (voff)[_i]), (PG8_LAS unsigned*)(lds + (bufoff) + ldsw + _i * 8192), 16, 0, 0); } while (0)
#define PG8_LDA(dst, b, h) do { _Pragma("unroll") for (int m = 0; m < 4; ++m) _Pragma("unroll") for (int k = 0; k < 2; ++k) dst[m][k] = *(const PG8_LAS bf16x8*)(lds + PG8_SA(b, h) + aoff + m * 2048 + k * 1024); } while (0)
#define PG8_LDB(dst, b, h) do { _Pragma("unroll") for (int n = 0; n < 2; ++n) _Pragma("unroll") for (int k = 0; k < 2; ++k) dst[n][k] = *(const PG8_LAS bf16x8*)(lds + PG8_SB(b, h) + boff + n * 2048 + k * 1024); } while (0)
#define PG8_MMA(ai, bj, At, Bt) do { __builtin_amdgcn_s_setprio(1); _Pragma("unroll") for (int m = 0; m < 4; ++m) _Pragma("unroll") for (int n = 0; n < 2; ++n) _Pragma("unroll") for (int k = 0; k < 2; ++k) \
        acc[ai][bj][m][n] = __builtin_amdgcn_mfma_f32_16x16x32_bf16(Bt[n][k], At[m][k], acc[ai][bj][m][n], 0, 0, 0); __builtin_amdgcn_s_setprio(0); } while (0)
#define PG8_WAIT_V(n) asm volatile("s_waitcnt vmcnt(" #n ")" ::: "memory")
#define PG8_WAIT_L(n) asm volatile("s_waitcnt lgkmcnt(" #n ")" ::: "memory")
#define PG8_BAR __builtin_amdgcn_s_barrier()
#define PG8_SCHED __builtin_amdgcn_sched_barrier(0)
#define PG8_ZERO_ACC() do { _Pragma("unroll") for (int a = 0; a < 2; ++a) _Pragma("unroll") for (int b = 0; b < 2; ++b) _Pragma("unroll") for (int m = 0; m < 4; ++m) _Pragma("unroll") for (int n = 0; n < 2; ++n) acc[a][b][m][n] = (f32x4){0.f, 0.f, 0.f, 0.f}; } while (0)
    unsigned pend = 0u; int par = 0, need_n = 0, upar = 0;
#define CH_SSQ(u) do { upar ^= 1; const int k_ = chain_kin(chain, u.stage, cchain != chain); if (k_ >= 0 && wid == 1) { const unsigned long long* s_ = (const unsigned long long*)(KA()->ws + WS_SSQ) + (size_t)k_ * MT + u.pm * 256 + 2 * lane; \
        _Pragma("unroll") for (int i_ = 0; i_ < 2; ++i_) __builtin_amdgcn_global_load_lds((const unsigned*)(s_ + 128 * i_), (PG8_LAS unsigned*)(sslot + 256 * upar + 128 * i_), 16, 0, 16); } } while (0)
    int qown = (int)(__builtin_amdgcn_s_getreg((3 << 11) | 20) & 7u);
    const int maxsteal = safe ? 7 : 0;
    int qcur = qown, qtried = 0;
#ifndef CH_POP_ASM
#define CH_POP_ASM 0
#endif
#if CH_POP_ASM
#define CH_POP_ISSUE() do { if (wid == 0) { unsigned one_ = 1u; const unsigned* qa_ = qw + 64 * qcur; asm volatile("global_atomic_add %0, %1, %2, off sc0" : "=v"(pend) : "v"(qa_), "v"(one_) : "memory"); } } while (0)
#define CH_POP_WAIT() asm volatile("s_waitcnt vmcnt(8)" : "+v"(pend) :: "memory")
#else
#define CH_POP_ISSUE() do { if (wid == 0 && lane == 0) pend = __hip_atomic_fetch_add(qw + 64 * qcur, 1u, __ATOMIC_RELAXED, __HIP_MEMORY_SCOPE_AGENT); } while (0)
#define CH_POP_WAIT() do {} while (0)
#endif
#ifdef PROBE_NODEP
#define PROBE_NODEP_HOOK() do { if (cchain != chain) need_n = 0; } while (0)
#else
#define PROBE_NODEP_HOOK() do {} while (0)
#endif
#define CH_POP_TAKE(u, ok) do { \
        if (wid == 0) { CH_POP_WAIT(); unsigned L_ = (unsigned)__builtin_amdgcn_readfirstlane((int)pend); int q_ = qcur; \
            while (L_ >= (unsigned)chain_total(chain, q_) && qtried < maxsteal) { ++qtried; qcur = (qcur + 1) & 7; q_ = qcur; \
                unsigned t_ = 0u; if (lane == 0) t_ = __hip_atomic_fetch_add(qw + 64 * q_, 1u, __ATOMIC_RELAXED, __HIP_MEMORY_SCOPE_AGENT); L_ = (unsigned)__builtin_amdgcn_readfirstlane((int)t_); } \
            if (lane == 0) { bx[par * 2] = L_; bx[par * 2 + 1] = (unsigned)q_; } } \
        asm volatile("s_waitcnt lgkmcnt(0)\n\ts_barrier" ::: "memory"); \
        const int Lb_ = __builtin_amdgcn_readfirstlane((int)bx[par * 2]), qb_ = __builtin_amdgcn_readfirstlane((int)bx[par * 2 + 1]); par ^= 1;     ok = Lb_ < chain_total(chain, qb_); \
        if (ok) { chain_decode(chain, qb_, Lb_, u, need_n); PROBE_NODEP_HOOK(); \
            if (need_n && wid == 0) __builtin_amdgcn_global_load_lds(rdy + (size_t)((u.stage - 1) * 68 + u.pm) * 64, (PG8_LAS unsigned*)(rslot + 256 * par), 4, 0, 16); } } while (0)
#define CH_READY(u) do { if (need_n) { \
        if (wid == 0) { unsigned c_ = 0u, sp_ = 0u; \
            for (;;) { c_ = (unsigned)__builtin_amdgcn_readfirstlane((int)__hip_atomic_load(rdy + (size_t)((u.stage - 1) * 68 + u.pm) * 64, __ATOMIC_RELAXED, __HIP_MEMORY_SCOPE_AGENT)); \
                if (c_ >= (unsigned)need_n || ++sp_ > (1u << 20)) break; __builtin_amdgcn_s_sleep(2); } } \
        asm volatile("" ::: "memory"); __builtin_amdgcn_s_barrier(); asm volatile("" ::: "memory"); } } while (0)
#ifdef PROBE_UPOK
#define PROBE_TRY(u, ok) do { if (u.stage == 1) ok = true; } while (0)
#else
#define PROBE_TRY(u, ok) do {} while (0)
#endif
#define CH_TRY(u, ok) do { ok = true; if (need_n) { \
        const unsigned c_ = (unsigned)__builtin_amdgcn_readfirstlane((int)*(volatile PG8_LAS unsigned*)(rslot + 256 * par)); ok = c_ >= (unsigned)need_n; PROBE_TRY(u, ok); } } while (0)
#ifdef PROBE_NODRAIN
#define CH_DRAIN() do {} while (0)
#else
#define CH_DRAIN() asm volatile("s_waitcnt vmcnt(0)" ::: "memory")
#endif
#define CH_DONE(u) do { if (u.stage < 3 && !(chain == 4 && u.stage == 2)) { CH_DRAIN();        \
        if (lane == 0) __hip_atomic_fetch_add(rdy + (size_t)(u.stage * 68 + u.pm) * 64, 1u, __ATOMIC_RELAXED, __HIP_MEMORY_SCOPE_AGENT); } } while (0)

    UnitX cur, nxt; bool have;
    CH_POP_ISSUE(); asm volatile("s_waitcnt vmcnt(0)" : "+v"(pend) :: "memory"); CH_POP_TAKE(cur, have);
    if (!have) return;
    f32x4 acc[2][2][4][2];
    bf16x8 At[4][2], B0[2][2], B1[2][2];
    for (;;) {
        PG8_ZERO_ACC();
        const char* cA = cur.A; const char* cB = cur.B;
#define KST(blk_) ((blk_) ? (unsigned)BLK_KT : (unsigned)(BK * 2))
#define HA(blk_, la_) ((blk_) ? (unsigned)BLK_AI : ((unsigned)(la_) << 8))
#define HB(la_) ((unsigned)BLK_AI)
        bool cblk = cur.stage != 0;
        unsigned voffA[2], voffB[2];
        CH_VOFF(cur.lda, cblk, voffA, voffB);
        CH_READY(cur);
        CH_SSQ(cur);
        PG8_STAGE_B(PG8_SB(0, 0), cB, voffB); PG8_STAGE_B(PG8_SB(0, 1), cB + HB(cur.lda), voffB); PG8_STAGE_A(PG8_SA(0, 0), cA, voffA); PG8_STAGE_A(PG8_SA(0, 1), cA + HA(cblk, cur.lda), voffA);
        if (wr == 1) PG8_BAR;
        PG8_WAIT_V(2); PG8_BAR;
        PG8_STAGE_B(PG8_SB(1, 0), cB + BLK_KT, voffB); PG8_STAGE_A(PG8_SA(1, 0), cA + KST(cblk), voffA); PG8_STAGE_B(PG8_SB(1, 1), cB + HB(cur.lda) + BLK_KT, voffB);
        PG8_WAIT_V(6); PG8_BAR;
        bool brk = false;
        for (;;) {
            bool chainon = false;
            const char* nA = cA; const char* nB = cB;
            int nLA = cur.lda; bool nblk = cblk;
            const int nt = cur.K / BK;
#ifdef PROBE_TIME
#define PT_NOW(v_) do { v_ = PROBE_TIME == 1 ? __builtin_amdgcn_s_memrealtime() : __builtin_amdgcn_s_memtime(); asm volatile("s_waitcnt lgkmcnt(0)" : "+s"(v_) :: "memory"); } while (0)
            const bool ptm_ = wid == 0 && __builtin_amdgcn_workgroup_id_x() == PROBE_WG && (PROBE_STAGE < 0 || cur.stage == PROBE_STAGE) && chain == PROBE_CH && cchain == chain;
            unsigned long long pt0_ = 0; if (ptm_ && PROBE_SEG == 1) PT_NOW(pt0_);
#endif
            for (int t = 0; t < nt; t += 2) {
                if (t == nt - 6) CH_POP_ISSUE();
                if (t == nt - 4) { bool has_next; CH_POP_TAKE(nxt, has_next);
                    brk = has_next && nxt.pm == cur.pm && nxt.stage == cur.stage + 1;
                    chainon = has_next && !brk;
                    if (chainon) { nA = nxt.A; nB = nxt.B; nLA = nxt.lda; nblk = nxt.stage != 0; } }
                const bool last = (t == nt - 2);
                if (last && chainon) { bool ok_; CH_TRY(nxt, ok_);
                    if (!ok_) { chainon = false; brk = true; nA = cA; nB = cB; nLA = cur.lda; nblk = cblk; } }
                const unsigned kstA = KST(cblk), hA = HA(cblk, cur.lda);
                const char* a1 = cA + (size_t)((unsigned)(t + 1) * kstA);
                const char* a2 = last ? nA : cA + (size_t)((unsigned)(t + 2) * kstA); const char* b2 = last ? nB : cB + (size_t)(t + 2) * BLK_KT;
                const char* a3 = a2 + (last ? KST(nblk) : kstA); const char* b3 = b2 + BLK_KT;
                const unsigned h2A = last ? HA(nblk, nLA) : hA, h2B = last ? HB(nLA) : HB(cur.lda);
                unsigned vA2[2], vB2[2];
                if (last) CH_VOFF(nLA, nblk, vA2, vB2);
                else {
#pragma unroll
                    for (int i = 0; i < 2; ++i) { vA2[i] = voffA[i]; vB2[i] = voffB[i]; } }
                PG8_LDB(B0, 0, 0); PG8_LDB(B1, 0, 1); PG8_SCHED; PG8_LDA(At, 0, 0); PG8_STAGE_A(PG8_SA(1, 1), a1 + hA, voffA);
                PG8_WAIT_V(8); PG8_WAIT_L(0); PG8_BAR; PG8_MMA(0, 0, At, B0); PG8_MMA(0, 1, At, B1); PG8_BAR; PG8_SCHED;
                PG8_LDA(At, 0, 1); PG8_STAGE_B(PG8_SB(0, 0), b2, vB2); PG8_STAGE_B(PG8_SB(0, 1), b2 + h2B, vB2); PG8_STAGE_A(PG8_SA(0, 0), a2, vA2);
                PG8_WAIT_V(8); PG8_WAIT_L(0); PG8_BAR; PG8_MMA(1, 0, At, B0); PG8_MMA(1, 1, At, B1); PG8_BAR; PG8_SCHED;
                PG8_LDB(B0, 1, 0); PG8_LDB(B1, 1, 1); PG8_SCHED; PG8_LDA(At, 1, 0); PG8_STAGE_A(PG8_SA(0, 1), a2 + h2A, vA2);
                PG8_WAIT_V(8); PG8_WAIT_L(0); PG8_BAR; PG8_MMA(0, 0, At, B0); PG8_MMA(0, 1, At, B1); PG8_BAR; PG8_SCHED;
                PG8_LDA(At, 1, 1); PG8_STAGE_B(PG8_SB(1, 0), b3, vB2); PG8_STAGE_B(PG8_SB(1, 1), b3 + h2B, vB2); PG8_STAGE_A(PG8_SA(1, 0), a3, vA2);
                PG8_WAIT_V(8); PG8_WAIT_L(0); PG8_BAR; PG8_MMA(1, 0, At, B0); PG8_MMA(1, 1, At, B1); PG8_BAR; PG8_SCHED;
            }
#ifdef PROBE_TIME
            if (ptm_) { if (PROBE_SEG == 1) { unsigned long long pt1_; PT_NOW(pt1_); if (lane == 0) bx[44] = bx[44] + (unsigned)(pt1_ - pt0_); }
                if (lane == 0) bx[45] = bx[45] + (unsigned)nt; }
#endif
            if (wr == 0) PG8_BAR;
#ifdef PROBE_TIME
            if (ptm_ && PROBE_SEG == 2) PT_NOW(pt0_);
#endif
#ifdef PROBE_NOEPI
            if (cchain != chain) { _Pragma("unroll") for (int a_ = 0; a_ < 2; ++a_) _Pragma("unroll") for (int b_ = 0; b_ < 2; ++b_) _Pragma("unroll") for (int m_ = 0; m_ < 4; ++m_)
                asm volatile("" :: "v"(acc[a_][b_][m_][0]), "v"(acc[a_][b_][m_][1])); }
            else
#endif
#ifdef PROBE_ST
            if (cchain != chain) {
                const rsrc_t rq_ = mk_rsrc(KA()->ws + WS_MIX, MT * 1024u * 2u);
                const unsigned qo_ = (PROBE_ST == 1 ? (unsigned)(cur.pm * 256 + wr * 64 + fr) * 1024u + (cur.pn & 3) * 256 + wc * 32 + 8 * fq : (unsigned)((cur.pm * 4 + (cur.pn & 3)) * 8 + wid) * 8192u + lane * 8) * 2u;
                _Pragma("unroll") for (int a_ = 0; a_ < 2; ++a_) _Pragma("unroll") for (int m_ = 0; m_ < 4; ++m_) _Pragma("unroll") for (int b_ = 0; b_ < 2; ++b_) {
                    const u32x4 w_ = pack8(acc[a_][b_][m_][0], acc[a_][b_][m_][1]);
                    bst16(rq_, qo_ + 2u * (PROBE_ST == 1 ? (a_ * 128 + m_ * 16) * 1024 + b_ * 128 : (a_ * 8 + m_ * 2 + b_) * 512), w_, false);
                }
            } else
#endif
            chain_epilogue(chain, cchain != chain, safe || cur.pm >= 64, sslot + 256 * upar, lds + (EPITR_OFF - RING_OFF) + wid * 2048, cur, acc, wr, wc, fr, fq);
            CH_DONE(cur);
#ifdef PROBE_TIME
            if (ptm_ && PROBE_SEG == 2) { unsigned long long pt1_; PT_NOW(pt1_); if (lane == 0) bx[44] = bx[44] + (unsigned)(pt1_ - pt0_); }
#endif
            if (!chainon) break;
            PG8_ZERO_ACC();
            cur = nxt; cA = nA; cB = nB; cblk = nblk;
            CH_VOFF(cur.lda, cblk, voffA, voffB);
            CH_SSQ(cur);
            if (wr == 1) PG8_BAR;
        }
        PG8_WAIT_V(0);
        PG8_BAR;
        if (!brk) break;
        cur = nxt;
    }
#undef PG8_SA
#undef PG8_SB
#undef PG8_STAGE_A
#undef PG8_STAGE_B
#undef PG8_LDA
#undef PG8_LDB
#undef PG8_MMA
#undef PG8_WAIT_V
#undef PG8_WAIT_L
#undef PG8_BAR
#undef PG8_SCHED
#undef PG8_ZERO_ACC
#undef CH_POP_ISSUE
#undef CH_POP_WAIT
#undef CH_POP_TAKE
#undef CH_VOFF
#undef CH_SSQ
#undef CH_TRY
#undef KST
#undef HA
#undef HB
#undef CH_READY
#undef CH_DONE
}
}

#define GAS __attribute__((address_space(1)))
#define LAS __attribute__((address_space(3)))
typedef unsigned short bf16;
typedef unsigned v4u __attribute__((ext_vector_type(4)));
typedef float f32x4 __attribute__((ext_vector_type(4)));
typedef short bf16x8 __attribute__((ext_vector_type(8)));
typedef GAS unsigned gu32;
typedef GAS unsigned long long gu64;
#define RLX_AGENT __ATOMIC_RELAXED, __HIP_MEMORY_SCOPE_AGENT
#define LDS_WAIT() asm volatile("s_waitcnt lgkmcnt(0)" ::: "memory")
#define VM_WAIT() asm volatile("s_waitcnt vmcnt(0)" ::: "memory")
__device__ __forceinline__ unsigned long long rt() { return __builtin_amdgcn_s_memrealtime(); }
__device__ __forceinline__ unsigned f2bf(float f) { unsigned u = __builtin_bit_cast(unsigned, f); return (u + 0x7fffu + ((u >> 16) & 1u)) >> 16; }
typedef float f32x2_t __attribute__((ext_vector_type(2))); typedef __bf16 bf16x2_t __attribute__((ext_vector_type(2)));
__device__ __forceinline__ unsigned pk2(float lo, float hi) { f32x2_t v = {lo, hi}; bf16x2_t b = __builtin_convertvector(v, bf16x2_t); return __builtin_bit_cast(unsigned, b); }

#define XB_TMO      128
#define XB_XCNT(j)  (256  + 64 * (j))
#define XB_XSUB(j)  (1280 + 64 * (j))
#define XB_XGEN(j)  (2304 + 64 * (j))
#define XB_TOP      3328
#define XB_TOPGEN   3392
#define XCD_BAR_WORDS 3456
#define XB_SPIN_CAP (1u << 18)

__device__ __forceinline__ unsigned xb_ld(unsigned* p)              { return __hip_atomic_load(p, __ATOMIC_RELAXED, __HIP_MEMORY_SCOPE_AGENT); }
__device__ __forceinline__ unsigned xb_add(unsigned* p, unsigned v) { return __hip_atomic_fetch_add(p, v, __ATOMIC_RELAXED, __HIP_MEMORY_SCOPE_AGENT); }
__device__ __forceinline__ unsigned xb_xcc_id() { return (unsigned)__builtin_amdgcn_s_getreg((3 << 11) | 20) & 0xFu; }
#define XB_SPIN(cond, bar) do { unsigned _sp = 0; while (cond) { __builtin_amdgcn_s_sleep(1); \
    if ((++_sp & 255u) == 0u) { if (xb_ld(&(bar)[XB_TMO])) break; if (_sp > XB_SPIN_CAP) { atomicAdd(&(bar)[XB_TMO], 1u); break; } } } } while (0)

struct XcdBarrier {
    unsigned* bar; unsigned x;
    volatile LAS unsigned* st;
};

__device__ __forceinline__ XcdBarrier xcd_barrier_post(unsigned* bar, volatile LAS unsigned* st) {
    XcdBarrier b; b.bar = bar; b.x = (unsigned)__builtin_amdgcn_readfirstlane((int)xb_xcc_id()); b.st = st;
    if (threadIdx.x == 0) (void)xb_add(&bar[XB_XCNT(b.x)], 1u);
    return b;
}
__device__ __forceinline__ void xcd_barrier_complete(unsigned* bar, unsigned x, unsigned& nloc, unsigned& nx) {
    const unsigned G = gridDim.x * gridDim.y * gridDim.z;
    unsigned sum, cnt, mine, sp = 0u;
    for (;;) {
        sum = 0u; cnt = 0u; mine = 0u;
#pragma unroll
        for (unsigned j = 0; j < 16; ++j) { const unsigned c = xb_ld(&bar[XB_XCNT(j)]); sum += c; cnt += (c > 0u) ? 1u : 0u; mine = (j == x) ? c : mine; }
        if (sum == G) break;
        __builtin_amdgcn_s_sleep(1);
        if ((++sp & 255u) == 0u) { if (xb_ld(&bar[XB_TMO])) break; if (sp > XB_SPIN_CAP) { atomicAdd(&bar[XB_TMO], 1u); break; } }
    }
    nloc = mine > 0u ? mine : 1u; nx = cnt > 0u ? cnt : 1u;
}

__device__ __forceinline__ void xcd_barrier(const XcdBarrier& b) {
    asm volatile("s_waitcnt vmcnt(0)" ::: "memory");
    __syncthreads();
    if (threadIdx.x == 0) {
        unsigned* bar = b.bar;
        __builtin_amdgcn_s_waitcnt(0);
        unsigned nloc = b.st[0], nx = b.st[1];
        if (nloc == 0u) { xcd_barrier_complete(bar, b.x, nloc, nx); b.st[0] = nloc; b.st[1] = nx; }
        const unsigned old = xb_add(&bar[XB_XSUB(b.x)], 1u);
        const unsigned gen = old / nloc;
        if (old + 1u == (gen + 1u) * nloc) {
            __builtin_amdgcn_fence(__ATOMIC_RELEASE, "agent");
            asm volatile("s_waitcnt vmcnt(0)" ::: "memory");
            const unsigned og = xb_add(&bar[XB_TOP], 1u);
            const unsigned tg = og / nx;
            if (og + 1u == (tg + 1u) * nx) xb_add(&bar[XB_TOPGEN], 1u);
            else XB_SPIN(xb_ld(&bar[XB_TOPGEN]) == tg, bar);
            __builtin_amdgcn_fence(__ATOMIC_ACQUIRE, "agent");
            xb_add(&bar[XB_XGEN(b.x)], 1u);
            asm volatile("s_waitcnt vmcnt(0)" ::: "memory");
        } else {
            XB_SPIN(xb_ld(&bar[XB_XGEN(b.x)]) == gen, bar);
            __builtin_amdgcn_fence(__ATOMIC_ACQUIRE, "agent");
            asm volatile("s_waitcnt vmcnt(0)" ::: "memory");
        }
    }
    __syncthreads();
}
typedef unsigned v2u __attribute__((ext_vector_type(2)));
typedef float f32x16 __attribute__((ext_vector_type(16)));
typedef short s16x4 __attribute__((ext_vector_type(4)));
#define WAIT_ALL_BAR() asm volatile("s_waitcnt vmcnt(0) lgkmcnt(0)\n\ts_barrier" ::: "memory")
__device__ __forceinline__ float bflo(unsigned w) { return __builtin_bit_cast(float, w << 16); }
__device__ __forceinline__ float bfhi(unsigned w) { return __builtin_bit_cast(float, w & 0xffff0000u); }
__device__ __forceinline__ void glds16(const void* gsrc, unsigned lds_dst) { unsigned keep;
    asm volatile("s_mov_b32 %0, m0\n\ts_mov_b32 m0, %2\n\ts_nop 0\n\tglobal_load_lds_dwordx4 %1, off\n\ts_mov_b32 m0, %0" : "=&s"(keep) : "v"(gsrc), "s"(lds_dst) : "memory"); }
typedef short v4i16_t __attribute__((ext_vector_type(4)));
__device__ __forceinline__ s16x4 vtr(const LAS unsigned char* p) { return __builtin_bit_cast(s16x4, __builtin_amdgcn_ds_read_tr16_b64_v4i16((LAS v4i16_t*)p)); }
#define LBAR() asm volatile("s_waitcnt lgkmcnt(0)\n\ts_barrier" ::: "memory")

struct Frame {
    LAS unsigned char* lds;
    volatile LAS unsigned* MISC;
    gu32* ctl;
    int tid, lane, wave, vcu, G;
};
using pg8::Args; using pg8::KArgs; using pg8::KA;

__device__ __forceinline__ float wave_sum(float v) {
#pragma unroll
    for (int o = 1; o < 64; o <<= 1) v += __shfl_xor(v, o);
    return v;
}
__device__ __forceinline__ void p0_transpose_item(const float* W, int K, int N, bf16* WT, int drow0, const float* g, LAS float* scr, int k0, int n0, int lane, int ldt) {
    const int n4 = 4 * (lane & 7), kr = lane >> 3; const bool ok = (n0 + n4) < N;
    f32x4 wv[8]; float gv[8];
#pragma unroll
    for (int i = 0; i < 8; ++i) { const int kk = 8 * i + kr; wv[i] = *(const GAS f32x4*)(W + (size_t)(k0 + kk) * N + (ok ? n0 + n4 : 0)); gv[i] = g ? g[k0 + kk] : 1.f; }
#pragma unroll
    for (int i = 0; i < 8; ++i) { const int kk = 8 * i + kr; const f32x4 x = ok ? wv[i] * gv[i] : (f32x4){0.f, 0.f, 0.f, 0.f};
        scr[kk * 33 + n4] = x[0]; scr[kk * 33 + n4 + 1] = x[1]; scr[kk * 33 + n4 + 2] = x[2]; scr[kk * 33 + n4 + 3] = x[3]; }
    LDS_WAIT(); asm volatile("" ::: "memory");
    const int c = lane & 7;
#pragma unroll
    for (int j = 0; j < 4; ++j) { const int nn = (lane >> 3) + 8 * j; const LAS float* s = scr + (8 * c) * 33 + nn;
        v4u o; o.x = pk2(s[0 * 33], s[1 * 33]); o.y = pk2(s[2 * 33], s[3 * 33]); o.z = pk2(s[4 * 33], s[5 * 33]); o.w = pk2(s[6 * 33], s[7 * 33]);
        const int nl = (drow0 & 255) + nn, rb = nl & 127, R = (rb & ~31) + 16 * ((nn >> 2) & 1) + 4 * (nn >> 3) + (nn & 3), ob = (R & 15) * 64 + (c & 3) * 16;
        *(GAS v4u*)((GAS unsigned char*)WT + ((size_t)((drow0 >> 8) * (ldt >> 6) + (k0 >> 6)) * 2 + (nl >> 7)) * 16384 + ((R >> 4) * 2 + (c >> 2)) * 1024 + (ob ^ (((ob >> 9) & 1) << 5))) = o; }
    LDS_WAIT(); asm volatile("" ::: "memory");
}
__device__ __forceinline__ void row_to_bf16(const float* xrow, bf16* orow, unsigned long long* ssq16, int lane) {
    const GAS f32x4* xr = (const GAS f32x4*)xrow + lane;
    f32x4 v[4]; float s = 0.f;
#pragma unroll
    for (int j = 0; j < 4; ++j) { v[j] = xr[64 * j]; s += (v[j].x * v[j].x + v[j].y * v[j].y) + (v[j].z * v[j].z + v[j].w * v[j].w); }
    GAS unsigned long long* o8 = (GAS unsigned long long*)orow + lane;
#pragma unroll
    for (int j = 0; j < 4; ++j) o8[64 * j] = (unsigned long long)pk2(v[j].x, v[j].y) | ((unsigned long long)pk2(v[j].z, v[j].w) << 32);
    if (ssq16) { s = wave_sum(s); if (lane == 0) ssq16[0] = (unsigned long long)(s * SSQ_FIX); }
}
__device__ __forceinline__ void p0_prologue(Frame& F) {
    KArgs ka = KA();
    LAS float* scr = (LAS float*)(F.lds + RING_OFF + F.wave * 16384);
    const int gw = F.vcu * NWAVES + F.wave, NGW = F.G * NWAVES;
    unsigned char* ws = ka->ws;
    constexpr int NITEMS = 2 * 1536 + 2 * 512 + 2 * 2176 + 2 * 512 + 4 * 2048 + 4 * 2048;
    for (int it = gw; it < NITEMS; it += NGW) {
        int r = it; const float* W; const float* g = nullptr; bf16* WT; int K = 1024, N, nnb, ldt = 1024; bool perm = false;
        if (r < 3072) { const int j = r / 1536; r -= j * 1536; W = ka->in[10] + (size_t)j * 1024 * 3072; N = 3072; nnb = 96; WT = (bf16*)(ws + WS_WINA) + (size_t)j * 3072 * 1024; g = ka->in[8] + (2 * j) * 1024; perm = true; }
        else if ((r -= 3072) < 1024) { const int j = r / 512; r -= j * 512; W = ka->in[11] + (size_t)j * 1024 * 1024; N = 1024; nnb = 32; WT = (bf16*)(ws + WS_WOA) + (size_t)j * 1024 * 1024; }
        else if ((r -= 1024) < 4352) { const int j = r / 2176; r -= j * 2176; W = ka->in[15] + (size_t)j * 1024 * NMIN_REAL; N = NMIN_REAL; nnb = 136; WT = (bf16*)(ws + WS_WINB) + (size_t)j * NMIN * 1024; g = ka->in[8] + (2 * j + 1) * 1024; }
        else if ((r -= 4352) < 1024) { const int j = r / 512; r -= j * 512; W = ka->in[21] + (size_t)j * 1024 * 1024; N = 1024; nnb = 32; WT = (bf16*)(ws + WS_WOB) + (size_t)j * 1024 * 1024; }
        else if ((r -= 1024) < 8192) { const int j = r / 2048; r -= j * 2048; W = ka->in[22] + (size_t)j * 1024 * 4096; N = 4096; nnb = 128; WT = (bf16*)(ws + WS_WUP) + (size_t)j * 4096 * 1024; g = ka->in[9] + j * 1024; }
        else { r -= 8192; const int j = r / 2048; r -= j * 2048; W = ka->in[23] + (size_t)j * 4096 * 1024; N = 1024; nnb = 32; K = 4096; ldt = 4096; WT = (bf16*)(ws + WS_WDN) + (size_t)j * 1024 * HIDP; }
        const int kb = r / nnb, nb = r % nnb, n0 = 32 * nb;
        int drow0 = n0;
        if (perm) { const int tile = n0 >> 8, rr = n0 & 255, wc = rr >> 6, bj = (rr & 63) >> 5; drow0 = 256 * tile + 128 * bj + 32 * wc; }
        p0_transpose_item(W, K, N, WT, drow0, g, scr, 64 * kb, n0, F.lane, ldt);
    }
    bf16* XB = (bf16*)(ws + WS_XB); unsigned long long* SSQ = (unsigned long long*)(ws + WS_SSQ);
    for (int m = gw; m < MT; m += NGW) {
        const float* xr = (m < MP) ? ka->in[0] + (size_t)m * D : ka->in[1] + (size_t)(m - MP) * D;
        const int r = m & 255; float s = 0.f;
        unsigned char* pb = (unsigned char*)XB + (size_t)(m >> 8) * (256 * D * 2) + (size_t)(r >> 7) * pg8::BLK_AI;
#pragma unroll
        for (int h = 0; h < 2; ++h) {
            const int g = F.lane + 64 * h;
            const f32x4 v0 = *(const GAS f32x4*)(xr + 8 * g), v1 = *(const GAS f32x4*)(xr + 8 * g + 4);
            s += ((v0.x * v0.x + v0.y * v0.y) + (v0.z * v0.z + v0.w * v0.w)) + ((v1.x * v1.x + v1.y * v1.y) + (v1.z * v1.z + v1.w * v1.w));
            v4u o; o.x = pk2(v0.x, v0.y); o.y = pk2(v0.z, v0.w); o.z = pk2(v1.x, v1.y); o.w = pk2(v1.z, v1.w);
            *(GAS v4u*)(pb + (size_t)(g >> 3) * pg8::BLK_KT + pg8::blk_img((r >> 6) & 1, (g >> 2) & 1, (r >> 4) & 3, r & 15, g & 3)) = o;
        }
        s = wave_sum(s); if (F.lane == 0) SSQ[m] = (unsigned long long)(s * SSQ_FIX);
    }
}
__device__ __forceinline__ void cache_to_rings(Frame& F, int j) {
    KArgs ka = KA();
    const unsigned xcd = __builtin_amdgcn_s_getreg((3 << 11) | 20) & 7u;
    unsigned* ctr = (unsigned*)ka->ws + pg8::CW_Q + 64 * 8 * (5 + j) + 64 * xcd;
    bf16* RK = (bf16*)(ka->ws + WS_RK); bf16* RV = (bf16*)(ka->ws + WS_RV);
    unsigned nx = 0u; if (F.lane == 0) nx = __hip_atomic_fetch_add(ctr, 8u, __ATOMIC_RELAXED, __HIP_MEMORY_SCOPE_AGENT);
    for (;;) {
        const unsigned rl = (unsigned)__builtin_amdgcn_readfirstlane((int)nx);
        if (rl >= 2048u) break;
        if (F.lane == 0) nx = __hip_atomic_fetch_add(ctr, 8u, __ATOMIC_RELAXED, __HIP_MEMORY_SCOPE_AGENT);
#pragma unroll 1
        for (int hb = 0; hb < 2; ++hb) {
        const unsigned r0 = xcd * 2048u + rl + 4u * hb;
        f32x4 v[4][4];
#pragma unroll
        for (int k = 0; k < 4; ++k) {
            const int r = (int)r0 + k, tsr = r >> 13, rr = r & 8191, b = rr >> 9, pos = rr & 511;
            const GAS f32x4* xr = (const GAS f32x4*)((tsr ? ka->in[3] : ka->in[2]) + (((size_t)j * 16 + b) * 512 + pos) * D) + F.lane;
#pragma unroll
            for (int q = 0; q < 4; ++q) v[k][q] = xr[64 * q];
        }
#pragma unroll
        for (int k = 0; k < 4; ++k) {
            const int r = (int)r0 + k, tsr = r >> 13, rr = r & 8191, b = rr >> 9, pos = rr & 511;
            GAS unsigned long long* o8 = (GAS unsigned long long*)((tsr ? RV : RK) + ((size_t)b * 576 + pos) * D) + F.lane;
#pragma unroll
            for (int q = 0; q < 4; ++q) o8[64 * q] = (unsigned long long)pk2(v[k][q].x, v[k][q].y) | ((unsigned long long)pk2(v[k][q].z, v[k][q].w) << 32);
        }
        }
    }
}


__device__ __forceinline__ int crow(int r, int hi) { return (r & 3) + 8 * (r >> 2) + 4 * hi; }
constexpr int AT_STAGE = 32768, AT_HEAD = 8192, AT_V = 4096;
constexpr float LOG2E = 1.4426950408889634f;
__device__ __forceinline__ void attn_unit(Frame& F, int cx, int hg, const bf16* Q, const bf16* KP, const bf16* VP, const bf16* RK, const bf16* RV, bf16* O, const float* relb  , const bool newtab) {
    const int lane = F.lane, wid = F.wave, r32 = lane & 31, hi = lane >> 5;
    const int hh = wid >> 1, head = 4 * hg + hh, rh = wid & 1;
#ifdef PROBE_ATT
    unsigned long long pa0_ = 0; const bool pam_ = blockIdx.x == PROBE_WG && F.tid == 0;
    if (pam_ && (PROBE_ATT == 1 || PROBE_ATT == 3)) pa0_ = __builtin_amdgcn_s_memrealtime();
#endif
    LAS unsigned char* ring = F.lds + RING_OFF;
    LAS float* btab = (LAS float*)(F.lds + EXTRA_OFF);
    const bf16 *Kb, *Vb; long kvrow0; int it0; long qrow0;
    if (cx < 256) { Kb = KP; Vb = VP; kvrow0 = (long)(cx - 8) * 64; it0 = cx < 8 ? 2 * (8 - cx) : 0; qrow0 = (long)cx * 64; }
    else { const int b = cx - 256; Kb = RK + (size_t)b * 576 * D; Vb = RV + (size_t)b * 576 * D; kvrow0 = 0; it0 = 0; qrow0 = MP + (long)b * 64; }
    const unsigned lds0 = (unsigned)(size_t)ring;
    const bf16* src0; long srcstep;
    if ((wid & 1) == 0) { src0 = Kb + (kvrow0 + (lane >> 2)) * D + (4 * hg + hh) * 64 + ((lane & 3) ^ ((lane >> 4) & 3)) * 8; srcstep = 0; }
    else { src0 = Vb + (kvrow0 + (lane >> 2)) * D + (4 * hg + hh) * 64 + (lane & 3) * 8; srcstep = 0; }
    const unsigned dst0 = lds0 + hh * AT_HEAD + (wid & 1) * AT_V;
#define AT_DMA(it) do { const bf16* s_ = src0 + (long)(it) * 32 * D; const unsigned d_ = dst0 + ((it) & 3) * AT_STAGE; \
        _Pragma("unroll") for (int p = 0; p < 4; ++p) glds16(s_ + (long)(p & 1) * 16 * D + (p >> 1) * 32, (unsigned)__builtin_amdgcn_readfirstlane(d_ + p * 1024)); } while (0)
    AT_DMA(it0); AT_DMA(it0 + 1);
    (void)srcstep;
    bf16x8 qr[4];
    const bf16* Qw = Q + (qrow0 + 32 * rh + r32) * D + head * 64;
#pragma unroll
    for (int d0 = 0; d0 < 4; ++d0) qr[d0] = *(const bf16x8*)(Qw + d0 * 16 + hi * 8);
    if (newtab && wid < 4) {
        const float* rb = relb + (4 * hg + wid) * 257; const float* qg = KA()->in[12] + ((relb - KA()->in[14]) / (16 * 257)) * 64; const float* kg = KA()->in[13] + ((relb - KA()->in[14]) / (16 * 257)) * 64;
        float bm = -3.0e38f, bv[6];
#pragma unroll
        for (int i = 0; i < 6; ++i) { const int e = lane + 64 * i; bv[i] = rb[e < 257 ? e : 256]; bm = fmaxf(bm, bv[i]); }
        float gq = fabsf(qg[lane]), gk = fabsf(kg[lane]);
#pragma unroll
        for (int o = 1; o < 64; o <<= 1) { bm = fmaxf(bm, __shfl_xor(bm, o)); gq = fmaxf(gq, __shfl_xor(gq, o)); gk = fmaxf(gk, __shfl_xor(gk, o)); }
        const float M = LOG2E * (8.2f * gq * gk + bm) + 0.25f;
#pragma unroll
        for (int i = 0; i < 6; ++i) { const int e = lane + 64 * i; if (e < 324) btab[wid * 324 + e] = bv[i] * LOG2E - M; }
    }
    f32x16 lsum = {}, o0 = {}, o1 = {};
    const bf16x8 ones8 = {0x3F80, 0x3F80, 0x3F80, 0x3F80, 0x3F80, 0x3F80, 0x3F80, 0x3F80};
    const int tq = 32 * rh + r32;
    const LAS float* bt = btab + hh * 324;
#ifdef PROBE_ATT
    if (pam_ && PROBE_ATT == 3) { F.MISC[60] = F.MISC[60] + (unsigned)(__builtin_amdgcn_s_memrealtime() - pa0_); F.MISC[61] = F.MISC[61] + 1u; }
    if (pam_ && PROBE_ATT == 2) pa0_ = __builtin_amdgcn_s_memrealtime();
#endif
    for (int it = it0; it < 18; it += 2) {
        asm volatile("s_waitcnt vmcnt(0) lgkmcnt(0)\n\ts_barrier" ::: "memory");
        if (it + 2 < 18) { AT_DMA(it + 2); AT_DMA(it + 3); }
        f32x16 p0[2];
        if (it < 12) { const float cb = bt[256];
#pragma unroll
            for (int s = 0; s < 2; ++s)
#pragma unroll
                for (int r = 0; r < 16; ++r) p0[s][r] = cb; }
        else {
#pragma unroll
            for (int s = 0; s < 2; ++s) { const LAS float* bl = bt + (128 + 512 + tq - 32 * (it + s) - 4 * hi - 27);
#pragma unroll
                for (int r = 0; r < 16; ++r) p0[s][r] = bl[27 - ((r & 3) + 8 * (r >> 2))]; } }
#pragma unroll
        for (int s = 0; s < 2; ++s) { const LAS unsigned char* kb = ring + ((it + s) & 3) * AT_STAGE + hh * AT_HEAD + (r32 >> 4) * 1024 + (r32 & 15) * 64;
            const int ks0 = (hi ^ ((r32 >> 2) & 3)) * 16;
#pragma unroll
          for (int d0 = 0; d0 < 4; ++d0) p0[s] = __builtin_amdgcn_mfma_f32_32x32x16_bf16(*(const LAS bf16x8*)(kb + (d0 >> 1) * 2048 + (ks0 ^ ((d0 & 1) * 32))), qr[d0], p0[s], 0, 0, 0); }
#pragma unroll
        for (int s = 0; s < 2; ++s)
#pragma unroll
            for (int r = 0; r < 16; ++r) p0[s][r] = __builtin_amdgcn_exp2f(p0[s][r]);
#pragma unroll
        for (int s = 0; s < 2; ++s) {
            v4u pw[2];
#pragma unroll
            for (int k = 0; k < 2; ++k) pw[k] = (v4u){pk2(p0[s][8 * k], p0[s][8 * k + 1]), pk2(p0[s][8 * k + 2], p0[s][8 * k + 3]), pk2(p0[s][8 * k + 4], p0[s][8 * k + 5]), pk2(p0[s][8 * k + 6], p0[s][8 * k + 7])};
            const LAS unsigned char* vb = ring + ((it + s) & 3) * AT_STAGE + hh * AT_HEAD + AT_V + ((lane >> 4) & 1) * 32 + (lane & 3) * 8 + (4 * hi + ((lane & 15) >> 2)) * 64;
#pragma unroll
            for (int ks = 0; ks < 2; ++ks) {
                const s16x4 l0 = vtr(vb + ks * 1024), h0 = vtr(vb + ks * 1024 + 512), l1 = vtr(vb + 2048 + ks * 1024), h1 = vtr(vb + 2048 + ks * 1024 + 512);
                const bf16x8 v0 = (bf16x8){l0[0], l0[1], l0[2], l0[3], h0[0], h0[1], h0[2], h0[3]}, v1 = (bf16x8){l1[0], l1[1], l1[2], l1[3], h1[0], h1[1], h1[2], h1[3]};
                const bf16x8 pa = __builtin_bit_cast(bf16x8, pw[ks]);
                o0 = __builtin_amdgcn_mfma_f32_32x32x16_bf16(v0, pa, o0, 0, 0, 0);
                o1 = __builtin_amdgcn_mfma_f32_32x32x16_bf16(v1, pa, o1, 0, 0, 0);
                lsum = __builtin_amdgcn_mfma_f32_32x32x16_bf16(ones8, pa, lsum, 0, 0, 0);
            }
        }
    }
#undef AT_DMA
#ifdef PROBE_ATT
    if (pam_ && PROBE_ATT == 2) { F.MISC[60] = F.MISC[60] + (unsigned)(__builtin_amdgcn_s_memrealtime() - pa0_); F.MISC[61] = F.MISC[61] + 1u; }
#endif
    const float rl = 1.0f / lsum[0];
    WAIT_ALL_BAR();
    {
        LAS unsigned char* scr = ring + wid * 4096;
        LAS unsigned char* wp = scr + r32 * 128 + hi * 8;
#pragma unroll
        for (int g = 0; g < 4; ++g) {
            v2u w0, w1;
            w0.x = pk2(o0[4 * g] * rl, o0[4 * g + 1] * rl); w0.y = pk2(o0[4 * g + 2] * rl, o0[4 * g + 3] * rl);
            w1.x = pk2(o1[4 * g] * rl, o1[4 * g + 1] * rl); w1.y = pk2(o1[4 * g + 2] * rl, o1[4 * g + 3] * rl);
            *(LAS v2u*)(wp + ((g ^ (r32 & 7)) * 16)) = w0; *(LAS v2u*)(wp + (((4 + g) ^ (r32 & 7)) * 16)) = w1;
        }
        asm volatile("s_waitcnt lgkmcnt(0)" ::: "memory");
        bf16* Ob = O + (qrow0 + 32 * rh + (lane >> 3)) * D + head * 64 + (lane & 7) * 8;
#pragma unroll
        for (int i = 0; i < 4; ++i) {
            const int r = 8 * i + (lane >> 3);
            const v4u w = *(const LAS v4u*)(scr + r * 128 + (((lane & 7) ^ (r & 7)) * 16));
            *(v4u*)(Ob + (size_t)(8 * i) * D) = w;
        }
    }
    WAIT_ALL_BAR();
#ifdef PROBE_ATT
    if (pam_ && PROBE_ATT == 1) { F.MISC[60] = F.MISC[60] + (unsigned)(__builtin_amdgcn_s_memrealtime() - pa0_); F.MISC[61] = F.MISC[61] + 1u; }
#endif
}
__device__ __forceinline__ void attn_phase(Frame& F, int j) {
    KArgs ka = KA(); unsigned char* ws = ka->ws;
    const bf16 *Q = (const bf16*)(ws + WS_Q), *KP = (const bf16*)(ws + WS_KP), *VP = (const bf16*)(ws + WS_VP), *RK = (const bf16*)(ws + WS_RK), *RV = (const bf16*)(ws + WS_RV);
    bf16* O = (bf16*)(ws + WS_O);
    const float* relb = ka->in[14] + (size_t)j * 16 * 257;
    const int x = F.vcu >> 5, c = F.vcu & 31;
    int hgprev = -1;
#pragma unroll 1
    for (int i = 0; ; ++i) {
        int cx, hg;
        if (F.G == 256) { if (i < 4) { cx = 32 * x + 16 * (i & 1) + (c >> 1); hg = 2 * (i >> 1) + (c & 1); } else if (i == 4 && c < 8) { cx = 256 + 2 * x + (c >> 2); hg = c & 3; } else break; }
        else { const int u = F.vcu + i * F.G; if (u >= 272 * 4) break; cx = u >> 2; hg = u & 3; }
        attn_unit(F, cx, hg, Q, KP, VP, RK, RV, O, relb, hg != hgprev); hgprev = hg;
    }
}

struct MUnit { int head, ntok, b, isS; long row0; };
__device__ __forceinline__ void munit(int u, MUnit& m) {
    if (u < 512) { m.head = u & 3; m.ntok = 128; m.row0 = (long)(u >> 2) * 128; m.isS = 0; m.b = 0; }
    else { const int v = u - 512; m.head = v & 3; m.b = v >> 2; m.ntok = 64; m.row0 = MP + (long)m.b * 64; m.isS = 1; }
}
__device__ __forceinline__ f32x4 mfma16(bf16x8 a, bf16x8 b, f32x4 c) { return __builtin_amdgcn_mfma_f32_16x16x32_bf16(a, b, c, 0, 0, 0); }
__device__ __forceinline__ bf16x8 trfrag(const LAS unsigned char* p) { const s16x4 lo = vtr(p), hi = vtr(p + 1024); return (bf16x8){lo[0], lo[1], lo[2], lo[3], hi[0], hi[1], hi[2], hi[3]}; }
constexpr int MSTART_OFF = 2048;


__device__ __forceinline__ void gate_scans(LAS float* xs, int tid, int ntok, float& bt, float& ut, float& pm) {
    const int lane = tid & 63; const bool on = tid < 128;
    float b = on ? xs[128 + (tid < ntok ? tid : 0)] : 0.f; if (tid >= ntok) b = 0.f;
#pragma unroll
    for (int o = 1; o < 64; o <<= 1) { const float y = __shfl_up(b, o); if (lane >= o) b += y; }
    if (on && lane == 63) xs[512 + (tid >> 6)] = b;
    LBAR();
    if (on && tid >= 64) b += xs[512];
    const float ig = (tid < ntok) ? xs[tid] : 0.f;
    float u = (tid < ntok) ? ig - b : -3.0e38f, m = u;
#pragma unroll
    for (int o = 1; o < 64; o <<= 1) { const float y = __shfl_up(m, o); if (lane >= o) m = fmaxf(m, y); }
    if (on && lane == 63) xs[514 + (tid >> 6)] = m;
    LBAR();
    if (on && tid >= 64) m = fmaxf(m, xs[514]);
    if (tid < ntok) { xs[128 + tid] = b; xs[256 + tid] = u; xs[384 + tid] = m; }
    bt = b; ut = u; pm = m;
}

__device__ __forceinline__ int slab_off(int e, int d) { return e < 256 ? (e >> 6) * 32768 + (d >> 3) * 1024 + (e & 63) * 16 + (d & 7) * 2 : 131072 + (d >> 3) * 256 + (e - 256) * 16 + (d & 7) * 2; }
__device__ __forceinline__ void slab_ed(int vi, int& e, int& d) {
    const int off = vi * 8;
    if (off < 131072) { e = (off >> 15) * 64 + ((off >> 4) & 63); d = ((off >> 10) & 31) * 8 + ((off >> 3) & 1) * 4; }
    else { const int t = off - 131072; e = 256 + ((t >> 4) & 15); d = (t >> 8) * 8 + ((t >> 3) & 1) * 4; }
}
__device__ __forceinline__ void mlstm_a_unit(Frame& F, int j, int u) {
    MUnit mu; munit(u, mu); KArgs ka = KA();
#ifdef PROBE_MA
    unsigned pm_last_ = 0; const bool pmm_ = blockIdx.x == PROBE_WG && F.tid == 0 && u < 512;
#define PM_MARK(k_) do { if (pmm_) { const unsigned now_ = (unsigned)__builtin_amdgcn_s_memrealtime(); if ((k_) > 0 && ((k_) - 1 == PROBE_MA || PROBE_MA == 9)) F.MISC[60] = F.MISC[60] + (now_ - pm_last_); if ((k_) == 4) F.MISC[61] = F.MISC[61] + 1u; pm_last_ = now_; } } while (0)
    PM_MARK(0);
#endif
    unsigned char* ws = ka->ws;
    const bf16* QKP = (const bf16*)(ws + WS_QKP); const bf16* V = (const bf16*)(ws + WS_V);
    bf16* QC = (bf16*)(ws + WS_QC); bf16* KC = (bf16*)(ws + WS_KC);
    bf16* slab = (bf16*)(ws + WS_SLAB + (size_t)u * SLAB_BYTES);
    const float* gates = (const float*)(ka->ws + WS_GATES); float* stats = (float*)(ka->ws + WS_STATS);
    LAS float* xs = (LAS float*)(F.lds + EXTRA_OFF + 9216);
    LAS unsigned char* Kt = F.lds + RING_OFF; LAS unsigned char* Wv = F.lds + RING_OFF + 65536;
    const int tid = F.tid, lane = F.lane, wid = F.wave, head = mu.head, ntok = mu.ntok; const long row0 = mu.row0;
    if (tid < ntok) { xs[tid] = gates[(row0 + tid) * 8 + head]; xs[128 + tid] = gates[(row0 + tid) * 8 + 4 + head]; }
    LBAR();
    float bt, ut, pmx; gate_scans(xs, tid, ntok, bt, ut, pmx);
    LBAR();
    const float umax = xs[384 + ntok - 1], bsum = xs[128 + ntok - 1];
    LBAR();
    if (tid < ntok) xs[256 + tid] = expf(ut - umax);
    if (tid == 0) { stats[u * 2] = bsum; stats[u * 2 + 1] = umax; }
    const int nh = ntok >> 6;
    const int cgi = tid & 63, rseg = tid >> 6, c = cgi & 31; const bool isk = cgi >= 32;
    const int qcol = (isk ? 1024 : 0) + head * 256 + 8 * c;
    const int vc = tid & 31, kseg = tid >> 5;
    float cw[4][8], cb[8];
#pragma unroll
    for (int jj = 0; jj < 4; ++jj) { const f32x4 w0 = *(const f32x4*)(ka->in[18] + ((size_t)j * 4 + jj) * 2048 + qcol), w1 = *(const f32x4*)(ka->in[18] + ((size_t)j * 4 + jj) * 2048 + qcol + 4);
#pragma unroll
        for (int e = 0; e < 4; ++e) { cw[jj][e] = w0[e]; cw[jj][4 + e] = w1[e]; } }
    { const f32x4 w0 = *(const f32x4*)(ka->in[19] + (size_t)j * 2048 + qcol), w1 = *(const f32x4*)(ka->in[19] + (size_t)j * 2048 + qcol + 4);
#pragma unroll
      for (int e = 0; e < 4; ++e) { cb[e] = w0[e]; cb[4 + e] = w1[e]; } }
    LBAR();
#ifdef PROBE_MA
    PM_MARK(1);
#endif
    for (int hs = 0; hs < nh; ++hs) {
        v4u xr[11], vr[4];
#pragma unroll
        for (int i = 0; i < 11; ++i) { const long gr = row0 + 64 * hs + 8 * rseg + i - 3; xr[i] = *(const v4u*)(QKP + (size_t)(gr < 0 ? 0 : gr) * 2048 + qcol); }
#pragma unroll
        for (int i = 0; i < 4; ++i) vr[i] = *(const v4u*)(V + (size_t)(row0 + 64 * hs + 4 * kseg + i) * D + head * 256 + 8 * vc);
        {
            float x0[8], x1[8], x2[8];
#pragma unroll
            for (int e = 0; e < 8; ++e) { x0[e] = 0.f; x1[e] = 0.f; x2[e] = 0.f; }
#pragma unroll
            for (int i = -3; i < 8; ++i) {
                const int tt = 64 * hs + 8 * rseg + i;
                float x[8];
                {
                    const long gr = row0 + tt; const v4u w = xr[i + 3];
                    x[0] = bflo(w.x); x[1] = bfhi(w.x); x[2] = bflo(w.y); x[3] = bfhi(w.y); x[4] = bflo(w.z); x[5] = bfhi(w.z); x[6] = bflo(w.w); x[7] = bfhi(w.w);
                    if (i < 0) {
                        const int ts = tt < -3 ? -3 : (tt > -1 ? -1 : tt);
                        const float* sp = ka->in[7] + (((size_t)j * 16 + mu.b) * 3 + (3 + ts)) * 2048 + qcol;
                        const f32x4 w0 = *(const f32x4*)sp, w1 = *(const f32x4*)(sp + 4);
                        const bool useS = mu.isS && tt < 0, zero = !mu.isS && gr < 0;
#pragma unroll
                        for (int e = 0; e < 4; ++e) { x[e] = useS ? w0[e] : (zero ? 0.f : x[e]); x[4 + e] = useS ? w1[e] : (zero ? 0.f : x[4 + e]); }
                    }
                }
                if (i >= 0) {
                    float y[8];
#pragma unroll
                    for (int e = 0; e < 8; ++e) { const float s = cb[e] + cw[0][e] * x0[e] + cw[1][e] * x1[e] + cw[2][e] * x2[e] + cw[3][e] * x[e]; float v = s * __builtin_amdgcn_rcpf(1.0f + __expf(-s)); if (isk) v *= 0.0625f; y[e] = v; }
                    v4u o; o.x = pk2(y[0], y[1]); o.y = pk2(y[2], y[3]); o.z = pk2(y[4], y[5]); o.w = pk2(y[6], y[7]);
                    *(v4u*)((isk ? KC : QC) + (size_t)(row0 + tt) * D + head * 256 + 8 * c) = o;
                    if (isk) *(LAS v4u*)(Kt + (c >> 2) * 8192 + (64 * hs + 8 * rseg + i) * 64 + (c & 3) * 16) = o;
                }
#pragma unroll
                for (int e = 0; e < 8; ++e) { x0[e] = x1[e]; x1[e] = x2[e]; x2[e] = x[e]; }
            }
        }
        {
#pragma unroll
            for (int i = 0; i < 4; ++i) {
                const int key = 4 * kseg + i; const float w = xs[256 + 64 * hs + key];
                const v4u x = vr[i];
                v4u o; o.x = pk2(bflo(x.x) * w, bfhi(x.x) * w); o.y = pk2(bflo(x.y) * w, bfhi(x.y) * w); o.z = pk2(bflo(x.z) * w, bfhi(x.z) * w); o.w = pk2(bflo(x.w) * w, bfhi(x.w) * w);
                *(LAS v4u*)(Wv + (vc >> 2) * 8192 + (64 * hs + key) * 64 + (vc & 3) * 16) = o;
            }
            if (tid < 256) { const int key = tid >> 2, ch = tid & 3; v4u o = (v4u){0u, 0u, 0u, 0u}; if (ch == 0) o.x = f2bf(xs[256 + 64 * hs + key]); *(LAS v4u*)(Wv + 8 * 8192 + (64 * hs + key) * 64 + ch * 16) = o; }
        }
    }
    LBAR();
#ifdef PROBE_MA
    PM_MARK(2);
#endif
    f32x4 acc[2][17];
#pragma unroll
    for (int dd = 0; dd < 2; ++dd)
#pragma unroll
        for (int eb = 0; eb < 17; ++eb) acc[dd][eb] = (f32x4){0.f, 0.f, 0.f, 0.f};
    {
        const int g = lane >> 4, q = (lane & 15) >> 2, p = lane & 3;
        for (int ks = 0; ks < 2 * nh; ++ks) {
            const int koff = (32 * ks + 4 * g + q) * 64 + p * 8;
            bf16x8 af[2];
#pragma unroll
            for (int dd = 0; dd < 2; ++dd) { const int db = 2 * wid + dd; af[dd] = trfrag(Kt + (db >> 1) * 8192 + (db & 1) * 32 + koff); }
#pragma unroll
            for (int eb = 0; eb < 17; ++eb) {
                const bf16x8 bfr = trfrag(Wv + (eb >> 1) * 8192 + (eb & 1) * 32 + koff);
                acc[0][eb] = mfma16(af[0], bfr, acc[0][eb]); acc[1][eb] = mfma16(af[1], bfr, acc[1][eb]);
            }
        }
    }
#ifdef PROBE_MA
    PM_MARK(3);
#endif
    {
        const int g = lane >> 4, el = lane & 15;
        unsigned char* sb1 = (unsigned char*)slab + el * 16 + (g & 1) * 8 + wid * 4096 + (g >> 1) * 1024;
        unsigned char* sb2 = (unsigned char*)slab + 131072 + el * 16 + (g & 1) * 8 + wid * 1024 + (g >> 1) * 256;
#pragma unroll
        for (int dd = 0; dd < 2; ++dd)
#pragma unroll
            for (int eb = 0; eb < 17; ++eb) {
                const f32x4 v = acc[dd][eb];
                v2u o; o.x = pk2(v[0], v[1]); o.y = pk2(v[2], v[3]);
                *(v2u*)(eb < 16 ? sb1 + (eb >> 2) * 32768 + (eb & 3) * 256 + dd * 2048 : sb2 + dd * 512) = o;
            }
    }
    LBAR();
#ifdef PROBE_MA
    PM_MARK(4);
#endif
}

__device__ __forceinline__ void mlstm_b_phase(Frame& F, int j, bool dry = false) {
    KArgs ka = KA();
    unsigned char* A = ka->ws; unsigned char* slab0 = A + WS_SLAB;
    float* stats = (float*)(ka->ws + WS_STATS); float* mstart = stats + MSTART_OFF;
    LAS float* tab = (LAS float*)(F.lds + EXTRA_OFF);
    const int tid = F.tid;
    for (int vb = F.vcu; vb < 256; vb += F.G) {
        if (vb < 136) {
            const int head = vb / 34, vi = (vb % 34) * 512 + tid;
            LBAR();
            if (tid < 128) { const int u = tid * 4 + head; tab[272 + tid] = stats[u * 2]; tab[400 + tid] = stats[u * 2 + 1]; }
            LBAR();
            if (tid == 0) { float m = 0.f; for (int J = 0; J < 128; ++J) { tab[528 + J] = m; m = tab[272 + J] + fmaxf(m, tab[400 + J]); } tab[256] = m; }
            LBAR();
            if (tid < 128) { const float bs = tab[272 + tid], um = tab[400 + tid], m = tab[528 + tid], mn = bs + fmaxf(m, um);
                tab[tid] = expf(bs + m - mn); tab[128 + tid] = expf(bs + um - mn); if (vb % 34 == 0 && !dry) mstart[tid * 4 + head] = m; }
            LBAR();
            f32x4 C = (f32x4){0.f, 0.f, 0.f, 0.f};
            unsigned char* p0 = slab0 + (size_t)head * SLAB_BYTES + (size_t)vi * 8;
            for (int J0 = 0; J0 < 128; J0 += 16) {
                v2u dq[16];
#pragma unroll
                for (int k = 0; k < 16; ++k) dq[k] = *(const v2u*)(p0 + (size_t)(J0 + k) * 4 * SLAB_BYTES);
#pragma unroll
                for (int k = 0; k < 16; ++k) {
                    v2u o; o.x = pk2(C[0], C[1]); o.y = pk2(C[2], C[3]);
                    *(v2u*)(dry ? A + WS_QKP + (size_t)((J0 + k) & 63) * MiB + (size_t)vi * 8 : p0 + (size_t)(J0 + k) * 4 * SLAB_BYTES) = o;
                    const float dc = tab[J0 + k], sc = tab[128 + J0 + k];
                    C[0] = dc * C[0] + sc * bflo(dq[k].x); C[1] = dc * C[1] + sc * bfhi(dq[k].x); C[2] = dc * C[2] + sc * bflo(dq[k].y); C[3] = dc * C[3] + sc * bfhi(dq[k].y);
                }
            }
            int e, d; slab_ed(vi, e, d);
            if (!dry) {
            if (e < 256) *(f32x4*)(ka->out + O_CP + (((size_t)j * 4 + head) * 256 + e) * 256 + d) = C;
            else if (e == 256) *(f32x4*)(ka->out + O_NP + ((size_t)j * 4 + head) * 256 + d) = C;
            if (vb % 34 == 0 && tid == 0) ka->out[O_MP + j * 4 + head] = tab[256];
            }
        } else {
            constexpr int SN = 64 * 17408, SS = 120 * 512;
            for (int idx0 = (vb - 136) * 512 + tid; idx0 < SN; idx0 += 4 * SS) {
                int vi_[4], u_[4], e_[4]; size_t sh_[4]; bool ok_[4]; f32x4 C0_[4], N0_[4]; v2u dq_[4]; float m0_[4], bs_[4], um_[4]; unsigned char* p_[4];
#pragma unroll
                for (int k = 0; k < 4; ++k) {
                    const int idx = idx0 + k * SS; ok_[k] = idx < SN; const int ic = ok_[k] ? idx : 0;
                    const int v = ic / 17408, vi = ic - v * 17408, b = v >> 2, head = v & 3; vi_[k] = vi; u_[k] = 512 + v; int d; slab_ed(vi, e_[k], d);
                    sh_[k] = ((size_t)j * 16 + b) * 4 + head;
                    m0_[k] = ka->in[6][sh_[k]]; bs_[k] = stats[u_[k] * 2]; um_[k] = stats[u_[k] * 2 + 1];
                    C0_[k] = *(const f32x4*)(ka->in[4] + (sh_[k] * 256 + (e_[k] < 256 ? e_[k] : 0)) * 256 + d);
                    N0_[k] = *(const f32x4*)(ka->in[5] + sh_[k] * 256 + d);
                    p_[k] = slab0 + (size_t)u_[k] * SLAB_BYTES + (size_t)vi * 8;
                    dq_[k] = *(const v2u*)p_[k];
                }
#pragma unroll
                for (int k = 0; k < 4; ++k) if (ok_[k]) {
                    int e, d; slab_ed(vi_[k], e, d); const size_t sh = sh_[k];
                    const float m0 = m0_[k], bs = bs_[k], um = um_[k], mn = bs + fmaxf(m0, um), dc = expf(bs + m0 - mn), sc = expf(bs + um - mn);
                    const f32x4 C0 = e < 256 ? C0_[k] : (e == 256 ? N0_[k] : (f32x4){0.f, 0.f, 0.f, 0.f});
                    const v2u dq = dq_[k];
                    v2u o; o.x = pk2(C0[0], C0[1]); o.y = pk2(C0[2], C0[3]); if (!dry) *(v2u*)p_[k] = o;
                    f32x4 Ce; Ce[0] = dc * C0[0] + sc * bflo(dq.x); Ce[1] = dc * C0[1] + sc * bfhi(dq.x); Ce[2] = dc * C0[2] + sc * bflo(dq.y); Ce[3] = dc * C0[3] + sc * bfhi(dq.y);
                    if (!dry) { if (e < 256) *(f32x4*)(ka->out + O_CS + (sh * 256 + e) * 256 + d) = Ce; else if (e == 256) *(f32x4*)(ka->out + O_NS + sh * 256 + d) = Ce;
                        if (vi_[k] == 0) { ka->out[O_MS + sh] = mn; mstart[u_[k]] = m0; } }
                    else if (Ce[0] == 1.2345e30f) ka->out[0] = Ce[1];
                }
            }
        }
    }
}

__device__ __forceinline__ void mlstm_c_unit(Frame& F, int j, int u, bool dry = false) {
#ifdef PROBE_MC
    unsigned pc_last_ = 0; const bool pcm_ = blockIdx.x == PROBE_WG && F.tid == 0 && u < 512;
#define PC_MARK(k_) do { if (pcm_) { const unsigned now_ = (unsigned)__builtin_amdgcn_s_memrealtime(); if ((k_) > 0 && ((k_) - 1 == PROBE_MC || PROBE_MC == 9)) F.MISC[60] = F.MISC[60] + (now_ - pc_last_); if ((k_) == 6) F.MISC[61] = F.MISC[61] + 1u; pc_last_ = now_; } } while (0)
    PC_MARK(0);
#endif
    MUnit mu; munit(u, mu); KArgs ka = KA();
    unsigned char* A = ka->ws;
    const bf16* V = (const bf16*)(A + WS_V); bf16* OG = (bf16*)(A + WS_OG);
    const bf16* QC = (const bf16*)(A + WS_QC); const bf16* KC = (const bf16*)(A + WS_KC);
    const bf16* slab = (const bf16*)(A + WS_SLAB + (size_t)u * SLAB_BYTES);
    const float* gates = (const float*)(ka->ws + WS_GATES); const float* stats = (const float*)(ka->ws + WS_STATS);
    LAS float* xs = (LAS float*)(F.lds + EXTRA_OFF + 9216);
    LAS unsigned char* ring = F.lds + RING_OFF; const unsigned lds0 = (unsigned)(size_t)ring;
    const int tid = F.tid, lane = F.lane, wid = F.wave, head = mu.head, ntok = mu.ntok; const long row0 = mu.row0;
    const int tl = lane & 15, g = lane >> 4, t = 16 * wid + tl;
    const bool active = 16 * wid < ntok;
    const float ms = stats[MSTART_OFF + u];
#pragma unroll
    for (int ct = 0; ct < 4; ++ct)
#pragma unroll
        for (int k = 0; k < 4; ++k) { const int c = wid * 4 + k;
            glds16((const unsigned char*)slab + ct * 32768 + c * 1024 + lane * 16, (unsigned)__builtin_amdgcn_readfirstlane(lds0 + ct * 32768 + c * 1024)); }
    bf16x8 qf[8];
#pragma unroll
    for (int kd = 0; kd < 8; ++kd) qf[kd] = *(const bf16x8*)(QC + (size_t)(row0 + (active ? t : 0)) * D + head * 256 + 32 * kd + 8 * g);
    if (tid < ntok) { xs[tid] = gates[(row0 + tid) * 8 + head]; xs[128 + tid] = gates[(row0 + tid) * 8 + 4 + head]; }
    LBAR();
    float bt, ut, pmx; gate_scans(xs, tid, ntok, bt, ut, pmx);
    if (tid < ntok) { xs[384 + tid] = bt + fmaxf(ms, pmx); xs[256 + tid] = ut * LOG2E; }
    LBAR();
    float b_t = 0.f, m_t = 0.f;
    if (active) { b_t = xs[128 + t]; m_t = xs[384 + t]; }
    const float a_t = (b_t - m_t) * LOG2E, inter_t = expf(b_t + ms - m_t);
    WAIT_ALL_BAR();
#ifdef PROBE_MC
    PC_MARK(1);
#endif
    f32x4 acc[16];
#pragma unroll
    for (int eb = 0; eb < 16; ++eb) acc[eb] = (f32x4){0.f, 0.f, 0.f, 0.f};
    if (active) {
#pragma unroll
        for (int eb = 0; eb < 16; ++eb) {
            const LAS unsigned char* cb = ring + (eb >> 2) * 32768 + g * 1024 + ((eb & 3) * 16 + tl) * 16;
#pragma unroll
            for (int kd = 0; kd < 8; ++kd) acc[eb] = mfma16(*(const LAS bf16x8*)(cb + kd * 4096), qf[kd], acc[eb]);
        }
    }
    WAIT_ALL_BAR();
#ifdef PROBE_MC
    PC_MARK(2);
#endif
#define MC_DMA_KV(kt, bk, bv) do { \
        _Pragma("unroll") for (int k = 0; k < 4; ++k) { const int pc = wid * 4 + k;        \
            glds16(KC + (size_t)(row0 + 64 * (kt) + 16 * k + (lane >> 2)) * D + head * 256 + wid * 32 + ((lane & 3) ^ ((lane >> 4) & 3)) * 8, (unsigned)__builtin_amdgcn_readfirstlane(lds0 + (bk) * 32768 + pc * 1024)); } \
        _Pragma("unroll") for (int k = 0; k < 4; ++k) { const int pc = wid * 4 + k, cg = pc >> 2, rg = pc & 3; \
            glds16(V + (size_t)(row0 + 64 * (kt) + 16 * rg + (lane >> 2)) * D + head * 256 + cg * 32 + (lane & 3) * 8, (unsigned)__builtin_amdgcn_readfirstlane(lds0 + (bv) * 32768 + pc * 1024)); } } while (0)
#pragma unroll
    for (int k = 0; k < 4; ++k) { const int c = wid * 4 + k; const int rr = lane > 15 ? 15 : lane;
        glds16((const unsigned char*)slab + 131072 + c * 256 + rr * 16, (unsigned)__builtin_amdgcn_readfirstlane(lds0 + c * 1024)); }
    MC_DMA_KV(0, 2, 3);
    WAIT_ALL_BAR();
#ifdef PROBE_MC
    PC_MARK(3);
#endif
    float nq = 0.f;
    {
        f32x4 ad = (f32x4){0.f, 0.f, 0.f, 0.f};
        if (active) {
            const LAS unsigned char* cb = ring + g * 1024 + tl * 16;
#pragma unroll
            for (int kd = 0; kd < 8; ++kd) ad = mfma16(*(const LAS bf16x8*)(cb + kd * 4096), qf[kd], ad);
        }
        nq = __shfl(ad[0], tl);
    }
#pragma unroll
    for (int eb = 0; eb < 16; ++eb) acc[eb] = acc[eb] * inter_t;
    float den = inter_t * nq, denp = 0.f;
    WAIT_ALL_BAR();
#ifdef PROBE_MC
    PC_MARK(4);
#endif
    const int nkt = ntok >> 6;
    if (nkt > 1) MC_DMA_KV(1, 0, 1);
    for (int kt = 0; kt < nkt; ++kt) {
        if (kt == 1) WAIT_ALL_BAR();
        const LAS unsigned char* bK = ring + (kt == 0 ? 2 : 0) * 32768; const LAS unsigned char* bV = bK + 32768;
        if (active && kt <= (wid >> 2)) {
            f32x4 sacc[4];
#pragma unroll
            for (int sb = 0; sb < 4; ++sb) { sacc[sb] = (f32x4){0.f, 0.f, 0.f, 0.f};
                const LAS unsigned char* kb = bK + sb * 1024 + tl * 64 + ((g ^ ((tl >> 2) & 3)) * 16);
#pragma unroll
                for (int kd = 0; kd < 8; ++kd) sacc[sb] = mfma16(*(const LAS bf16x8*)(kb + kd * 4096), qf[kd], sacc[sb]); }
            unsigned pw[8];
#pragma unroll
            for (int sb = 0; sb < 4; ++sb) {
                const f32x4 c4 = *(const LAS f32x4*)(xs + 256 + 64 * kt + 16 * sb + 4 * g);
                float pv[4];
#pragma unroll
                for (int r = 0; r < 4; ++r) { const int s = 64 * kt + 16 * sb + 4 * g + r; const float w = __builtin_amdgcn_exp2f(fminf(a_t + c4[r], 0.f)); pv[r] = (s <= t) ? sacc[sb][r] * w : 0.f; denp += pv[r]; }
                pw[2 * sb] = pk2(pv[0], pv[1]); pw[2 * sb + 1] = pk2(pv[2], pv[3]);
            }
            const bf16x8 pf0 = __builtin_bit_cast(bf16x8, (v4u){pw[0], pw[1], pw[2], pw[3]}), pf1 = __builtin_bit_cast(bf16x8, (v4u){pw[4], pw[5], pw[6], pw[7]});
            const int q = tl >> 2, p = lane & 3;
            const LAS unsigned char* vb = bV + (4 * g + q) * 64 + p * 8;
#pragma unroll
            for (int eb = 0; eb < 16; ++eb) {
                const LAS unsigned char* ve = vb + (eb >> 1) * 4096 + (eb & 1) * 32;
                acc[eb] = mfma16(trfrag(ve), pf0, acc[eb]);
                acc[eb] = mfma16(trfrag(ve + 32 * 64), pf1, acc[eb]);
            }
        }
    }
#undef MC_DMA_KV
#ifdef PROBE_MC
    PC_MARK(5);
#endif
    denp += __shfl_xor(denp, 16); denp += __shfl_xor(denp, 32);
    den += denp;
    const float inv = 1.0f / fmaxf(fabsf(den), expf(-m_t));
    float ss = 0.f;
#pragma unroll
    for (int eb = 0; eb < 16; ++eb) { acc[eb] = acc[eb] * inv; const f32x4 x = acc[eb]; ss += (x[0] * x[0] + x[1] * x[1]) + (x[2] * x[2] + x[3] * x[3]); }
    ss += __shfl_xor(ss, 16); ss += __shfl_xor(ss, 32);
    const float rr = 1.0f / sqrtf(ss * (1.0f / 256.0f) + 1e-6f);
    if (active) {
        const float* hn = ka->in[20] + (size_t)j * 1024 + head * 256;
        LAS unsigned char* scr = ring + (nkt > 1 ? 2 : 0) * 32768 + wid * 8192;
        bf16* gbase = (dry ? (bf16*)(A + WS_QKP) : OG) + (size_t)(row0 + 16 * wid + (lane >> 5)) * D + head * 256 + (lane & 31) * 8;
        const bf16* gin = OG + (size_t)(row0 + 16 * wid + (lane >> 5)) * D + head * 256 + (lane & 31) * 8;
        v4u gv[8];
#pragma unroll
        for (int i = 0; i < 8; ++i) gv[i] = *(const v4u*)(gin + (size_t)(2 * i) * D);
#pragma unroll
        for (int i = 0; i < 8; ++i) { const int r = 2 * i + (lane >> 5); *(LAS v4u*)(scr + r * 512 + (((lane & 31) ^ r) * 16)) = gv[i]; }
        asm volatile("s_waitcnt lgkmcnt(0)" ::: "memory");
        LAS unsigned char* lp = scr + tl * 512 + (g & 1) * 8;
#pragma unroll
        for (int eb = 0; eb < 16; ++eb) {
            const int e0 = 16 * eb + 4 * g; const f32x4 h4 = *(const f32x4*)(hn + e0); const f32x4 x = acc[eb];
            LAS v2u* p = (LAS v2u*)(lp + (((2 * eb + (g >> 1)) ^ tl) * 16));
            const v2u og = *p;
            v2u o; o.x = pk2(x[0] * rr * h4[0] * bflo(og.x), x[1] * rr * h4[1] * bfhi(og.x)); o.y = pk2(x[2] * rr * h4[2] * bflo(og.y), x[3] * rr * h4[3] * bfhi(og.y));
            *p = o;
        }
        asm volatile("s_waitcnt lgkmcnt(0)" ::: "memory");
#pragma unroll
        for (int i = 0; i < 8; ++i) { const int r = 2 * i + (lane >> 5); *(v4u*)(gbase + (size_t)(2 * i) * D) = *(const LAS v4u*)(scr + r * 512 + (((lane & 31) ^ r) * 16)); }
    }
    WAIT_ALL_BAR();
#ifdef PROBE_MC
    PC_MARK(6);
#endif
}


__global__ void __launch_bounds__(NWAVES * 64, 2) hybrid_fwd(Args args_unused) {
    extern __shared__ __attribute__((aligned(16))) unsigned char lds[];
    Frame F;
    F.lds = (LAS unsigned char*)lds;
    F.MISC = (volatile LAS unsigned*)(F.lds + MISC_OFF);
#define FRESH() do { int t_ = threadIdx.x; asm volatile("" : "+v"(t_)); F.tid = t_; F.lane = t_ & 63; F.wave = __builtin_amdgcn_readfirstlane(t_ >> 6); \
        unsigned l_ = (unsigned)(size_t)(LAS unsigned char*)lds; asm volatile("" : "+s"(l_)); F.lds = (LAS unsigned char*)(size_t)l_; F.MISC = (volatile LAS unsigned*)(F.lds + MISC_OFF); } while (0)
    FRESH();
    F.G = gridDim.x; { const int bx = blockIdx.x; F.vcu = (F.G % 8 == 0) ? (bx % 8) * (F.G / 8) + bx / 8 : bx; }
    F.ctl = (gu32*)(KA()->ws + WS_CTL);
    for (int u = F.tid; u < (LDS_BYTES - LDSCTL_OFF) / 4; u += NWAVES * 64) ((LAS unsigned*)(F.lds + LDSCTL_OFF))[u] = 0u;
    __syncthreads();
    (void)xcd_barrier_post((unsigned*)(F.ctl + CW_BAR), F.MISC + 8);
#define GRID_BAR() do { FRESH(); XcdBarrier b_; b_.bar = (unsigned*)((gu32*)(KA()->ws + WS_CTL) + CW_BAR); b_.x = (unsigned)__builtin_amdgcn_readfirstlane((int)xb_xcc_id()); b_.st = F.MISC + 8; xcd_barrier(b_); } while (0)

#ifndef PROBE_ONECH
#define PROBE_ONECH -1
#endif
#ifdef PROBE_PHC
#define PT_MARK(cls_) do { if (blockIdx.x == PROBE_WG && threadIdx.x == 0) { const unsigned now_ = (unsigned)__builtin_amdgcn_s_memrealtime(); if ((cls_) == PROBE_PHC || (PROBE_PHC == 9 && (cls_) >= 0)) F.MISC[60] = F.MISC[60] + (now_ - F.MISC[62]); F.MISC[62] = now_; F.MISC[61] = 1u; } } while (0)
#else
#define PT_MARK(cls_) do {} while (0)
#endif
    PT_MARK(-1);
#ifdef PROBE_LAST
    if (blockIdx.x == 0 && threadIdx.x == 0) { const unsigned long long st_ = __builtin_amdgcn_s_memrealtime(); __hip_atomic_store((unsigned long long*)((gu32*)(KA()->ws + WS_CTL) + 12000), st_, __ATOMIC_RELAXED, __HIP_MEMORY_SCOPE_AGENT); }
#endif
    FRESH(); p0_prologue(F);
    GRID_BAR(); PT_MARK(0);
#ifdef PROBE_BARS
    for (int pb_ = 0; pb_ < PROBE_BARS; ++pb_) { GRID_BAR(); }
#endif
#ifdef DUP_P0
    FRESH(); p0_prologue(F);
    GRID_BAR();
#endif
    { if (threadIdx.x == 0) { unsigned full = (F.G == 256) ? 1u : 0u; const unsigned* bw = (const unsigned*)((gu32*)(KA()->ws + WS_CTL) + CW_BAR);
          for (int jx = 0; jx < 16; ++jx) { const unsigned cnt = __hip_atomic_load(bw + XB_XCNT(jx), __ATOMIC_RELAXED, __HIP_MEMORY_SCOPE_AGENT); if (jx < 8 ? cnt != 32u : cnt != 0u) full = 0u; }
          F.MISC[10] = full; }
      __syncthreads(); }
#ifdef FORCE_SAFE
    const bool safe_mode = __builtin_amdgcn_readfirstlane((int)F.MISC[10]) != 12345;
#else
    const bool safe_mode = __builtin_amdgcn_readfirstlane((int)F.MISC[10]) == 0;
#endif
#pragma unroll 1
#ifdef PROBE_DUPCH
    for (int pc = -PROBE_NDUP; pc < 5; ++pc) {
        const int chain = pc < 0 ? PROBE_DUPCH : pc; const int j = chain >> 1;
        FRESH(); pg8::gemm_chain(F.lds + RING_OFF, F.MISC + 16, F.lds + RDYSLOT_OFF, (LAS unsigned long long*)(F.lds + EXTRA_OFF), chain, pc < 0 ? 5 - (pc + 1) : chain, safe_mode);
        if (pc < 0) { GRID_BAR(); continue; }
#else
    for (int chain = 0; chain < 5; ++chain) {
        const int j = chain >> 1;
#if defined(PROBE_TIME) && PROBE_SEG == 3
        unsigned long long pc0_ = PROBE_TIME == 1 ? __builtin_amdgcn_s_memrealtime() : __builtin_amdgcn_s_memtime();
#endif
        FRESH(); pg8::gemm_chain(F.lds + RING_OFF, F.MISC + 16, F.lds + RDYSLOT_OFF, (LAS unsigned long long*)(F.lds + EXTRA_OFF), chain, chain, safe_mode);
#if defined(PROBE_TIME) && PROBE_SEG == 3
        if (chain == PROBE_CH && blockIdx.x == PROBE_WG && threadIdx.x == 0) { const unsigned long long pc1_ = PROBE_TIME == 1 ? __builtin_amdgcn_s_memrealtime() : __builtin_amdgcn_s_memtime(); F.MISC[60] = F.MISC[60] + (unsigned)(pc1_ - pc0_); }
#endif
#endif
        if (chain == 4) break;
        if ((chain & 1) == 0) { FRESH(); cache_to_rings(F, j); }
        GRID_BAR(); PT_MARK((PROBE_ONECH < 0 || chain == PROBE_ONECH) ? 1 : 7);
        if ((chain & 1) == 0) {
            FRESH(); attn_phase(F, j);
#ifdef DUP_ATT
            GRID_BAR(); FRESH(); attn_phase(F, j);
#endif
            GRID_BAR(); PT_MARK(2);
        } else {
            FRESH(); for (int u = F.vcu; u < N_MUNITS; u += F.G) mlstm_a_unit(F, j, u);
            GRID_BAR(); PT_MARK(3);
#ifdef DUP_MA
            FRESH(); for (int u = F.vcu; u < N_MUNITS; u += F.G) mlstm_a_unit(F, j, u);
            GRID_BAR();
#endif
#ifdef DUP_MB
            FRESH(); mlstm_b_phase(F, j, true);
            GRID_BAR();
#endif
            FRESH(); mlstm_b_phase(F, j);
            GRID_BAR(); PT_MARK(4);
#ifdef DUP_MC
            FRESH(); for (int u = F.vcu; u < N_MUNITS; u += F.G) mlstm_c_unit(F, j, u, true);
            GRID_BAR();
#endif
            FRESH(); for (int u = F.vcu; u < N_MUNITS; u += F.G) mlstm_c_unit(F, j, u);
            GRID_BAR(); PT_MARK(5);
        }
    }
    PT_MARK(1);
#if defined(PROBE_TIME) || defined(PROBE_PHC) || defined(PROBE_ATT) || defined(PROBE_MA) || defined(PROBE_MC)
    if (blockIdx.x == PROBE_WG && threadIdx.x == 0) { const unsigned tot = F.MISC[60], cnt = F.MISC[61];
        const unsigned long long wait_ticks = cnt ? (unsigned long long)((float)tot * (float)(PROBE_SCALE * 100.0) / (float)cnt) : 0ull;
        const unsigned long long t0 = __builtin_amdgcn_s_memrealtime(); while (__builtin_amdgcn_s_memrealtime() - t0 < wait_ticks) __builtin_amdgcn_s_sleep(8); }
#endif
#ifdef PROBE_LAST
    if (threadIdx.x == 0) { unsigned* cw_ = (unsigned*)KA()->ws + 12064; const unsigned n_ = __hip_atomic_fetch_add(cw_, 1u, __ATOMIC_RELAXED, __HIP_MEMORY_SCOPE_AGENT);
        if (n_ == gridDim.x - 1) { const unsigned long long st_ = __hip_atomic_load((unsigned long long*)((gu32*)(KA()->ws + WS_CTL) + 12000), __ATOMIC_RELAXED, __HIP_MEMORY_SCOPE_AGENT);
            const unsigned long long t0 = __builtin_amdgcn_s_memrealtime(); const unsigned long long wait_ticks = (unsigned long long)((float)(t0 - st_) * (float)PROBE_SCALE);
            while (__builtin_amdgcn_s_memrealtime() - t0 < wait_ticks) __builtin_amdgcn_s_sleep(8); } }
#endif
#undef GRID_BAR
}

extern "C" void kernel_launch(void* const* d_in, const int* in_sizes, int n_in, void* d_out, int out_size, void* d_ws, size_t ws_size, hipStream_t stream) {
    static int grid = 0;
    if (grid == 0) {
        if (n_in != 24 || (size_t)out_size != O_END || ws_size < WS_END) { fprintf(stderr, "kernel_launch: unexpected shapes: n_in %d out %d ws %zu (need %zu)\n", n_in, out_size, ws_size, (size_t)WS_END); grid = -1; return; }
        int dev = 0, cus = 0, per_cu = 0;
        if (hipGetDevice(&dev) != hipSuccess || hipDeviceGetAttribute(&cus, hipDeviceAttributeMultiprocessorCount, dev) != hipSuccess) { fprintf(stderr, "kernel_launch: device query failed\n"); grid = -1; return; }
        if (hipFuncSetAttribute((const void*)hybrid_fwd, hipFuncAttributeMaxDynamicSharedMemorySize, LDS_BYTES) != hipSuccess) { fprintf(stderr, "kernel_launch: hipFuncSetAttribute failed\n"); grid = -1; return; }
        if (hipOccupancyMaxActiveBlocksPerMultiprocessor(&per_cu, (const void*)hybrid_fwd, NWAVES * 64, LDS_BYTES) != hipSuccess || per_cu < 1)
            fprintf(stderr, "kernel_launch: note: occupancy query reports %d workgroups per CU\n", per_cu);
        (void)hipGetLastError();
        grid = cus;
    }
    if (grid < 0) return;
    if (hipMemsetAsync((char*)d_ws + WS_CTL, 0, CTL_ZERO_BYTES, stream) != hipSuccess) { fprintf(stderr, "kernel_launch: hipMemsetAsync failed\n"); return; }
    Args a{};
    for (int i = 0; i < 24; ++i) a.in[i] = (const float*)d_in[i];
    a.out = (float*)d_out; a.ws = (unsigned char*)d_ws;
    hipLaunchKernelGGL(hybrid_fwd, dim3(grid), dim3(NWAVES * 64), LDS_BYTES, stream, a);
    const hipError_t le = hipPeekAtLastError();
    if (le != hipSuccess) fprintf(stderr, "kernel_launch: launch failed: %s\n", hipGetErrorName(le));
}
```

```cpp
#include <hip/hip_runtime.h>
#include <cstdio>
#include <cstdint>
constexpr int MP = 16384, MS = 1024, MT = 17408, D = 1024, FF = 4096, NQKV = 3072, NMIN = 4352  , NMIN_REAL = 4104;
constexpr int HIDP = 4096 + 64;
constexpr int N_MUNITS = 576;
constexpr size_t SLAB_BYTES = 272 * 256 * 2;
constexpr size_t O_Y = 0, O_KP = 17825792, O_VP = 18874368, O_KS = 19922944, O_VS = 22020096, O_CP = 24117248, O_NP = 24641536, O_MP = 24643584, O_BP = 24643592,
                 O_CS = 24655880, O_NS = 33044488, O_MS = 33077256, O_BS = 33077384, O_END = 33273992;
constexpr size_t MiB = 1u << 20;
constexpr size_t WS_CTL = 0, WS_SSQ = MiB / 2, CTL_ZERO_BYTES = 2 * MiB;
constexpr float SSQ_FIX = 268435456.0f, SSQ_UNFIX = 1.0f / 268435456.0f;
constexpr size_t WS_WINA = 2 * MiB, WS_WOA = 14 * MiB, WS_WINB = 18 * MiB, WS_WOB = 35 * MiB, WS_WUP = 39 * MiB, WS_WDN = 71 * MiB;
constexpr size_t WS_XB = 104 * MiB, WS_GATES = 139 * MiB, WS_STATS = 140 * MiB;
constexpr size_t WS_MIX = 141 * MiB, WS_HID = 175 * MiB, WS_NXT = 320 * MiB, WS_END = 422 * MiB;
constexpr size_t WS_Q = WS_MIX, WS_O = WS_MIX, WS_OG = WS_MIX;
constexpr size_t WS_KP = WS_NXT, WS_VP = WS_NXT + 32 * MiB, WS_RK = WS_NXT + 64 * MiB, WS_RV = WS_NXT + 82 * MiB;
constexpr size_t WS_QKP = WS_NXT, WS_V = WS_NXT + 68 * MiB;
constexpr size_t WS_QC = WS_HID, WS_KC = WS_HID + 34 * MiB, WS_SLAB = WS_HID + 68 * MiB;
static_assert(WS_SLAB + (size_t)N_MUNITS * SLAB_BYTES <= WS_NXT && WS_RV + 18 * MiB <= WS_END && WS_V + 34 * MiB <= WS_END && WS_HID + (size_t)MT * HIDP * 2 <= WS_NXT, "d_ws map");
constexpr int CW_BAR = 4096;
constexpr int RING_OFF = 0, RING_BYTES = 131072, EXTRA_OFF = RING_BYTES, EXTRA_BYTES = 28672  , EPITR_OFF = EXTRA_OFF + 12288, LDSCTL_OFF = EXTRA_OFF + EXTRA_BYTES, MISC_OFF = LDSCTL_OFF + 320, RDYSLOT_OFF = LDSCTL_OFF + 1024  ;
constexpr int LDS_BYTES = 163840;
static_assert(MISC_OFF + 128 <= LDS_BYTES, "LDS map");
constexpr int NWAVES = 8;

namespace pg8 {
#define PG8_LAS __attribute__((address_space(3)))
typedef unsigned short bf16_t;
typedef short bf16x8 __attribute__((ext_vector_type(8)));
typedef float f32x4 __attribute__((ext_vector_type(4)));
typedef unsigned u32x4 __attribute__((ext_vector_type(4)));
constexpr int BM = 256, BK = 64, HALF = 128, HTB = HALF * BK * 2  , STAGE_BYTES = 8 * HTB, NXCD = 8, WGM = 8;

__host__ __device__ __forceinline__ int lds_byte(int r, int c) { const int st = (r >> 4) * 2 + (c >> 5), rr = r & 15, cc = c & 31, ob = rr * 64 + cc * 2; return st * 1024 + (ob ^ (((ob >> 9) & 1) << 5)); }
__host__ __device__ __forceinline__ void stage_rc(int b, int& R, int& C) { const int st = b / 1024, sb = b % 1024, swz = sb ^ (((sb >> 9) & 1) << 5); R = (st >> 1) * 16 + swz / 64; C = (st & 1) * 32 + (swz % 64) / 2; }
__host__ __device__ __forceinline__ int perm32(int rho) { const int n = rho >> 4, i = rho & 15; return 8 * (i >> 2) + 4 * n + (i & 3); }

struct Unit { int pm, pn; };
struct Gemm { const bf16_t* A; const bf16_t* Bt; int M, N, K; };

struct StaticOrder {
    int nM, nN, nwg, G, c;
    __host__ __device__ void init(int M, int N, int G_, int c_) { nM = M / BM; nN = N / BM; nwg = nM * nN; G = G_; c = c_; }
    __host__ __device__ bool next(int i, Unit& u) const {
        const long L = (long)i * G + c; if (L >= nwg) return false;
        int wgid = (int)L; { const int q = nwg / NXCD, r = nwg % NXCD, xcd = wgid % NXCD, off = wgid / NXCD; wgid = (xcd < r ? xcd * (q + 1) : r * (q + 1) + (xcd - r) * q) + off; }
        const int nig = WGM * nN, gid = wgid / nig, fm = gid * WGM, gsz = (nM - fm) < WGM ? (nM - fm) : WGM;
        u.pm = fm + ((wgid % nig) % gsz); u.pn = (wgid % nig) / gsz; return true;
    }
    __device__ __forceinline__ void a_ready(const Unit&) const {}
    __device__ __forceinline__ void done(const Unit&) const {}
};

constexpr int MP_ROWS = MP, MS_ROWS = MS, DM = D;
constexpr size_t BLK_KT = 32768, BLK_AI = 16384;
__host__ __device__ __forceinline__ constexpr int blk_img(int wr, int wcl, int m, int fr, int fq) { return ((4 * wr + m) * 2 + wcl) * 1024 + ((fr * 64 + fq * 16) ^ ((fr >> 3) << 5)); }
constexpr float NEPS = 1e-6f;
struct Args { const float* in[24]; float* out; unsigned char* ws; };
typedef const __attribute__((address_space(4))) Args* KArgs;
__device__ __forceinline__ KArgs KA() { KArgs p = (KArgs)__builtin_amdgcn_kernarg_segment_ptr(); asm volatile("" : "+s"(p)); return p; }
typedef float f32x2_e __attribute__((ext_vector_type(2))); typedef __bf16 bf16x2_e __attribute__((ext_vector_type(2)));
__device__ __forceinline__ unsigned cvt_pk_bf16(float lo, float hi) { f32x2_e v = {lo, hi}; bf16x2_e b = __builtin_convertvector(v, bf16x2_e); return __builtin_bit_cast(unsigned, b); }
__device__ __forceinline__ u32x4 pack8(const f32x4 v0, const f32x4 v1) { u32x4 w; w.x = cvt_pk_bf16(v0[0], v0[1]); w.y = cvt_pk_bf16(v0[2], v0[3]); w.z = cvt_pk_bf16(v1[0], v1[1]); w.w = cvt_pk_bf16(v1[2], v1[3]); return w; }
typedef __amdgpu_buffer_rsrc_t rsrc_t;
__device__ __forceinline__ rsrc_t mk_rsrc(const void* p, unsigned bytes) { return __builtin_amdgcn_make_buffer_rsrc((void*)p, 0, (int)bytes, 0x00020000); }
__device__ __forceinline__ f32x4 bld16(rsrc_t r, unsigned off) { return __builtin_bit_cast(f32x4, __builtin_amdgcn_raw_buffer_load_b128(r, (int)off, 0, 16)); }
__device__ __forceinline__ void bst16(rsrc_t r, unsigned off, u32x4 v, bool wt) { if (wt) __builtin_amdgcn_raw_buffer_store_b128(v, r, (int)off, 0, 16); else __builtin_amdgcn_raw_buffer_store_b128(v, r, (int)off, 0, 0); }
__device__ __forceinline__ void bst16(rsrc_t r, unsigned off, f32x4 v, bool wt) { bst16(r, off, __builtin_bit_cast(u32x4, v), wt); }
__device__ __forceinline__ void epi_tr(PG8_LAS unsigned char* slot, int fr, int fq, const u32x4 in0, const u32x4 in1, u32x4& out0, u32x4& out1) {
    const int lane = fq * 16 + fr, r = lane >> 3, c = lane & 7;
    asm volatile("" ::: "memory");
    *(PG8_LAS u32x4*)(slot + fr * 128 + ((fq ^ (fr & 7)) * 16)) = in0;
    *(PG8_LAS u32x4*)(slot + fr * 128 + (((4 + fq) ^ (fr & 7)) * 16)) = in1;
    asm volatile("s_waitcnt lgkmcnt(0)" ::: "memory");
    out0 = *(const PG8_LAS u32x4*)(slot + r * 128 + ((c ^ (r & 7)) * 16));
    out1 = *(const PG8_LAS u32x4*)(slot + (8 + r) * 128 + ((c ^ (r & 7)) * 16));
    asm volatile("s_waitcnt lgkmcnt(0)" ::: "memory");
}
template <int NAI> __device__ __forceinline__ void row_scales(const unsigned long long* ssqk, int row0, float (&rs)[NAI][4], const PG8_LAS unsigned long long* sl = nullptr, int lrow0 = 0) {
    unsigned long long raw[NAI][4];
    if (sl) {
#pragma unroll
        for (int ai = 0; ai < NAI; ++ai)
#pragma unroll
            for (int m = 0; m < 4; ++m) raw[ai][m] = sl[lrow0 + ai * HALF + m * 16];
    } else {
#pragma unroll
        for (int ai = 0; ai < NAI; ++ai)
#pragma unroll
            for (int m = 0; m < 4; ++m) raw[ai][m] = __hip_atomic_load(ssqk + row0 + ai * HALF + m * 16, __ATOMIC_RELAXED, __HIP_MEMORY_SCOPE_AGENT);
    }
#pragma unroll
    for (int ai = 0; ai < NAI; ++ai)
#pragma unroll
        for (int m = 0; m < 4; ++m) rs[ai][m] = 1.0f / sqrtf((float)raw[ai][m] * (SSQ_UNFIX / 1024.0f) + NEPS);
}

struct EpiRes {
    int last, kout, dry, wt;
    __device__ __forceinline__ void operator()(const f32x4 (&acc)[2][2][4][2], const Unit& u, int wr, int wc, int fr, int fq) const { run<2>(acc, u.pm * BM + wr * 64, u.pn, wc, fr, fq); }
    template <int NAI> __device__ __forceinline__ void run(const f32x4 (&acc)[NAI][2][4][2], int rowbase, int pn, int wc, int fr, int fq) const {
        KArgs ka = KA(); float* out = ka->out; unsigned char* ws = ka->ws; unsigned long long* ssq = (unsigned long long*)(ws + WS_SSQ) + (size_t)kout * MT;
        const rsrc_t rb = mk_rsrc(ws + WS_XB, MT * D * 2u);
        const rsrc_t ro = dry ? mk_rsrc(ws + WS_NXT, MT * D * 4u) : mk_rsrc(out, MT * D * 4u), rx = dry ? mk_rsrc(ws + WS_NXT + 68 * MiB, MT * D * 2u) : rb;
        const int row0 = rowbase + fr, col0 = pn * BM + wc * 32 + 8 * fq;
        const unsigned xo = (unsigned)(rowbase >> 8) * (256u * DM * 2u) + (unsigned)(4 * pn + (wc >> 1)) * (unsigned)BLK_KT + (unsigned)blk_img((rowbase >> 6) & 1, wc & 1, 0, fr, fq);
#pragma unroll
        for (int ai = 0; ai < NAI; ++ai) {
            u32x4 b[4][2];
#pragma unroll
            for (int m = 0; m < 4; ++m)
#pragma unroll
                for (int bj = 0; bj < 2; ++bj) b[m][bj] = __builtin_bit_cast(u32x4, bld16(rb, xo + (unsigned)(2 * bj * (int)BLK_KT + ai * (int)BLK_AI + m * 2048)));
#pragma unroll
            for (int m = 0; m < 4; ++m) {
                const int row = row0 + ai * HALF + m * 16; const unsigned eo = (unsigned)(row * DM + col0);
                float ss = 0.f;
#pragma unroll
                for (int bj = 0; bj < 2; ++bj) {
                    const u32x4 w = b[m][bj];
                    const f32x4 b0 = {__uint_as_float(w.x << 16), __uint_as_float(w.x & 0xffff0000u), __uint_as_float(w.y << 16), __uint_as_float(w.y & 0xffff0000u)};
                    const f32x4 b1 = {__uint_as_float(w.z << 16), __uint_as_float(w.z & 0xffff0000u), __uint_as_float(w.w << 16), __uint_as_float(w.w & 0xffff0000u)};
                    const f32x4 v0 = acc[ai][bj][m][0] + b0, v1 = acc[ai][bj][m][1] + b1;
                    if (last) { bst16(ro, (eo + bj * HALF) * 4u, v0, wt); bst16(ro, (eo + bj * HALF) * 4u + 16u, v1, wt); }
                    else bst16(rx, xo + (unsigned)(2 * bj * (int)BLK_KT + ai * (int)BLK_AI + m * 2048), pack8(v0, v1), wt);
                    ss += (v0[0] * v0[0] + v0[1] * v0[1]) + (v0[2] * v0[2] + v0[3] * v0[3]) + (v1[0] * v1[0] + v1[1] * v1[1]) + (v1[2] * v1[2] + v1[3] * v1[3]);
                }
                ss += __shfl_xor(ss, 16); ss += __shfl_xor(ss, 32);
                if (fq == 0) atomicAdd(ssq + row, (unsigned long long)(ss * SSQ_FIX));
            }
            asm volatile("" ::: "memory");
        }
    }
};

struct EpiUp {
    int kin, wt; const PG8_LAS unsigned long long* sl;
    __device__ __forceinline__ void operator()(const f32x4 (&acc)[2][2][4][2], const Unit& u, int wr, int wc, int fr, int fq) const { run<2>(acc, u.pm * BM + wr * 64, u.pn, wc, fr, fq); }
    template <int NAI> __device__ __forceinline__ void run(const f32x4 (&acc)[NAI][2][4][2], int rowbase, int pn, int wc, int fr, int fq) const {
        KArgs ka = KA(); unsigned char* ws = ka->ws; const unsigned long long* ssq = (const unsigned long long*)(ws + WS_SSQ) + (size_t)kin * MT;
        const rsrc_t rh = mk_rsrc(ws + WS_HID, MT * (unsigned)HIDP * 2u);
        const int row0 = rowbase + fr;
        const unsigned ho = (unsigned)(rowbase >> 8) * (256u * FF * 2u) + (unsigned)(4 * pn + (wc >> 1)) * (unsigned)BLK_KT + (unsigned)blk_img((rowbase >> 6) & 1, wc & 1, 0, fr, fq);
        float rs[NAI][4]; row_scales<NAI>(ssq, row0, rs, sl, (rowbase & 255) + fr);
#pragma unroll
        for (int ai = 0; ai < NAI; ++ai)
#pragma unroll
            for (int m = 0; m < 4; ++m) {
#pragma unroll
                for (int bj = 0; bj < 2; ++bj) {
                    f32x4 v0 = acc[ai][bj][m][0] * rs[ai][m], v1 = acc[ai][bj][m][1] * rs[ai][m];
#pragma unroll
                    for (int i = 0; i < 4; ++i) { const float a = fmaxf(v0[i], 0.f), b = fmaxf(v1[i], 0.f); v0[i] = a * a; v1[i] = b * b; }
                    bst16(rh, ho + (unsigned)(2 * bj * (int)BLK_KT + ai * (int)BLK_AI + m * 2048), pack8(v0, v1), wt);
                }
            }
    }
};

struct EpiQKV {
    int j, kin; const PG8_LAS unsigned long long* sl; PG8_LAS unsigned char* slot;
    __device__ __forceinline__ void operator()(const f32x4 (&acc)[2][2][4][2], const Unit& u, int wr, int wc, int fr, int fq) const { run<2>(acc, u.pm * BM + wr * 64, u.pn, wc, fr, fq); }
    template <int NAI> __device__ __forceinline__ void run(const f32x4 (&acc)[NAI][2][4][2], int rowbase, int pn, int wc, int fr, int fq) const {
        KArgs ka = KA(); unsigned char* ws = ka->ws; float* out = ka->out; const unsigned long long* ssq = (const unsigned long long*)(ws + WS_SSQ) + (size_t)kin * MT; const float* qg = ka->in[12] + j * 64; const float* kg = ka->in[13] + j * 64;
        bf16_t *Q = (bf16_t*)(ws + WS_Q), *KP = (bf16_t*)(ws + WS_KP), *VP = (bf16_t*)(ws + WS_VP), *RK = (bf16_t*)(ws + WS_RK), *RV = (bf16_t*)(ws + WS_RV);
        float *okp = out + O_KP + (size_t)j * 512 * DM, *ovp = out + O_VP + (size_t)j * 512 * DM, *oks = out + O_KS + (size_t)j * MS_ROWS * DM, *ovs = out + O_VS + (size_t)j * MS_ROWS * DM;
        const int t = pn >> 2, head = (pn & 3) * 4 + wc;
        const int row0 = rowbase + fr;
        float rs[NAI][4]; row_scales<NAI>(ssq, row0, rs, sl, (rowbase & 255) + fr);
        f32x4 g[2][2];
        const float* gp = (t == 0) ? qg : kg;
#pragma unroll
        for (int bj = 0; bj < 2; ++bj)
#pragma unroll
            for (int n = 0; n < 2; ++n) { g[bj][n] = (t < 2) ? *(const f32x4*)(gp + 32 * bj + 8 * fq + 4 * n) : (f32x4){1.f, 1.f, 1.f, 1.f}; if (t == 0) g[bj][n] = g[bj][n] * (0.125f * 1.4426950408889634f); }
#pragma unroll
        for (int ai = 0; ai < NAI; ++ai)
#pragma unroll
            for (int m = 0; m < 4; ++m) {
                const int row = row0 + ai * HALF + m * 16;
                f32x4 v[2][2]; float ss = 0.f;
#pragma unroll
                for (int bj = 0; bj < 2; ++bj)
#pragma unroll
                    for (int n = 0; n < 2; ++n) { v[bj][n] = acc[ai][bj][m][n] * rs[ai][m]; const f32x4 x = v[bj][n]; ss += (x[0] * x[0] + x[1] * x[1]) + (x[2] * x[2] + x[3] * x[3]); }
                if (t < 2) {
                    ss += __shfl_xor(ss, 16); ss += __shfl_xor(ss, 32);
                    const float rr = 1.0f / sqrtf(ss * (1.0f / 64.0f) + NEPS);
#pragma unroll
                    for (int bj = 0; bj < 2; ++bj)
#pragma unroll
                        for (int n = 0; n < 2; ++n) v[bj][n] = v[bj][n] * rr * g[bj][n];
                }
                {
                    u32x4 o0, o1; epi_tr(slot, fr, fq, pack8(v[0][0], v[0][1]), pack8(v[1][0], v[1][1]), o0, o1);
                    const int ln = fq * 16 + fr, col = head * 64 + (ln & 7) * 8;
#pragma unroll
                    for (int h = 0; h < 2; ++h) {
                        const int rw = rowbase + ai * HALF + m * 16 + 8 * h + (ln >> 3);
                        bf16_t* dstb;
                        if (t == 0) dstb = Q + (size_t)rw * DM + col;
                        else if (rw < MP_ROWS) dstb = (t == 1 ? KP : VP) + (size_t)rw * DM + col;
                        else { const int sr = rw - MP_ROWS, b = sr >> 6, tt = sr & 63; dstb = (t == 1 ? RK : RV) + ((size_t)b * 576 + 512 + tt) * DM + col; }
                        *(u32x4*)dstb = h ? o1 : o0;
                    }
                }
                if (t != 0 && (row >= MP_ROWS - 512)) {
#pragma unroll
                    for (int bj = 0; bj < 2; ++bj) {
                        const int col = head * 64 + 32 * bj + 8 * fq;
                        float* dstf;
                        if (row < MP_ROWS) dstf = (t == 1 ? okp : ovp) + (size_t)(row - (MP_ROWS - 512)) * DM + col;
                        else dstf = (t == 1 ? oks : ovs) + (size_t)(row - MP_ROWS) * DM + col;
                        *(f32x4*)dstf = v[bj][0]; *(f32x4*)(dstf + 4) = v[bj][1];
                    }
                }
            }
    }
};

struct EpiMIn {
    int j, kin; const PG8_LAS unsigned long long* sl; PG8_LAS unsigned char* slot;
    __device__ __forceinline__ void operator()(const f32x4 (&acc)[2][2][4][2], const Unit& u, int wr, int wc, int fr, int fq) const { run<2>(acc, u.pm * BM + wr * 64, u.pn, wc, fr, fq); }
    template <int NAI> __device__ __forceinline__ void run(const f32x4 (&acc)[NAI][2][4][2], int rowbase, int pn, int wc, int fr, int fq) const {
        KArgs ka = KA(); unsigned char* ws = ka->ws; float* out = ka->out; const unsigned long long* ssq = (const unsigned long long*)(ws + WS_SSQ) + (size_t)kin * MT; const float* b_i = ka->in[16] + j * 4; const float* b_f = ka->in[17] + j * 4;
        bf16_t *QKP = (bf16_t*)(ws + WS_QKP), *V = (bf16_t*)(ws + WS_V), *OG = (bf16_t*)(ws + WS_OG); float* gates = (float*)(ws + WS_GATES);
        float *ocp = out + O_BP + (size_t)j * 3 * 2048, *ocs = out + O_BS + (size_t)j * 16 * 3 * 2048;
        const int row0 = rowbase + fr, cl0 = wc * 32 + 8 * fq;
        if (pn == 16 && !(wc == 0 && fq == 0)) return;
        float rs[NAI][4]; row_scales<NAI>(ssq, row0, rs, sl, (rowbase & 255) + fr);
#pragma unroll
        for (int ai = 0; ai < NAI; ++ai)
#pragma unroll
            for (int m = 0; m < 4; ++m) {
                const int row = row0 + ai * HALF + m * 16;
                if (pn == 16) {
                    const f32x4 gi = acc[ai][0][m][0] * rs[ai][m] + *(const f32x4*)b_i, gf = acc[ai][0][m][1] * rs[ai][m] + *(const f32x4*)b_f;
                    f32x4 lf;
#pragma unroll
                    for (int i = 0; i < 4; ++i) lf[i] = fminf(gf[i], 0.f) - log1pf(expf(-fabsf(gf[i])));
                    *(f32x4*)(gates + (size_t)row * 8) = gi; *(f32x4*)(gates + (size_t)row * 8 + 4) = lf;
                    continue;
                }
                u32x4 wq[2];
#pragma unroll
                for (int bj = 0; bj < 2; ++bj) {
                    f32x4 v0 = acc[ai][bj][m][0] * rs[ai][m], v1 = acc[ai][bj][m][1] * rs[ai][m];
                    if (pn < 8) {
                        const int col = pn * BM + cl0 + bj * HALF;
                        float* dstf = nullptr;
                        if (row < MP_ROWS) { if (row >= MP_ROWS - 3) dstf = ocp + (size_t)(row - (MP_ROWS - 3)) * 2048 + col; }
                        else { const int sr = row - MP_ROWS, b = sr >> 6, tt = sr & 63; if (tt >= 61) dstf = ocs + ((size_t)b * 3 + (tt - 61)) * 2048 + col; }
                        if (dstf) { *(f32x4*)dstf = v0; *(f32x4*)(dstf + 4) = v1; }
                    } else if (pn >= 12) {
#pragma unroll
                        for (int i = 0; i < 4; ++i) { v0[i] = __builtin_amdgcn_rcpf(1.0f + __expf(-v0[i])); v1[i] = __builtin_amdgcn_rcpf(1.0f + __expf(-v1[i])); }
                    }
                    wq[bj] = pack8(v0, v1);
                }
                {
                    u32x4 o0, o1; epi_tr(slot, fr, fq, wq[0], wq[1], o0, o1);
                    const int ln = fq * 16 + fr, cl = wc * 32 + (ln & 3) * 8 + ((ln >> 2) & 1) * HALF;
                    bf16_t* dst = (pn < 8) ? QKP + (size_t)pn * BM + cl : (pn < 12) ? V + (size_t)(pn - 8) * BM + cl : OG + (size_t)(pn - 12) * BM + cl;
                    const int pitch = (pn < 8) ? 2048 : DM;
                    const int rw = rowbase + ai * HALF + m * 16 + (ln >> 3);
                    *(u32x4*)(dst + (size_t)rw * pitch) = o0; *(u32x4*)(dst + (size_t)(rw + 8) * pitch) = o1;
                }
            }
    }
};
}

namespace pg8 {
constexpr int CW_Q = 8192, CW_RDY = 16384;
struct UnitX { const char* A; const char* B; int K, lda, pm, pn, stage; };
__device__ __forceinline__ int chain_nn3(int chain) { return (chain == 4) ? 0 : ((chain & 1) ? 17 : 12); }
__device__ __forceinline__ int chain_scnt(int nN, int q) { return (4 * nN - q + 7) >> 3; }
__device__ __forceinline__ int chain_total(int chain, int q) {
    const int n3 = chain_nn3(chain), t3 = n3 ? chain_scnt(n3, q) + 8 * n3 : 0;
    return chain == 0 ? t3 : (2 + 32) + (8 + 128) + (2 + 32) + t3;
}
__device__ __forceinline__ void chain_decode(int chain, int q, int L, UnitX& u, int& need) {
    KArgs ka = KA(); const unsigned char* ws = ka->ws;
    int s, i, samp = 0;
    if (chain == 0) { s = 3; i = L; }
    else if (L < 34) { s = 0; i = L; samp = 2; }
    else if (L < 172) {
        const int x = L - 34;
        if (x < 56) { s = 1; i = x; samp = 8; } else if (x < 58) { s = 2; i = x - 56; samp = 2; } else { s = 1; i = x - 2; samp = 8; }
    }
    else if (L < 204) { s = 2; i = L - 172 + 2; samp = 2; }
    else { s = 3; i = L - 204; }
    const int l = chain - 1, lin = chain;
    int nN, K = 1024; const unsigned char *A, *B;
    if (s == 0)      { nN = 4;  A = ws + WS_MIX; B = ws + ((l & 1) ? WS_WOB : WS_WOA) + (size_t)(l >> 1) * 1024 * 1024 * 2; }
    else if (s == 1) { nN = 16; A = ws + WS_XB;  B = ws + WS_WUP + (size_t)l * 4096 * 1024 * 2; }
    else if (s == 2) { nN = 4;  A = ws + WS_HID; B = ws + WS_WDN + (size_t)l * HIDP * 1024 * 2; K = 4096; }
    else             { nN = (lin & 1) ? 17 : 12; A = ws + WS_XB; B = (lin & 1) ? ws + WS_WINB + (size_t)(lin >> 1) * 4352 * 1024 * 2 : ws + WS_WINA + (size_t)(lin >> 1) * 3072 * 1024 * 2; samp = chain_scnt(nN, q); }
    if (i < samp) { const int e = q + 8 * i, sp = e / nN; u.pm = 64 + sp; u.pn = e - sp * nN; }
    else { const int ip = i - samp, gsz = 4 * nN, g = ip >= gsz ? 1 : 0, r = ip - g * gsz; u.pm = q + 8 * (4 * g + (r & 3)); u.pn = r >> 2; }
    u.K = K; u.stage = s; u.lda = (s == 2) ? HIDP : K;
    u.A = (const char*)A + (size_t)u.pm * 256 * K * 2; u.B = (const char*)B + (size_t)u.pn * 256 * K * 2;
    need = (s == 1) ? 32 : (s == 2) ? 128 : (s == 3 && chain > 0) ? 32 : 0;
}
__device__ __forceinline__ int chain_kin(int chain, int stage, bool dry) { return stage == 1 ? (dry ? 6 : 2 * chain - 1) : (stage == 3 ? 2 * chain : -1); }
__device__ __forceinline__ void chain_epilogue(int chain, bool dry, bool wt, const PG8_LAS unsigned long long* sl, PG8_LAS unsigned char* slot, const UnitX& u, const f32x4 (&acc)[2][2][4][2], int wr, int wc, int fr, int fq) {
    const int rowbase = u.pm * BM + wr * 64;
    if (u.stage == 0 || u.stage == 2) { EpiRes E{(chain == 4 && u.stage == 2 && !dry) ? 1 : 0, dry ? 9 : 2 * chain - 1 + (u.stage >> 1), dry ? 1 : 0, wt ? 1 : 0}; E.run<2>(acc, rowbase, u.pn, wc, fr, fq); }
    else if (u.stage == 1) { EpiUp E{chain_kin(chain, 1, dry), wt ? 1 : 0, sl}; E.run<2>(acc, rowbase, u.pn, wc, fr, fq); }
    else if (chain & 1) { EpiMIn E{chain >> 1, 2 * chain, sl, slot}; E.run<2>(acc, rowbase, u.pn, wc, fr, fq); }
    else { EpiQKV E{chain >> 1, 2 * chain, sl, slot}; E.run<2>(acc, rowbase, u.pn, wc, fr, fq); }
}

__device__ __forceinline__ void gemm_chain(PG8_LAS unsigned char* lds, volatile PG8_LAS unsigned* bx  , PG8_LAS unsigned char* rslot  , PG8_LAS unsigned long long* sslot  , const int chain, const int cchain  , const bool safe  ) {
    int tid_ = threadIdx.x; asm volatile("" : "+v"(tid_));
    const int tid = tid_, wid = __builtin_amdgcn_readfirstlane(tid >> 6), lane = tid & 63, wr = wid >> 2, wc = wid & 3, fr = lane & 15, fq = lane >> 4;
    unsigned* const ctl = (unsigned*)KA()->ws;
    unsigned* const qw = ctl + CW_Q + 64 * 8 * cchain;
    unsigned* const rdy = ctl + CW_RDY + (size_t)cchain * 3 * 68 * 64;
#define CH_VOFF(LA_, BLK_, vA_, vB_) do { _Pragma("unroll") for (int i_ = 0; i_ < 2; ++i_) { int R_, C_; stage_rc(tid * 16 + i_ * 8192, R_, C_); const int Rb_ = (R_ & ~31) + perm32(R_ & 31); \
        vA_[i_] = (BLK_) ? (unsigned)(tid * 16 + i_ * 8192) : (unsigned)(R_ * (LA_) + C_) * 2u; vB_[i_] = (unsigned)(tid * 16 + i_ * 8192); (void)Rb_; } } while (0)
    const size_t kstep = (size_t)(BK * 2);
    const unsigned ldsw = (unsigned)wid * 1024u;
    const int aoff = lds_byte(wr * 64 + fr, fq * 8), boff = lds_byte(wc * 32 + fr, fq * 8);
#ifndef PG8_A_AUX
#define PG8_A_AUX 16
#endif
#define PG8_SA(b, h) (((b) * 2 + (h)) * HTB)
#define PG8_SB(b, h) ((4 + (b) * 2 + (h)) * HTB)
#define PG8_STAGE_A(bufoff, gbase, voff) do { _Pragma("unroll") for (int _i = 0; _i < 2; ++_i) \
        __builtin_amdgcn_global_load_lds((const unsigned*)((const char*)(gbase) + (voff)[_i]), (PG8_LAS unsigned*)(lds + (bufoff) + ldsw + _i * 8192), 16, 0, PG8_A_AUX); } while (0)
#define PG8_STAGE_B(bufoff, gbase, voff) do { _Pragma("unroll") for (int _i = 0; _i < 2; ++_i) \
        __builtin_amdgcn_global_load_lds((const unsigned*)((const char*)(gbase) + (voff)[_i]), (PG8_LAS unsigned*)(lds + (bufoff) + ldsw + _i * 8192), 16, 0, 0); } while (0)
#define PG8_LDA(dst, b, h) do { _Pragma("unroll") for (int m = 0; m < 4; ++m) _Pragma("unroll") for (int k = 0; k < 2; ++k) dst[m][k] = *(const PG8_LAS bf16x8*)(lds + PG8_SA(b, h) + aoff + m * 2048 + k * 1024); } while (0)
#define PG8_LDB(dst, b, h) do { _Pragma("unroll") for (int n = 0; n < 2; ++n) _Pragma("unroll") for (int k = 0; k < 2; ++k) dst[n][k] = *(const PG8_LAS bf16x8*)(lds + PG8_SB(b, h) + boff + n * 2048 + k * 1024); } while (0)
#define PG8_MMA(ai, bj, At, Bt) do { __builtin_amdgcn_s_setprio(1); _Pragma("unroll") for (int m = 0; m < 4; ++m) _Pragma("unroll") for (int n = 0; n < 2; ++n) _Pragma("unroll") for (int k = 0; k < 2; ++k) \
        acc[ai][bj][m][n] = __builtin_amdgcn_mfma_f32_16x16x32_bf16(Bt[n][k], At[m][k], acc[ai][bj][m][n], 0, 0, 0); __builtin_amdgcn_s_setprio(0); } while (0)
#define PG8_WAIT_V(n) asm volatile("s_waitcnt vmcnt(" #n ")" ::: "memory")
#define PG8_WAIT_L(n) asm volatile("s_waitcnt lgkmcnt(" #n ")" ::: "memory")
#define PG8_BAR __builtin_amdgcn_s_barrier()
#define PG8_SCHED __builtin_amdgcn_sched_barrier(0)
#define PG8_ZERO_ACC() do { _Pragma("unroll") for (int a = 0; a < 2; ++a) _Pragma("unroll") for (int b = 0; b < 2; ++b) _Pragma("unroll") for (int m = 0; m < 4; ++m) _Pragma("unroll") for (int n = 0; n < 2; ++n) acc[a][b][m][n] = (f32x4){0.f, 0.f, 0.f, 0.f}; } while (0)
    unsigned pend = 0u; int par = 0, need_n = 0, upar = 0;
#define CH_SSQ(u) do { upar ^= 1; const int k_ = chain_kin(chain, u.stage, cchain != chain); if (k_ >= 0 && wid == 1) { const unsigned long long* s_ = (const unsigned long long*)(KA()->ws + WS_SSQ) + (size_t)k_ * MT + u.pm * 256 + 2 * lane; \
        _Pragma("unroll") for (int i_ = 0; i_ < 2; ++i_) __builtin_amdgcn_global_load_lds((const unsigned*)(s_ + 128 * i_), (PG8_LAS unsigned*)(sslot + 256 * upar + 128 * i_), 16, 0, 16); } } while (0)
    int qown = (int)(__builtin_amdgcn_s_getreg((3 << 11) | 20) & 7u);
    const int maxsteal = safe ? 7 : 0;
    int qcur = qown, qtried = 0;
#ifndef CH_POP_ASM
#define CH_POP_ASM 0
#endif
#if CH_POP_ASM
#define CH_POP_ISSUE() do { if (wid == 0) { unsigned one_ = 1u; const unsigned* qa_ = qw + 64 * qcur; asm volatile("global_atomic_add %0, %1, %2, off sc0" : "=v"(pend) : "v"(qa_), "v"(one_) : "memory"); } } while (0)
#define CH_POP_WAIT() asm volatile("s_waitcnt vmcnt(8)" : "+v"(pend) :: "memory")
#else
#define CH_POP_ISSUE() do { if (wid == 0 && lane == 0) pend = __hip_atomic_fetch_add(qw + 64 * qcur, 1u, __ATOMIC_RELAXED, __HIP_MEMORY_SCOPE_AGENT); } while (0)
#define CH_POP_WAIT() do {} while (0)
#endif
#ifdef PROBE_NODEP
#define PROBE_NODEP_HOOK() do { if (cchain != chain) need_n = 0; } while (0)
#else
#define PROBE_NODEP_HOOK() do {} while (0)
#endif
#define CH_POP_TAKE(u, ok) do { \
        if (wid == 0) { CH_POP_WAIT(); unsigned L_ = (unsigned)__builtin_amdgcn_readfirstlane((int)pend); int q_ = qcur; \
            while (L_ >= (unsigned)chain_total(chain, q_) && qtried < maxsteal) { ++qtried; qcur = (qcur + 1) & 7; q_ = qcur; \
                unsigned t_ = 0u; if (lane == 0) t_ = __hip_atomic_fetch_add(qw + 64 * q_, 1u, __ATOMIC_RELAXED, __HIP_MEMORY_SCOPE_AGENT); L_ = (unsigned)__builtin_amdgcn_readfirstlane((int)t_); } \
            if (lane == 0) { bx[par * 2] = L_; bx[par * 2 + 1] = (unsigned)q_; } } \
        asm volatile("s_waitcnt lgkmcnt(0)\n\ts_barrier" ::: "memory"); \
        const int Lb_ = __builtin_amdgcn_readfirstlane((int)bx[par * 2]), qb_ = __builtin_amdgcn_readfirstlane((int)bx[par * 2 + 1]); par ^= 1;     ok = Lb_ < chain_total(chain, qb_); \
        if (ok) { chain_decode(chain, qb_, Lb_, u, need_n); PROBE_NODEP_HOOK(); \
            if (need_n && wid == 0) __builtin_amdgcn_global_load_lds(rdy + (size_t)((u.stage - 1) * 68 + u.pm) * 64, (PG8_LAS unsigned*)(rslot + 256 * par), 4, 0, 16); } } while (0)
#define CH_READY(u) do { if (need_n) { \
        if (wid == 0) { unsigned c_ = 0u, sp_ = 0u; \
            for (;;) { c_ = (unsigned)__builtin_amdgcn_readfirstlane((int)__hip_atomic_load(rdy + (size_t)((u.stage - 1) * 68 + u.pm) * 64, __ATOMIC_RELAXED, __HIP_MEMORY_SCOPE_AGENT)); \
                if (c_ >= (unsigned)need_n || ++sp_ > (1u << 20)) break; __builtin_amdgcn_s_sleep(2); } } \
        asm volatile("" ::: "memory"); __builtin_amdgcn_s_barrier(); asm volatile("" ::: "memory"); } } while (0)
#ifdef PROBE_UPOK
#define PROBE_TRY(u, ok) do { if (u.stage == 1) ok = true; } while (0)
#else
#define PROBE_TRY(u, ok) do {} while (0)
#endif
#define CH_TRY(u, ok) do { ok = true; if (need_n) { \
        const unsigned c_ = (unsigned)__builtin_amdgcn_readfirstlane((int)*(volatile PG8_LAS unsigned*)(rslot + 256 * par)); ok = c_ >= (unsigned)need_n; PROBE_TRY(u, ok); } } while (0)
#ifdef PROBE_NODRAIN
#define CH_DRAIN() do {} while (0)
#else
#define CH_DRAIN() asm volatile("s_waitcnt vmcnt(0)" ::: "memory")
#endif
#define CH_DONE(u) do { if (u.stage < 3 && !(chain == 4 && u.stage == 2)) { CH_DRAIN();        \
        if (lane == 0) __hip_atomic_fetch_add(rdy + (size_t)(u.stage * 68 + u.pm) * 64, 1u, __ATOMIC_RELAXED, __HIP_MEMORY_SCOPE_AGENT); } } while (0)

    UnitX cur, nxt; bool have;
    CH_POP_ISSUE(); asm volatile("s_waitcnt vmcnt(0)" : "+v"(pend) :: "memory"); CH_POP_TAKE(cur, have);
    if (!have) return;
    f32x4 acc[2][2][4][2];
    bf16x8 At[4][2], B0[2][2], B1[2][2];
    for (;;) {
        PG8_ZERO_ACC();
        const char* cA = cur.A; const char* cB = cur.B;
#define KST(blk_) ((blk_) ? (unsigned)BLK_KT : (unsigned)(BK * 2))
#define HA(blk_, la_) ((blk_) ? (unsigned)BLK_AI : ((unsigned)(la_) << 8))
#define HB(la_) ((unsigned)BLK_AI)
        bool cblk = cur.stage != 0;
        unsigned voffA[2], voffB[2];
        CH_VOFF(cur.lda, cblk, voffA, voffB);
        CH_READY(cur);
        CH_SSQ(cur);
        PG8_STAGE_B(PG8_SB(0, 0), cB, voffB); PG8_STAGE_B(PG8_SB(0, 1), cB + HB(cur.lda), voffB); PG8_STAGE_A(PG8_SA(0, 0), cA, voffA); PG8_STAGE_A(PG8_SA(0, 1), cA + HA(cblk, cur.lda), voffA);
        if (wr == 1) PG8_BAR;
        PG8_WAIT_V(2); PG8_BAR;
        PG8_STAGE_B(PG8_SB(1, 0), cB + BLK_KT, voffB); PG8_STAGE_A(PG8_SA(1, 0), cA + KST(cblk), voffA); PG8_STAGE_B(PG8_SB(1, 1), cB + HB(cur.lda) + BLK_KT, voffB);
        PG8_WAIT_V(6); PG8_BAR;
        bool brk = false;
        for (;;) {
            bool chainon = false;
            const char* nA = cA; const char* nB = cB;
            int nLA = cur.lda; bool nblk = cblk;
            const int nt = cur.K / BK;
#ifdef PROBE_TIME
#define PT_NOW(v_) do { v_ = PROBE_TIME == 1 ? __builtin_amdgcn_s_memrealtime() : __builtin_amdgcn_s_memtime(); asm volatile("s_waitcnt lgkmcnt(0)" : "+s"(v_) :: "memory"); } while (0)
            const bool ptm_ = wid == 0 && __builtin_amdgcn_workgroup_id_x() == PROBE_WG && (PROBE_STAGE < 0 || cur.stage == PROBE_STAGE) && chain == PROBE_CH && cchain == chain;
            unsigned long long pt0_ = 0; if (ptm_ && PROBE_SEG == 1) PT_NOW(pt0_);
#endif
            for (int t = 0; t < nt; t += 2) {
                if (t == nt - 6) CH_POP_ISSUE();
#if defined(PROBE_TIME) && PROBE_SEG == 4
                unsigned long long pq0_ = 0; if (t == nt - 4 && ptm_) PT_NOW(pq0_);
#endif
                if (t == nt - 4) { bool has_next; CH_POP_TAKE(nxt, has_next);
#if defined(PROBE_TIME) && PROBE_SEG == 4
                    if (ptm_) { unsigned long long pq1_; PT_NOW(pq1_); if (lane == 0) bx[44] = bx[44] + (unsigned)(pq1_ - pq0_); }
#endif

                    brk = has_next && nxt.pm == cur.pm && nxt.stage == cur.stage + 1;
                    chainon = has_next && !brk;
                    if (chainon) { nA = nxt.A; nB = nxt.B; nLA = nxt.lda; nblk = nxt.stage != 0; } }
                const bool last = (t == nt - 2);
                if (last && chainon) { bool ok_; CH_TRY(nxt, ok_);
                    if (!ok_) { chainon = false; brk = true; nA = cA; nB = cB; nLA = cur.lda; nblk = cblk; } }
                const unsigned kstA = KST(cblk), hA = HA(cblk, cur.lda);
                const char* a1 = cA + (size_t)((unsigned)(t + 1) * kstA);
                const char* a2 = last ? nA : cA + (size_t)((unsigned)(t + 2) * kstA); const char* b2 = last ? nB : cB + (size_t)(t + 2) * BLK_KT;
                const char* a3 = a2 + (last ? KST(nblk) : kstA); const char* b3 = b2 + BLK_KT;
                const unsigned h2A = last ? HA(nblk, nLA) : hA, h2B = last ? HB(nLA) : HB(cur.lda);
                unsigned vA2[2], vB2[2];
                if (last) CH_VOFF(nLA, nblk, vA2, vB2);
                else {
#pragma unroll
                    for (int i = 0; i < 2; ++i) { vA2[i] = voffA[i]; vB2[i] = voffB[i]; } }
                PG8_LDB(B0, 0, 0); PG8_LDB(B1, 0, 1); PG8_SCHED; PG8_LDA(At, 0, 0); PG8_STAGE_A(PG8_SA(1, 1), a1 + hA, voffA);
                PG8_WAIT_V(8); PG8_WAIT_L(0); PG8_BAR; PG8_MMA(0, 0, At, B0); PG8_MMA(0, 1, At, B1); PG8_BAR; PG8_SCHED;
                PG8_LDA(At, 0, 1); PG8_STAGE_B(PG8_SB(0, 0), b2, vB2); PG8_STAGE_B(PG8_SB(0, 1), b2 + h2B, vB2); PG8_STAGE_A(PG8_SA(0, 0), a2, vA2);
                PG8_WAIT_V(8); PG8_WAIT_L(0); PG8_BAR; PG8_MMA(1, 0, At, B0); PG8_MMA(1, 1, At, B1); PG8_BAR; PG8_SCHED;
                PG8_LDB(B0, 1, 0); PG8_LDB(B1, 1, 1); PG8_SCHED; PG8_LDA(At, 1, 0); PG8_STAGE_A(PG8_SA(0, 1), a2 + h2A, vA2);
                PG8_WAIT_V(8); PG8_WAIT_L(0); PG8_BAR; PG8_MMA(0, 0, At, B0); PG8_MMA(0, 1, At, B1); PG8_BAR; PG8_SCHED;
                PG8_LDA(At, 1, 1); PG8_STAGE_B(PG8_SB(1, 0), b3, vB2); PG8_STAGE_B(PG8_SB(1, 1), b3 + h2B, vB2); PG8_STAGE_A(PG8_SA(1, 0), a3, vA2);
                PG8_WAIT_V(8); PG8_WAIT_L(0); PG8_BAR; PG8_MMA(1, 0, At, B0); PG8_MMA(1, 1, At, B1); PG8_BAR; PG8_SCHED;
            }
#ifdef PROBE_TIME
            if (ptm_) { if (PROBE_SEG == 1) { unsigned long long pt1_; PT_NOW(pt1_); if (lane == 0) bx[44] = bx[44] + (unsigned)(pt1_ - pt0_); }
                if (lane == 0) bx[45] = bx[45] + (unsigned)nt; }
#endif
            if (wr == 0) PG8_BAR;
#ifdef PROBE_TIME
            if (ptm_ && PROBE_SEG == 2) PT_NOW(pt0_);
#endif
#ifdef PROBE_NOEPI
            if (cchain != chain) { _Pragma("unroll") for (int a_ = 0; a_ < 2; ++a_) _Pragma("unroll") for (int b_ = 0; b_ < 2; ++b_) _Pragma("unroll") for (int m_ = 0; m_ < 4; ++m_)
                asm volatile("" :: "v"(acc[a_][b_][m_][0]), "v"(acc[a_][b_][m_][1])); }
            else
#endif
#ifdef PROBE_ST
            if (cchain != chain) {
                const rsrc_t rq_ = mk_rsrc(KA()->ws + WS_MIX, MT * 1024u * 2u);
                const unsigned qo_ = (PROBE_ST == 1 ? (unsigned)(cur.pm * 256 + wr * 64 + fr) * 1024u + (cur.pn & 3) * 256 + wc * 32 + 8 * fq : (unsigned)((cur.pm * 4 + (cur.pn & 3)) * 8 + wid) * 8192u + lane * 8) * 2u;
                _Pragma("unroll") for (int a_ = 0; a_ < 2; ++a_) _Pragma("unroll") for (int m_ = 0; m_ < 4; ++m_) _Pragma("unroll") for (int b_ = 0; b_ < 2; ++b_) {
                    const u32x4 w_ = pack8(acc[a_][b_][m_][0], acc[a_][b_][m_][1]);
                    bst16(rq_, qo_ + 2u * (PROBE_ST == 1 ? (a_ * 128 + m_ * 16) * 1024 + b_ * 128 : (a_ * 8 + m_ * 2 + b_) * 512), w_, false);
                }
            } else
#endif
            chain_epilogue(chain, cchain != chain, safe || cur.pm >= 64, sslot + 256 * upar, lds + (EPITR_OFF - RING_OFF) + wid * 2048, cur, acc, wr, wc, fr, fq);
            CH_DONE(cur);
#ifdef PROBE_TIME
            if (ptm_ && PROBE_SEG == 2) { unsigned long long pt1_; PT_NOW(pt1_); if (lane == 0) bx[44] = bx[44] + (unsigned)(pt1_ - pt0_); }
#endif
            if (!chainon) break;
            PG8_ZERO_ACC();
            cur = nxt; cA = nA; cB = nB; cblk = nblk;
            CH_VOFF(cur.lda, cblk, voffA, voffB);
            CH_SSQ(cur);
            if (wr == 1) PG8_BAR;
        }
        PG8_WAIT_V(0);
        PG8_BAR;
        if (!brk) break;
        cur = nxt;
    }
#undef PG8_SA
#undef PG8_SB
#undef PG8_STAGE_A
#undef PG8_STAGE_B
#undef PG8_LDA
#undef PG8_LDB
#undef PG8_MMA
#undef PG8_WAIT_V
#undef PG8_WAIT_L
#undef PG8_BAR
#undef PG8_SCHED
#undef PG8_ZERO_ACC
#undef CH_POP_ISSUE
#undef CH_POP_WAIT
#undef CH_POP_TAKE
#undef CH_VOFF
#undef CH_SSQ
#undef CH_TRY
#undef KST
#undef HA
#undef HB
#undef CH_READY
#undef CH_DONE
}
}

#define GAS __attribute__((address_space(1)))
#define LAS __attribute__((address_space(3)))
typedef unsigned short bf16;
typedef unsigned v4u __attribute__((ext_vector_type(4)));
typedef float f32x4 __attribute__((ext_vector_type(4)));
typedef short bf16x8 __attribute__((ext_vector_type(8)));
typedef GAS unsigned gu32;
typedef GAS unsigned long long gu64;
#define RLX_AGENT __ATOMIC_RELAXED, __HIP_MEMORY_SCOPE_AGENT
#define LDS_WAIT() asm volatile("s_waitcnt lgkmcnt(0)" ::: "memory")
#define VM_WAIT() asm volatile("s_waitcnt vmcnt(0)" ::: "memory")
__device__ __forceinline__ unsigned long long rt() { return __builtin_amdgcn_s_memrealtime(); }
__device__ __forceinline__ unsigned f2bf(float f) { unsigned u = __builtin_bit_cast(unsigned, f); return (u + 0x7fffu + ((u >> 16) & 1u)) >> 16; }
typedef float f32x2_t __attribute__((ext_vector_type(2))); typedef __bf16 bf16x2_t __attribute__((ext_vector_type(2)));
__device__ __forceinline__ unsigned pk2(float lo, float hi) { f32x2_t v = {lo, hi}; bf16x2_t b = __builtin_convertvector(v, bf16x2_t); return __builtin_bit_cast(unsigned, b); }

#define XB_TMO      128
#define XB_XCNT(j)  (256  + 64 * (j))
#define XB_XSUB(j)  (1280 + 64 * (j))
#define XB_XGEN(j)  (2304 + 64 * (j))
#define XB_TOP      3328
#define XB_TOPGEN   3392
#define XCD_BAR_WORDS 3456
#define XB_SPIN_CAP (1u << 18)

__device__ __forceinline__ unsigned xb_ld(unsigned* p)              { return __hip_atomic_load(p, __ATOMIC_RELAXED, __HIP_MEMORY_SCOPE_AGENT); }
__device__ __forceinline__ unsigned xb_add(unsigned* p, unsigned v) { return __hip_atomic_fetch_add(p, v, __ATOMIC_RELAXED, __HIP_MEMORY_SCOPE_AGENT); }
__device__ __forceinline__ unsigned xb_xcc_id() { return (unsigned)__builtin_amdgcn_s_getreg((3 << 11) | 20) & 0xFu; }
#define XB_SPIN(cond, bar) do { unsigned _sp = 0; while (cond) { __builtin_amdgcn_s_sleep(1); \
    if ((++_sp & 255u) == 0u) { if (xb_ld(&(bar)[XB_TMO])) break; if (_sp > XB_SPIN_CAP) { atomicAdd(&(bar)[XB_TMO], 1u); break; } } } } while (0)

struct XcdBarrier {
    unsigned* bar; unsigned x;
    volatile LAS unsigned* st;
};

__device__ __forceinline__ XcdBarrier xcd_barrier_post(unsigned* bar, volatile LAS unsigned* st) {
    XcdBarrier b; b.bar = bar; b.x = (unsigned)__builtin_amdgcn_readfirstlane((int)xb_xcc_id()); b.st = st;
    if (threadIdx.x == 0) (void)xb_add(&bar[XB_XCNT(b.x)], 1u);
    return b;
}
__device__ __forceinline__ void xcd_barrier_complete(unsigned* bar, unsigned x, unsigned& nloc, unsigned& nx) {
    const unsigned G = gridDim.x * gridDim.y * gridDim.z;
    unsigned sum, cnt, mine, sp = 0u;
    for (;;) {
        sum = 0u; cnt = 0u; mine = 0u;
#pragma unroll
        for (unsigned j = 0; j < 16; ++j) { const unsigned c = xb_ld(&bar[XB_XCNT(j)]); sum += c; cnt += (c > 0u) ? 1u : 0u; mine = (j == x) ? c : mine; }
        if (sum == G) break;
        __builtin_amdgcn_s_sleep(1);
        if ((++sp & 255u) == 0u) { if (xb_ld(&bar[XB_TMO])) break; if (sp > XB_SPIN_CAP) { atomicAdd(&bar[XB_TMO], 1u); break; } }
    }
    nloc = mine > 0u ? mine : 1u; nx = cnt > 0u ? cnt : 1u;
}

__device__ __forceinline__ void xcd_barrier(const XcdBarrier& b) {
    asm volatile("s_waitcnt vmcnt(0)" ::: "memory");
    __syncthreads();
    if (threadIdx.x == 0) {
        unsigned* bar = b.bar;
        __builtin_amdgcn_s_waitcnt(0);
        unsigned nloc = b.st[0], nx = b.st[1];
        if (nloc == 0u) { xcd_barrier_complete(bar, b.x, nloc, nx); b.st[0] = nloc; b.st[1] = nx; }
        const unsigned old = xb_add(&bar[XB_XSUB(b.x)], 1u);
        const unsigned gen = old / nloc;
        if (old + 1u == (gen + 1u) * nloc) {
            __builtin_amdgcn_fence(__ATOMIC_RELEASE, "agent");
            asm volatile("s_waitcnt vmcnt(0)" ::: "memory");
            const unsigned og = xb_add(&bar[XB_TOP], 1u);
            const unsigned tg = og / nx;
            if (og + 1u == (tg + 1u) * nx) xb_add(&bar[XB_TOPGEN], 1u);
            else XB_SPIN(xb_ld(&bar[XB_TOPGEN]) == tg, bar);
            __builtin_amdgcn_fence(__ATOMIC_ACQUIRE, "agent");
            xb_add(&bar[XB_XGEN(b.x)], 1u);
            asm volatile("s_waitcnt vmcnt(0)" ::: "memory");
        } else {
            XB_SPIN(xb_ld(&bar[XB_XGEN(b.x)]) == gen, bar);
            __builtin_amdgcn_fence(__ATOMIC_ACQUIRE, "agent");
            asm volatile("s_waitcnt vmcnt(0)" ::: "memory");
        }
    }
    __syncthreads();
}
typedef unsigned v2u __attribute__((ext_vector_type(2)));
typedef float f32x16 __attribute__((ext_vector_type(16)));
typedef short s16x4 __attribute__((ext_vector_type(4)));
#define WAIT_ALL_BAR() asm volatile("s_waitcnt vmcnt(0) lgkmcnt(0)\n\ts_barrier" ::: "memory")
__device__ __forceinline__ float bflo(unsigned w) { return __builtin_bit_cast(float, w << 16); }
__device__ __forceinline__ float bfhi(unsigned w) { return __builtin_bit_cast(float, w & 0xffff0000u); }
__device__ __forceinline__ void glds16(const void* gsrc, unsigned lds_dst) { unsigned keep;
    asm volatile("s_mov_b32 %0, m0\n\ts_mov_b32 m0, %2\n\ts_nop 0\n\tglobal_load_lds_dwordx4 %1, off\n\ts_mov_b32 m0, %0" : "=&s"(keep) : "v"(gsrc), "s"(lds_dst) : "memory"); }
typedef short v4i16_t __attribute__((ext_vector_type(4)));
__device__ __forceinline__ s16x4 vtr(const LAS unsigned char* p) { return __builtin_bit_cast(s16x4, __builtin_amdgcn_ds_read_tr16_b64_v4i16((LAS v4i16_t*)p)); }
#define LBAR() asm volatile("s_waitcnt lgkmcnt(0)\n\ts_barrier" ::: "memory")

struct Frame {
    LAS unsigned char* lds;
    volatile LAS unsigned* MISC;
    gu32* ctl;
    int tid, lane, wave, vcu, G;
};
using pg8::Args; using pg8::KArgs; using pg8::KA;

__device__ __forceinline__ float wave_sum(float v) {
#pragma unroll
    for (int o = 1; o < 64; o <<= 1) v += __shfl_xor(v, o);
    return v;
}
struct P0Item { const float* W; const float* g; bf16* WT; int N, ldt, drow0, k0, n0; };
__device__ __forceinline__ void p0_item_decode(int it, P0Item& d) {
    KArgs ka = KA(); unsigned char* ws = ka->ws;
    int r = it; d.g = nullptr; d.ldt = 1024; int nnb; bool perm = false;
    if (r < 3072) { const int j = r / 1536; r -= j * 1536; d.W = ka->in[10] + (size_t)j * 1024 * 3072; d.N = 3072; nnb = 96; d.WT = (bf16*)(ws + WS_WINA) + (size_t)j * 3072 * 1024; d.g = ka->in[8] + (2 * j) * 1024; perm = true; }
    else if ((r -= 3072) < 1024) { const int j = r / 512; r -= j * 512; d.W = ka->in[11] + (size_t)j * 1024 * 1024; d.N = 1024; nnb = 32; d.WT = (bf16*)(ws + WS_WOA) + (size_t)j * 1024 * 1024; }
    else if ((r -= 1024) < 4352) { const int j = r / 2176; r -= j * 2176; d.W = ka->in[15] + (size_t)j * 1024 * NMIN_REAL; d.N = NMIN_REAL; nnb = 136; d.WT = (bf16*)(ws + WS_WINB) + (size_t)j * NMIN * 1024; d.g = ka->in[8] + (2 * j + 1) * 1024; }
    else if ((r -= 4352) < 1024) { const int j = r / 512; r -= j * 512; d.W = ka->in[21] + (size_t)j * 1024 * 1024; d.N = 1024; nnb = 32; d.WT = (bf16*)(ws + WS_WOB) + (size_t)j * 1024 * 1024; }
    else if ((r -= 1024) < 8192) { const int j = r / 2048; r -= j * 2048; d.W = ka->in[22] + (size_t)j * 1024 * 4096; d.N = 4096; nnb = 128; d.WT = (bf16*)(ws + WS_WUP) + (size_t)j * 4096 * 1024; d.g = ka->in[9] + j * 1024; }
    else { r -= 8192; const int j = r / 2048; r -= j * 2048; d.W = ka->in[23] + (size_t)j * 4096 * 1024; d.N = 1024; nnb = 32; d.ldt = 4096; d.WT = (bf16*)(ws + WS_WDN) + (size_t)j * 1024 * HIDP; }
    const int kb = r / nnb, nb = r % nnb; d.n0 = 32 * nb; d.k0 = 64 * kb;
    d.drow0 = d.n0;
    if (perm) { const int tile = d.n0 >> 8, rr = d.n0 & 255, wc = rr >> 6, bj = (rr & 63) >> 5; d.drow0 = 256 * tile + 128 * bj + 32 * wc; }
}
__device__ __forceinline__ void p0_item_load(const P0Item& d, int lane, f32x4 (&wv)[8], float (&gv)[8]) {
    const int n4 = 4 * (lane & 7), kr = lane >> 3; const bool ok = (d.n0 + n4) < d.N;
#pragma unroll
    for (int i = 0; i < 8; ++i) { const int kk = 8 * i + kr; wv[i] = *(const GAS f32x4*)(d.W + (size_t)(d.k0 + kk) * d.N + (ok ? d.n0 + n4 : 0)); gv[i] = d.g ? d.g[d.k0 + kk] : 1.f; }
}
__device__ __forceinline__ void p0_item_store(const P0Item& d, int lane, const f32x4 (&wv)[8], const float (&gv)[8], LAS float* scr) {
    const int n4 = 4 * (lane & 7), kr = lane >> 3; const bool ok = (d.n0 + n4) < d.N;
#pragma unroll
    for (int i = 0; i < 8; ++i) { const int kk = 8 * i + kr; const f32x4 x = ok ? wv[i] * gv[i] : (f32x4){0.f, 0.f, 0.f, 0.f};
        scr[kk * 33 + n4] = x[0]; scr[kk * 33 + n4 + 1] = x[1]; scr[kk * 33 + n4 + 2] = x[2]; scr[kk * 33 + n4 + 3] = x[3]; }
    LDS_WAIT(); asm volatile("" ::: "memory");
    const int c = lane & 7;
#pragma unroll
    for (int j = 0; j < 4; ++j) { const int nn = (lane >> 3) + 8 * j; const LAS float* s = scr + (8 * c) * 33 + nn;
        v4u o; o.x = pk2(s[0 * 33], s[1 * 33]); o.y = pk2(s[2 * 33], s[3 * 33]); o.z = pk2(s[4 * 33], s[5 * 33]); o.w = pk2(s[6 * 33], s[7 * 33]);
        const int nl = (d.drow0 & 255) + nn, rb = nl & 127, R = (rb & ~31) + 16 * ((nn >> 2) & 1) + 4 * (nn >> 3) + (nn & 3), ob = (R & 15) * 64 + (c & 3) * 16;
        *(GAS v4u*)((GAS unsigned char*)d.WT + ((size_t)((d.drow0 >> 8) * (d.ldt >> 6) + (d.k0 >> 6)) * 2 + (nl >> 7)) * 16384 + ((R >> 4) * 2 + (c >> 2)) * 1024 + (ob ^ (((ob >> 9) & 1) << 5))) = o; }
    LDS_WAIT(); asm volatile("" ::: "memory");
}
__device__ __forceinline__ void p0_prologue(Frame& F) {
    KArgs ka = KA();
    LAS float* scr = (LAS float*)(F.lds + RING_OFF + F.wave * 16384);
    const int gw = F.vcu * NWAVES + F.wave, NGW = F.G * NWAVES;
    unsigned char* ws = ka->ws;
    constexpr int NITEMS = 2 * 1536 + 2 * 512 + 2 * 2176 + 2 * 512 + 4 * 2048 + 4 * 2048;
#pragma unroll 1
    for (int it = gw; it < NITEMS; it += 2 * NGW) {
        P0Item d0, d1; f32x4 w0[8], w1[8]; float g0[8], g1[8];
        const bool two = it + NGW < NITEMS;
        p0_item_decode(it, d0); p0_item_load(d0, F.lane, w0, g0);
        if (two) { p0_item_decode(it + NGW, d1); p0_item_load(d1, F.lane, w1, g1); }
        p0_item_store(d0, F.lane, w0, g0, scr);
        if (two) p0_item_store(d1, F.lane, w1, g1, scr);
    }
    bf16* XB = (bf16*)(ws + WS_XB); unsigned long long* SSQ = (unsigned long long*)(ws + WS_SSQ);
    for (int m = gw; m < MT; m += NGW) {
        const float* xr = (m < MP) ? ka->in[0] + (size_t)m * D : ka->in[1] + (size_t)(m - MP) * D;
        const int r = m & 255; float s = 0.f;
        unsigned char* pb = (unsigned char*)XB + (size_t)(m >> 8) * (256 * D * 2) + (size_t)(r >> 7) * pg8::BLK_AI;
#pragma unroll
        for (int h = 0; h < 2; ++h) {
            const int g = F.lane + 64 * h;
            const f32x4 v0 = *(const GAS f32x4*)(xr + 8 * g), v1 = *(const GAS f32x4*)(xr + 8 * g + 4);
            s += ((v0.x * v0.x + v0.y * v0.y) + (v0.z * v0.z + v0.w * v0.w)) + ((v1.x * v1.x + v1.y * v1.y) + (v1.z * v1.z + v1.w * v1.w));
            v4u o; o.x = pk2(v0.x, v0.y); o.y = pk2(v0.z, v0.w); o.z = pk2(v1.x, v1.y); o.w = pk2(v1.z, v1.w);
            *(GAS v4u*)(pb + (size_t)(g >> 3) * pg8::BLK_KT + pg8::blk_img((r >> 6) & 1, (g >> 2) & 1, (r >> 4) & 3, r & 15, g & 3)) = o;
        }
        s = wave_sum(s); if (F.lane == 0) SSQ[m] = (unsigned long long)(s * SSQ_FIX);
    }
}
__device__ __forceinline__ void cache_to_rings(Frame& F, int j) {
    KArgs ka = KA();
    const unsigned xcd = __builtin_amdgcn_s_getreg((3 << 11) | 20) & 7u;
    unsigned* ctr = (unsigned*)ka->ws + pg8::CW_Q + 64 * 8 * (5 + j) + 64 * xcd;
    bf16* RK = (bf16*)(ka->ws + WS_RK); bf16* RV = (bf16*)(ka->ws + WS_RV);
    unsigned nx = 0u; if (F.lane == 0) nx = __hip_atomic_fetch_add(ctr, 8u, __ATOMIC_RELAXED, __HIP_MEMORY_SCOPE_AGENT);
    for (;;) {
        const unsigned rl = (unsigned)__builtin_amdgcn_readfirstlane((int)nx);
        if (rl >= 2048u) break;
        if (F.lane == 0) nx = __hip_atomic_fetch_add(ctr, 8u, __ATOMIC_RELAXED, __HIP_MEMORY_SCOPE_AGENT);
#pragma unroll 1
        for (int hb = 0; hb < 2; ++hb) {
        const unsigned r0 = xcd * 2048u + rl + 4u * hb;
        f32x4 v[4][4];
#pragma unroll
        for (int k = 0; k < 4; ++k) {
            const int r = (int)r0 + k, tsr = r >> 13, rr = r & 8191, b = rr >> 9, pos = rr & 511;
            const GAS f32x4* xr = (const GAS f32x4*)((tsr ? ka->in[3] : ka->in[2]) + (((size_t)j * 16 + b) * 512 + pos) * D) + F.lane;
#pragma unroll
            for (int q = 0; q < 4; ++q) v[k][q] = xr[64 * q];
        }
#pragma unroll
        for (int k = 0; k < 4; ++k) {
            const int r = (int)r0 + k, tsr = r >> 13, rr = r & 8191, b = rr >> 9, pos = rr & 511;
            GAS unsigned long long* o8 = (GAS unsigned long long*)((tsr ? RV : RK) + ((size_t)b * 576 + pos) * D) + F.lane;
#pragma unroll
            for (int q = 0; q < 4; ++q) o8[64 * q] = (unsigned long long)pk2(v[k][q].x, v[k][q].y) | ((unsigned long long)pk2(v[k][q].z, v[k][q].w) << 32);
        }
        }
    }
}


__device__ __forceinline__ int crow(int r, int hi) { return (r & 3) + 8 * (r >> 2) + 4 * hi; }
constexpr int AT_STAGE = 32768, AT_HEAD = 8192, AT_V = 4096;
constexpr float LOG2E = 1.4426950408889634f;
__device__ __forceinline__ void attn_unit(Frame& F, int cx, int hg, const bf16* Q, const bf16* KP, const bf16* VP, const bf16* RK, const bf16* RV, bf16* O, const float* relb  , const bool newtab) {
    const int lane = F.lane, wid = F.wave, r32 = lane & 31, hi = lane >> 5;
    const int hh = wid >> 1, head = 4 * hg + hh, rh = wid & 1;
#ifdef PROBE_ATT
    unsigned long long pa0_ = 0; const bool pam_ = blockIdx.x == PROBE_WG && F.tid == 0;
    if (pam_ && (PROBE_ATT == 1 || PROBE_ATT == 3)) pa0_ = __builtin_amdgcn_s_memrealtime();
#endif
    LAS unsigned char* ring = F.lds + RING_OFF;
    LAS float* btab = (LAS float*)(F.lds + EXTRA_OFF);
    const bf16 *Kb, *Vb; long kvrow0; int it0; long qrow0;
    if (cx < 256) { Kb = KP; Vb = VP; kvrow0 = (long)(cx - 8) * 64; it0 = cx < 8 ? 2 * (8 - cx) : 0; qrow0 = (long)cx * 64; }
    else { const int b = cx - 256; Kb = RK + (size_t)b * 576 * D; Vb = RV + (size_t)b * 576 * D; kvrow0 = 0; it0 = 0; qrow0 = MP + (long)b * 64; }
    const unsigned lds0 = (unsigned)(size_t)ring;
    const bf16* src0; long srcstep;
    if ((wid & 1) == 0) { src0 = Kb + (kvrow0 + (lane >> 2)) * D + (4 * hg + hh) * 64 + ((lane & 3) ^ ((lane >> 4) & 3)) * 8; srcstep = 0; }
    else { src0 = Vb + (kvrow0 + (lane >> 2)) * D + (4 * hg + hh) * 64 + (lane & 3) * 8; srcstep = 0; }
    const unsigned dst0 = lds0 + hh * AT_HEAD + (wid & 1) * AT_V;
#define AT_DMA(it) do { const bf16* s_ = src0 + (long)(it) * 32 * D; const unsigned d_ = dst0 + ((it) & 3) * AT_STAGE; \
        _Pragma("unroll") for (int p = 0; p < 4; ++p) glds16(s_ + (long)(p & 1) * 16 * D + (p >> 1) * 32, (unsigned)__builtin_amdgcn_readfirstlane(d_ + p * 1024)); } while (0)
    AT_DMA(it0); AT_DMA(it0 + 1);
    (void)srcstep;
    bf16x8 qr[4];
    const bf16* Qw = Q + (qrow0 + 32 * rh + r32) * D + head * 64;
#pragma unroll
    for (int d0 = 0; d0 < 4; ++d0) qr[d0] = *(const bf16x8*)(Qw + d0 * 16 + hi * 8);
    if (newtab && wid < 4) {
        const float* rb = relb + (4 * hg + wid) * 257; const float* qg = KA()->in[12] + ((relb - KA()->in[14]) / (16 * 257)) * 64; const float* kg = KA()->in[13] + ((relb - KA()->in[14]) / (16 * 257)) * 64;
        float bm = -3.0e38f, bv[6];
#pragma unroll
        for (int i = 0; i < 6; ++i) { const int e = lane + 64 * i; bv[i] = rb[e < 257 ? e : 256]; bm = fmaxf(bm, bv[i]); }
        float gq = fabsf(qg[lane]), gk = fabsf(kg[lane]);
#pragma unroll
        for (int o = 1; o < 64; o <<= 1) { bm = fmaxf(bm, __shfl_xor(bm, o)); gq = fmaxf(gq, __shfl_xor(gq, o)); gk = fmaxf(gk, __shfl_xor(gk, o)); }
        const float M = LOG2E * (8.2f * gq * gk + bm) + 0.25f;
#pragma unroll
        for (int i = 0; i < 6; ++i) { const int e = lane + 64 * i; if (e < 324) btab[wid * 324 + e] = bv[i] * LOG2E - M; }
    }
    float lrun = 0.f; f32x16 o0 = {}, o1 = {};
    const int tq = 32 * rh + r32;
    const LAS float* bt = btab + hh * 324;
#ifdef PROBE_ATT
    if (pam_ && PROBE_ATT == 3) { F.MISC[60] = F.MISC[60] + (unsigned)(__builtin_amdgcn_s_memrealtime() - pa0_); F.MISC[61] = F.MISC[61] + 1u; }
    if (pam_ && PROBE_ATT == 2) pa0_ = __builtin_amdgcn_s_memrealtime();
#endif
    for (int it = it0; it < 18; it += 2) {
        asm volatile("s_waitcnt vmcnt(0) lgkmcnt(0)\n\ts_barrier" ::: "memory");
        if (it + 2 < 18) { AT_DMA(it + 2); AT_DMA(it + 3); }
        f32x16 p0[2];
        if (it < 12) { const float cb = bt[256];
#pragma unroll
            for (int s = 0; s < 2; ++s)
#pragma unroll
                for (int r = 0; r < 16; ++r) p0[s][r] = cb; }
        else {
#pragma unroll
            for (int s = 0; s < 2; ++s) { const LAS float* bl = bt + (128 + 512 + tq - 32 * (it + s) - 4 * hi - 27);
#pragma unroll
                for (int r = 0; r < 16; ++r) p0[s][r] = bl[27 - ((r & 3) + 8 * (r >> 2))]; } }
#pragma unroll
        for (int s = 0; s < 2; ++s) { const LAS unsigned char* kb = ring + ((it + s) & 3) * AT_STAGE + hh * AT_HEAD + (r32 >> 4) * 1024 + (r32 & 15) * 64;
            const int ks0 = (hi ^ ((r32 >> 2) & 3)) * 16;
#pragma unroll
          for (int d0 = 0; d0 < 4; ++d0) p0[s] = __builtin_amdgcn_mfma_f32_32x32x16_bf16(*(const LAS bf16x8*)(kb + (d0 >> 1) * 2048 + (ks0 ^ ((d0 & 1) * 32))), qr[d0], p0[s], 0, 0, 0); }
        float ps = 0.f;
#pragma unroll
        for (int s = 0; s < 2; ++s)
#pragma unroll
            for (int r = 0; r < 16; ++r) { p0[s][r] = __builtin_amdgcn_exp2f(p0[s][r]); ps += p0[s][r]; }
        lrun += ps;
#pragma unroll
        for (int s = 0; s < 2; ++s) {
            v4u pw[2];
#pragma unroll
            for (int k = 0; k < 2; ++k) pw[k] = (v4u){pk2(p0[s][8 * k], p0[s][8 * k + 1]), pk2(p0[s][8 * k + 2], p0[s][8 * k + 3]), pk2(p0[s][8 * k + 4], p0[s][8 * k + 5]), pk2(p0[s][8 * k + 6], p0[s][8 * k + 7])};
            const LAS unsigned char* vb = ring + ((it + s) & 3) * AT_STAGE + hh * AT_HEAD + AT_V + ((lane >> 4) & 1) * 32 + (lane & 3) * 8 + (4 * hi + ((lane & 15) >> 2)) * 64;
#pragma unroll
            for (int ks = 0; ks < 2; ++ks) {
                const s16x4 l0 = vtr(vb + ks * 1024), h0 = vtr(vb + ks * 1024 + 512), l1 = vtr(vb + 2048 + ks * 1024), h1 = vtr(vb + 2048 + ks * 1024 + 512);
                const bf16x8 v0 = (bf16x8){l0[0], l0[1], l0[2], l0[3], h0[0], h0[1], h0[2], h0[3]}, v1 = (bf16x8){l1[0], l1[1], l1[2], l1[3], h1[0], h1[1], h1[2], h1[3]};
                const bf16x8 pa = __builtin_bit_cast(bf16x8, pw[ks]);
                o0 = __builtin_amdgcn_mfma_f32_32x32x16_bf16(v0, pa, o0, 0, 0, 0);
                o1 = __builtin_amdgcn_mfma_f32_32x32x16_bf16(v1, pa, o1, 0, 0, 0);
            }
        }
    }
#undef AT_DMA
#ifdef PROBE_ATT
    if (pam_ && PROBE_ATT == 2) { F.MISC[60] = F.MISC[60] + (unsigned)(__builtin_amdgcn_s_memrealtime() - pa0_); F.MISC[61] = F.MISC[61] + 1u; }
#endif
    { auto rr = __builtin_amdgcn_permlane32_swap(__float_as_uint(lrun), __float_as_uint(lrun), false, false); lrun = __uint_as_float(rr[0]) + __uint_as_float(rr[1]); }
    const float rl = 1.0f / lrun;
    WAIT_ALL_BAR();
    {
        LAS unsigned char* scr = ring + wid * 4096;
        LAS unsigned char* wp = scr + r32 * 128 + hi * 8;
#pragma unroll
        for (int g = 0; g < 4; ++g) {
            v2u w0, w1;
            w0.x = pk2(o0[4 * g] * rl, o0[4 * g + 1] * rl); w0.y = pk2(o0[4 * g + 2] * rl, o0[4 * g + 3] * rl);
            w1.x = pk2(o1[4 * g] * rl, o1[4 * g + 1] * rl); w1.y = pk2(o1[4 * g + 2] * rl, o1[4 * g + 3] * rl);
            *(LAS v2u*)(wp + ((g ^ (r32 & 7)) * 16)) = w0; *(LAS v2u*)(wp + (((4 + g) ^ (r32 & 7)) * 16)) = w1;
        }
        asm volatile("s_waitcnt lgkmcnt(0)" ::: "memory");
        bf16* Ob = O + (qrow0 + 32 * rh + (lane >> 3)) * D + head * 64 + (lane & 7) * 8;
#pragma unroll
        for (int i = 0; i < 4; ++i) {
            const int r = 8 * i + (lane >> 3);
            const v4u w = *(const LAS v4u*)(scr + r * 128 + (((lane & 7) ^ (r & 7)) * 16));
            *(v4u*)(Ob + (size_t)(8 * i) * D) = w;
        }
    }
    WAIT_ALL_BAR();
#ifdef PROBE_ATT
    if (pam_ && PROBE_ATT == 1) { F.MISC[60] = F.MISC[60] + (unsigned)(__builtin_amdgcn_s_memrealtime() - pa0_); F.MISC[61] = F.MISC[61] + 1u; }
#endif
}
__device__ __forceinline__ void attn_phase(Frame& F, int j) {
    KArgs ka = KA(); unsigned char* ws = ka->ws;
    const bf16 *Q = (const bf16*)(ws + WS_Q), *KP = (const bf16*)(ws + WS_KP), *VP = (const bf16*)(ws + WS_VP), *RK = (const bf16*)(ws + WS_RK), *RV = (const bf16*)(ws + WS_RV);
    bf16* O = (bf16*)(ws + WS_O);
    const float* relb = ka->in[14] + (size_t)j * 16 * 257;
    const int x = F.vcu >> 5, c = F.vcu & 31;
    int hgprev = -1;
#pragma unroll 1
    for (int i = 0; ; ++i) {
        int cx, hg;
        if (F.G == 256) { if (i < 4) { cx = 32 * x + 16 * (i & 1) + (c >> 1); hg = 2 * (i >> 1) + (c & 1); } else if (i == 4 && c < 8) { cx = 256 + 2 * x + (c >> 2); hg = c & 3; } else break; }
        else { const int u = F.vcu + i * F.G; if (u >= 272 * 4) break; cx = u >> 2; hg = u & 3; }
        attn_unit(F, cx, hg, Q, KP, VP, RK, RV, O, relb, hg != hgprev); hgprev = hg;
    }
}

struct MUnit { int head, ntok, b, isS; long row0; };
__device__ __forceinline__ void munit(int u, MUnit& m) {
    if (u < 512) { m.head = u & 3; m.ntok = 128; m.row0 = (long)(u >> 2) * 128; m.isS = 0; m.b = 0; }
    else { const int v = u - 512; m.head = v & 3; m.b = v >> 2; m.ntok = 64; m.row0 = MP + (long)m.b * 64; m.isS = 1; }
}
__device__ __forceinline__ f32x4 mfma16(bf16x8 a, bf16x8 b, f32x4 c) { return __builtin_amdgcn_mfma_f32_16x16x32_bf16(a, b, c, 0, 0, 0); }
__device__ __forceinline__ bf16x8 trfrag(const LAS unsigned char* p) { const s16x4 lo = vtr(p), hi = vtr(p + 1024); return (bf16x8){lo[0], lo[1], lo[2], lo[3], hi[0], hi[1], hi[2], hi[3]}; }
constexpr int MSTART_OFF = 2048;


__device__ __forceinline__ void gate_scans(LAS float* xs, int tid, int ntok, float& bt, float& ut, float& pm) {
    const int lane = tid & 63; const bool on = tid < 128;
    float b = on ? xs[128 + (tid < ntok ? tid : 0)] : 0.f; if (tid >= ntok) b = 0.f;
#pragma unroll
    for (int o = 1; o < 64; o <<= 1) { const float y = __shfl_up(b, o); if (lane >= o) b += y; }
    if (on && lane == 63) xs[512 + (tid >> 6)] = b;
    LBAR();
    if (on && tid >= 64) b += xs[512];
    const float ig = (tid < ntok) ? xs[tid] : 0.f;
    float u = (tid < ntok) ? ig - b : -3.0e38f, m = u;
#pragma unroll
    for (int o = 1; o < 64; o <<= 1) { const float y = __shfl_up(m, o); if (lane >= o) m = fmaxf(m, y); }
    if (on && lane == 63) xs[514 + (tid >> 6)] = m;
    LBAR();
    if (on && tid >= 64) m = fmaxf(m, xs[514]);
    if (tid < ntok) { xs[128 + tid] = b; xs[256 + tid] = u; xs[384 + tid] = m; }
    bt = b; ut = u; pm = m;
}

__device__ __forceinline__ int slab_off(int e, int d) { return e < 256 ? (e >> 6) * 32768 + (d >> 3) * 1024 + (e & 63) * 16 + (d & 7) * 2 : 131072 + (d >> 3) * 256 + (e - 256) * 16 + (d & 7) * 2; }
__device__ __forceinline__ void slab_ed(int vi, int& e, int& d) {
    const int off = vi * 8;
    if (off < 131072) { e = (off >> 15) * 64 + ((off >> 4) & 63); d = ((off >> 10) & 31) * 8 + ((off >> 3) & 1) * 4; }
    else { const int t = off - 131072; e = 256 + ((t >> 4) & 15); d = (t >> 8) * 8 + ((t >> 3) & 1) * 4; }
}
__device__ __forceinline__ void mlstm_a_unit(Frame& F, int j, int u) {
    MUnit mu; munit(u, mu); KArgs ka = KA();
#ifdef PROBE_MA
    unsigned pm_last_ = 0; const bool pmm_ = blockIdx.x == PROBE_WG && F.tid == 0 && u < 512;
#define PM_MARK(k_) do { if (pmm_) { const unsigned now_ = (unsigned)__builtin_amdgcn_s_memrealtime(); if ((k_) > 0 && ((k_) - 1 == PROBE_MA || PROBE_MA == 9)) F.MISC[60] = F.MISC[60] + (now_ - pm_last_); if ((k_) == 4) F.MISC[61] = F.MISC[61] + 1u; pm_last_ = now_; } } while (0)
    PM_MARK(0);
#endif
    unsigned char* ws = ka->ws;
    const bf16* QKP = (const bf16*)(ws + WS_QKP); const bf16* V = (const bf16*)(ws + WS_V);
    bf16* QC = (bf16*)(ws + WS_QC); bf16* KC = (bf16*)(ws + WS_KC);
    bf16* slab = (bf16*)(ws + WS_SLAB + (size_t)u * SLAB_BYTES);
    const float* gates = (const float*)(ka->ws + WS_GATES); float* stats = (float*)(ka->ws + WS_STATS);
    LAS float* xs = (LAS float*)(F.lds + EXTRA_OFF + 9216);
    LAS unsigned char* Kt = F.lds + RING_OFF; LAS unsigned char* Wv = F.lds + RING_OFF + 65536;
    const int tid = F.tid, lane = F.lane, wid = F.wave, head = mu.head, ntok = mu.ntok; const long row0 = mu.row0;
    if (tid < ntok) { xs[tid] = gates[(row0 + tid) * 8 + head]; xs[128 + tid] = gates[(row0 + tid) * 8 + 4 + head]; }
    LBAR();
    float bt, ut, pmx; gate_scans(xs, tid, ntok, bt, ut, pmx);
    LBAR();
    const float umax = xs[384 + ntok - 1], bsum = xs[128 + ntok - 1];
    LBAR();
    if (tid < ntok) xs[256 + tid] = expf(ut - umax);
    if (tid == 0) { stats[u * 2] = bsum; stats[u * 2 + 1] = umax; }
    const int nh = ntok >> 6;
    const int cgi = tid & 63, rseg = tid >> 6, c = cgi & 31; const bool isk = cgi >= 32;
    const int qcol = (isk ? 1024 : 0) + head * 256 + 8 * c;
    const int vc = tid & 31, kseg = tid >> 5;
    float cw[4][8], cb[8];
#pragma unroll
    for (int jj = 0; jj < 4; ++jj) { const f32x4 w0 = *(const f32x4*)(ka->in[18] + ((size_t)j * 4 + jj) * 2048 + qcol), w1 = *(const f32x4*)(ka->in[18] + ((size_t)j * 4 + jj) * 2048 + qcol + 4);
#pragma unroll
        for (int e = 0; e < 4; ++e) { cw[jj][e] = w0[e]; cw[jj][4 + e] = w1[e]; } }
    { const f32x4 w0 = *(const f32x4*)(ka->in[19] + (size_t)j * 2048 + qcol), w1 = *(const f32x4*)(ka->in[19] + (size_t)j * 2048 + qcol + 4);
#pragma unroll
      for (int e = 0; e < 4; ++e) { cb[e] = w0[e]; cb[4 + e] = w1[e]; } }
    LBAR();
#ifdef PROBE_MA
    PM_MARK(1);
#endif
    for (int hs = 0; hs < nh; ++hs) {
        v4u xr[11], vr[4];
#pragma unroll
        for (int i = 0; i < 11; ++i) { const long gr = row0 + 64 * hs + 8 * rseg + i - 3; xr[i] = *(const v4u*)(QKP + (size_t)(gr < 0 ? 0 : gr) * 2048 + qcol); }
#pragma unroll
        for (int i = 0; i < 4; ++i) vr[i] = *(const v4u*)(V + (size_t)(row0 + 64 * hs + 4 * kseg + i) * D + head * 256 + 8 * vc);
        {
            float x0[8], x1[8], x2[8];
#pragma unroll
            for (int e = 0; e < 8; ++e) { x0[e] = 0.f; x1[e] = 0.f; x2[e] = 0.f; }
#pragma unroll
            for (int i = -3; i < 8; ++i) {
                const int tt = 64 * hs + 8 * rseg + i;
                float x[8];
                {
                    const long gr = row0 + tt; const v4u w = xr[i + 3];
                    x[0] = bflo(w.x); x[1] = bfhi(w.x); x[2] = bflo(w.y); x[3] = bfhi(w.y); x[4] = bflo(w.z); x[5] = bfhi(w.z); x[6] = bflo(w.w); x[7] = bfhi(w.w);
                    if (i < 0) {
                        const int ts = tt < -3 ? -3 : (tt > -1 ? -1 : tt);
                        const float* sp = ka->in[7] + (((size_t)j * 16 + mu.b) * 3 + (3 + ts)) * 2048 + qcol;
                        const f32x4 w0 = *(const f32x4*)sp, w1 = *(const f32x4*)(sp + 4);
                        const bool useS = mu.isS && tt < 0, zero = !mu.isS && gr < 0;
#pragma unroll
                        for (int e = 0; e < 4; ++e) { x[e] = useS ? w0[e] : (zero ? 0.f : x[e]); x[4 + e] = useS ? w1[e] : (zero ? 0.f : x[4 + e]); }
                    }
                }
                if (i >= 0) {
                    float y[8];
#pragma unroll
                    for (int e = 0; e < 8; ++e) { const float s = cb[e] + cw[0][e] * x0[e] + cw[1][e] * x1[e] + cw[2][e] * x2[e] + cw[3][e] * x[e]; float v = s * __builtin_amdgcn_rcpf(1.0f + __expf(-s)); if (isk) v *= 0.0625f; y[e] = v; }
                    v4u o; o.x = pk2(y[0], y[1]); o.y = pk2(y[2], y[3]); o.z = pk2(y[4], y[5]); o.w = pk2(y[6], y[7]);
                    *(v4u*)((isk ? KC : QC) + (size_t)(row0 + tt) * D + head * 256 + 8 * c) = o;
                    if (isk) *(LAS v4u*)(Kt + (c >> 2) * 8192 + (64 * hs + 8 * rseg + i) * 64 + (c & 3) * 16) = o;
                }
#pragma unroll
                for (int e = 0; e < 8; ++e) { x0[e] = x1[e]; x1[e] = x2[e]; x2[e] = x[e]; }
            }
        }
        {
#pragma unroll
            for (int i = 0; i < 4; ++i) {
                const int key = 4 * kseg + i; const float w = xs[256 + 64 * hs + key];
                const v4u x = vr[i];
                v4u o; o.x = pk2(bflo(x.x) * w, bfhi(x.x) * w); o.y = pk2(bflo(x.y) * w, bfhi(x.y) * w); o.z = pk2(bflo(x.z) * w, bfhi(x.z) * w); o.w = pk2(bflo(x.w) * w, bfhi(x.w) * w);
                *(LAS v4u*)(Wv + (vc >> 2) * 8192 + (64 * hs + key) * 64 + (vc & 3) * 16) = o;
            }
            if (tid < 256) { const int key = tid >> 2, ch = tid & 3; v4u o = (v4u){0u, 0u, 0u, 0u}; if (ch == 0) o.x = f2bf(xs[256 + 64 * hs + key]); *(LAS v4u*)(Wv + 8 * 8192 + (64 * hs + key) * 64 + ch * 16) = o; }
        }
    }
    LBAR();
#ifdef PROBE_MA
    PM_MARK(2);
#endif
    f32x4 acc[2][17];
#pragma unroll
    for (int dd = 0; dd < 2; ++dd)
#pragma unroll
        for (int eb = 0; eb < 17; ++eb) acc[dd][eb] = (f32x4){0.f, 0.f, 0.f, 0.f};
    {
        const int g = lane >> 4, q = (lane & 15) >> 2, p = lane & 3;
        for (int ks = 0; ks < 2 * nh; ++ks) {
            const int koff = (32 * ks + 4 * g + q) * 64 + p * 8;
            bf16x8 af[2];
#pragma unroll
            for (int dd = 0; dd < 2; ++dd) { const int db = 2 * wid + dd; af[dd] = trfrag(Kt + (db >> 1) * 8192 + (db & 1) * 32 + koff); }
#pragma unroll
            for (int eb = 0; eb < 17; ++eb) {
                const bf16x8 bfr = trfrag(Wv + (eb >> 1) * 8192 + (eb & 1) * 32 + koff);
                acc[0][eb] = mfma16(af[0], bfr, acc[0][eb]); acc[1][eb] = mfma16(af[1], bfr, acc[1][eb]);
            }
        }
    }
#ifdef PROBE_MA
    PM_MARK(3);
#endif
    {
        const int g = lane >> 4, el = lane & 15;
        unsigned char* sb1 = (unsigned char*)slab + el * 16 + (g & 1) * 8 + wid * 4096 + (g >> 1) * 1024;
        unsigned char* sb2 = (unsigned char*)slab + 131072 + el * 16 + (g & 1) * 8 + wid * 1024 + (g >> 1) * 256;
#pragma unroll
        for (int dd = 0; dd < 2; ++dd)
#pragma unroll
            for (int eb = 0; eb < 17; ++eb) {
                const f32x4 v = acc[dd][eb];
                v2u o; o.x = pk2(v[0], v[1]); o.y = pk2(v[2], v[3]);
                *(v2u*)(eb < 16 ? sb1 + (eb >> 2) * 32768 + (eb & 3) * 256 + dd * 2048 : sb2 + dd * 512) = o;
            }
    }
    LBAR();
#ifdef PROBE_MA
    PM_MARK(4);
#endif
}

__device__ __forceinline__ void mlstm_b_phase(Frame& F, int j, bool dry = false) {
    KArgs ka = KA();
    unsigned char* A = ka->ws; unsigned char* slab0 = A + WS_SLAB;
    float* stats = (float*)(ka->ws + WS_STATS); float* mstart = stats + MSTART_OFF;
    LAS float* tab = (LAS float*)(F.lds + EXTRA_OFF);
    const int tid = F.tid;
    for (int vb = F.vcu; vb < 256; vb += F.G) {
        if (vb < 136) {
            const int head = vb / 34, vi = (vb % 34) * 512 + tid;
            LBAR();
            if (tid < 128) { const int u = tid * 4 + head; tab[272 + tid] = stats[u * 2]; tab[400 + tid] = stats[u * 2 + 1]; }
            LBAR();
            if (tid == 0) { float m = 0.f; for (int J = 0; J < 128; ++J) { tab[528 + J] = m; m = tab[272 + J] + fmaxf(m, tab[400 + J]); } tab[256] = m; }
            LBAR();
            if (tid < 128) { const float bs = tab[272 + tid], um = tab[400 + tid], m = tab[528 + tid], mn = bs + fmaxf(m, um);
                tab[tid] = expf(bs + m - mn); tab[128 + tid] = expf(bs + um - mn); if (vb % 34 == 0 && !dry) mstart[tid * 4 + head] = m; }
            LBAR();
            f32x4 C = (f32x4){0.f, 0.f, 0.f, 0.f};
            unsigned char* p0 = slab0 + (size_t)head * SLAB_BYTES + (size_t)vi * 8;
            for (int J0 = 0; J0 < 128; J0 += 16) {
                v2u dq[16];
#pragma unroll
                for (int k = 0; k < 16; ++k) dq[k] = *(const v2u*)(p0 + (size_t)(J0 + k) * 4 * SLAB_BYTES);
#pragma unroll
                for (int k = 0; k < 16; ++k) {
                    v2u o; o.x = pk2(C[0], C[1]); o.y = pk2(C[2], C[3]);
                    *(v2u*)(dry ? A + WS_QKP + (size_t)((J0 + k) & 63) * MiB + (size_t)vi * 8 : p0 + (size_t)(J0 + k) * 4 * SLAB_BYTES) = o;
                    const float dc = tab[J0 + k], sc = tab[128 + J0 + k];
                    C[0] = dc * C[0] + sc * bflo(dq[k].x); C[1] = dc * C[1] + sc * bfhi(dq[k].x); C[2] = dc * C[2] + sc * bflo(dq[k].y); C[3] = dc * C[3] + sc * bfhi(dq[k].y);
                }
            }
            int e, d; slab_ed(vi, e, d);
            if (!dry) {
            if (e < 256) *(f32x4*)(ka->out + O_CP + (((size_t)j * 4 + head) * 256 + e) * 256 + d) = C;
            else if (e == 256) *(f32x4*)(ka->out + O_NP + ((size_t)j * 4 + head) * 256 + d) = C;
            if (vb % 34 == 0 && tid == 0) ka->out[O_MP + j * 4 + head] = tab[256];
            }
        } else {
            constexpr int SN = 64 * 17408, SS = 120 * 512;
            for (int idx0 = (vb - 136) * 512 + tid; idx0 < SN; idx0 += 4 * SS) {
                int vi_[4], u_[4], e_[4]; size_t sh_[4]; bool ok_[4]; f32x4 C0_[4], N0_[4]; v2u dq_[4]; float m0_[4], bs_[4], um_[4]; unsigned char* p_[4];
#pragma unroll
                for (int k = 0; k < 4; ++k) {
                    const int idx = idx0 + k * SS; ok_[k] = idx < SN; const int ic = ok_[k] ? idx : 0;
                    const int v = ic / 17408, vi = ic - v * 17408, b = v >> 2, head = v & 3; vi_[k] = vi; u_[k] = 512 + v; int d; slab_ed(vi, e_[k], d);
                    sh_[k] = ((size_t)j * 16 + b) * 4 + head;
                    m0_[k] = ka->in[6][sh_[k]]; bs_[k] = stats[u_[k] * 2]; um_[k] = stats[u_[k] * 2 + 1];
                    C0_[k] = *(const f32x4*)(ka->in[4] + (sh_[k] * 256 + (e_[k] < 256 ? e_[k] : 0)) * 256 + d);
                    N0_[k] = *(const f32x4*)(ka->in[5] + sh_[k] * 256 + d);
                    p_[k] = slab0 + (size_t)u_[k] * SLAB_BYTES + (size_t)vi * 8;
                    dq_[k] = *(const v2u*)p_[k];
                }
#pragma unroll
                for (int k = 0; k < 4; ++k) if (ok_[k]) {
                    int e, d; slab_ed(vi_[k], e, d); const size_t sh = sh_[k];
                    const float m0 = m0_[k], bs = bs_[k], um = um_[k], mn = bs + fmaxf(m0, um), dc = expf(bs + m0 - mn), sc = expf(bs + um - mn);
                    const f32x4 C0 = e < 256 ? C0_[k] : (e == 256 ? N0_[k] : (f32x4){0.f, 0.f, 0.f, 0.f});
                    const v2u dq = dq_[k];
                    v2u o; o.x = pk2(C0[0], C0[1]); o.y = pk2(C0[2], C0[3]); if (!dry) *(v2u*)p_[k] = o;
                    f32x4 Ce; Ce[0] = dc * C0[0] + sc * bflo(dq.x); Ce[1] = dc * C0[1] + sc * bfhi(dq.x); Ce[2] = dc * C0[2] + sc * bflo(dq.y); Ce[3] = dc * C0[3] + sc * bfhi(dq.y);
                    if (!dry) { if (e < 256) *(f32x4*)(ka->out + O_CS + (sh * 256 + e) * 256 + d) = Ce; else if (e == 256) *(f32x4*)(ka->out + O_NS + sh * 256 + d) = Ce;
                        if (vi_[k] == 0) { ka->out[O_MS + sh] = mn; mstart[u_[k]] = m0; } }
                    else if (Ce[0] == 1.2345e30f) ka->out[0] = Ce[1];
                }
            }
        }
    }
}

__device__ __forceinline__ void mlstm_c_unit(Frame& F, int j, int u, bool dry = false) {
#ifdef PROBE_MC
    unsigned pc_last_ = 0; const bool pcm_ = blockIdx.x == PROBE_WG && F.tid == 0 && u < 512;
#define PC_MARK(k_) do { if (pcm_) { const unsigned now_ = (unsigned)__builtin_amdgcn_s_memrealtime(); if ((k_) > 0 && ((k_) - 1 == PROBE_MC || PROBE_MC == 9)) F.MISC[60] = F.MISC[60] + (now_ - pc_last_); if ((k_) == 6) F.MISC[61] = F.MISC[61] + 1u; pc_last_ = now_; } } while (0)
    PC_MARK(0);
#endif
    MUnit mu; munit(u, mu); KArgs ka = KA();
    unsigned char* A = ka->ws;
    const bf16* V = (const bf16*)(A + WS_V); bf16* OG = (bf16*)(A + WS_OG);
    const bf16* QC = (const bf16*)(A + WS_QC); const bf16* KC = (const bf16*)(A + WS_KC);
    const bf16* slab = (const bf16*)(A + WS_SLAB + (size_t)u * SLAB_BYTES);
    const float* gates = (const float*)(ka->ws + WS_GATES); const float* stats = (const float*)(ka->ws + WS_STATS);
    LAS float* xs = (LAS float*)(F.lds + EXTRA_OFF + 9216);
    LAS unsigned char* ring = F.lds + RING_OFF; const unsigned lds0 = (unsigned)(size_t)ring;
    const int tid = F.tid, lane = F.lane, wid = F.wave, head = mu.head, ntok = mu.ntok; const long row0 = mu.row0;
    const int tl = lane & 15, g = lane >> 4, t = 16 * wid + tl;
    const bool active = 16 * wid < ntok;
    const float ms = stats[MSTART_OFF + u];
#pragma unroll
    for (int ct = 0; ct < 4; ++ct)
#pragma unroll
        for (int k = 0; k < 4; ++k) { const int c = wid * 4 + k;
            glds16((const unsigned char*)slab + ct * 32768 + c * 1024 + lane * 16, (unsigned)__builtin_amdgcn_readfirstlane(lds0 + ct * 32768 + c * 1024)); }
    bf16x8 qf[8];
#pragma unroll
    for (int kd = 0; kd < 8; ++kd) qf[kd] = *(const bf16x8*)(QC + (size_t)(row0 + (active ? t : 0)) * D + head * 256 + 32 * kd + 8 * g);
    if (tid < ntok) { xs[tid] = gates[(row0 + tid) * 8 + head]; xs[128 + tid] = gates[(row0 + tid) * 8 + 4 + head]; }
    LBAR();
    float bt, ut, pmx; gate_scans(xs, tid, ntok, bt, ut, pmx);
    if (tid < ntok) { xs[384 + tid] = bt + fmaxf(ms, pmx); xs[256 + tid] = ut * LOG2E; }
    LBAR();
    float b_t = 0.f, m_t = 0.f;
    if (active) { b_t = xs[128 + t]; m_t = xs[384 + t]; }
    const float a_t = (b_t - m_t) * LOG2E, inter_t = expf(b_t + ms - m_t);
    WAIT_ALL_BAR();
#ifdef PROBE_MC
    PC_MARK(1);
#endif
    f32x4 acc[16];
#pragma unroll
    for (int eb = 0; eb < 16; ++eb) acc[eb] = (f32x4){0.f, 0.f, 0.f, 0.f};
    if (active) {
#pragma unroll
        for (int eb = 0; eb < 16; ++eb) {
            const LAS unsigned char* cb = ring + (eb >> 2) * 32768 + g * 1024 + ((eb & 3) * 16 + tl) * 16;
#pragma unroll
            for (int kd = 0; kd < 8; ++kd) acc[eb] = mfma16(*(const LAS bf16x8*)(cb + kd * 4096), qf[kd], acc[eb]);
        }
    }
    WAIT_ALL_BAR();
#ifdef PROBE_MC
    PC_MARK(2);
#endif
#define MC_DMA_KV(kt, bk, bv) do { \
        _Pragma("unroll") for (int k = 0; k < 4; ++k) { const int pc = wid * 4 + k;        \
            glds16(KC + (size_t)(row0 + 64 * (kt) + 16 * k + (lane >> 2)) * D + head * 256 + wid * 32 + ((lane & 3) ^ ((lane >> 4) & 3)) * 8, (unsigned)__builtin_amdgcn_readfirstlane(lds0 + (bk) * 32768 + pc * 1024)); } \
        _Pragma("unroll") for (int k = 0; k < 4; ++k) { const int pc = wid * 4 + k, cg = pc >> 2, rg = pc & 3; \
            glds16(V + (size_t)(row0 + 64 * (kt) + 16 * rg + (lane >> 2)) * D + head * 256 + cg * 32 + (lane & 3) * 8, (unsigned)__builtin_amdgcn_readfirstlane(lds0 + (bv) * 32768 + pc * 1024)); } } while (0)
#pragma unroll
    for (int k = 0; k < 4; ++k) { const int c = wid * 4 + k; const int rr = lane > 15 ? 15 : lane;
        glds16((const unsigned char*)slab + 131072 + c * 256 + rr * 16, (unsigned)__builtin_amdgcn_readfirstlane(lds0 + c * 1024)); }
    MC_DMA_KV(0, 2, 3);
    WAIT_ALL_BAR();
#ifdef PROBE_MC
    PC_MARK(3);
#endif
    float nq = 0.f;
    {
        f32x4 ad = (f32x4){0.f, 0.f, 0.f, 0.f};
        if (active) {
            const LAS unsigned char* cb = ring + g * 1024 + tl * 16;
#pragma unroll
            for (int kd = 0; kd < 8; ++kd) ad = mfma16(*(const LAS bf16x8*)(cb + kd * 4096), qf[kd], ad);
        }
        nq = __shfl(ad[0], tl);
    }
#pragma unroll
    for (int eb = 0; eb < 16; ++eb) acc[eb] = acc[eb] * inter_t;
    float den = inter_t * nq, denp = 0.f;
    WAIT_ALL_BAR();
#ifdef PROBE_MC
    PC_MARK(4);
#endif
    const int nkt = ntok >> 6;
    if (nkt > 1) MC_DMA_KV(1, 0, 1);
    for (int kt = 0; kt < nkt; ++kt) {
        if (kt == 1) WAIT_ALL_BAR();
        const LAS unsigned char* bK = ring + (kt == 0 ? 2 : 0) * 32768; const LAS unsigned char* bV = bK + 32768;
        if (active && kt <= (wid >> 2)) {
            f32x4 sacc[4];
#pragma unroll
            for (int sb = 0; sb < 4; ++sb) { sacc[sb] = (f32x4){0.f, 0.f, 0.f, 0.f};
                const LAS unsigned char* kb = bK + sb * 1024 + tl * 64 + ((g ^ ((tl >> 2) & 3)) * 16);
#pragma unroll
                for (int kd = 0; kd < 8; ++kd) sacc[sb] = mfma16(*(const LAS bf16x8*)(kb + kd * 4096), qf[kd], sacc[sb]); }
            unsigned pw[8];
#pragma unroll
            for (int sb = 0; sb < 4; ++sb) {
                const f32x4 c4 = *(const LAS f32x4*)(xs + 256 + 64 * kt + 16 * sb + 4 * g);
                float pv[4];
#pragma unroll
                for (int r = 0; r < 4; ++r) { const int s = 64 * kt + 16 * sb + 4 * g + r; const float w = __builtin_amdgcn_exp2f(fminf(a_t + c4[r], 0.f)); pv[r] = (s <= t) ? sacc[sb][r] * w : 0.f; denp += pv[r]; }
                pw[2 * sb] = pk2(pv[0], pv[1]); pw[2 * sb + 1] = pk2(pv[2], pv[3]);
            }
            const bf16x8 pf0 = __builtin_bit_cast(bf16x8, (v4u){pw[0], pw[1], pw[2], pw[3]}), pf1 = __builtin_bit_cast(bf16x8, (v4u){pw[4], pw[5], pw[6], pw[7]});
            const int q = tl >> 2, p = lane & 3;
            const LAS unsigned char* vb = bV + (4 * g + q) * 64 + p * 8;
#pragma unroll
            for (int eb = 0; eb < 16; ++eb) {
                const LAS unsigned char* ve = vb + (eb >> 1) * 4096 + (eb & 1) * 32;
                acc[eb] = mfma16(trfrag(ve), pf0, acc[eb]);
                acc[eb] = mfma16(trfrag(ve + 32 * 64), pf1, acc[eb]);
            }
        }
    }
#undef MC_DMA_KV
#ifdef PROBE_MC
    PC_MARK(5);
#endif
    denp += __shfl_xor(denp, 16); denp += __shfl_xor(denp, 32);
    den += denp;
    const float inv = 1.0f / fmaxf(fabsf(den), expf(-m_t));
    float ss = 0.f;
#pragma unroll
    for (int eb = 0; eb < 16; ++eb) { acc[eb] = acc[eb] * inv; const f32x4 x = acc[eb]; ss += (x[0] * x[0] + x[1] * x[1]) + (x[2] * x[2] + x[3] * x[3]); }
    ss += __shfl_xor(ss, 16); ss += __shfl_xor(ss, 32);
    const float rr = 1.0f / sqrtf(ss * (1.0f / 256.0f) + 1e-6f);
    if (active) {
        const float* hn = ka->in[20] + (size_t)j * 1024 + head * 256;
        LAS unsigned char* scr = ring + (nkt > 1 ? 2 : 0) * 32768 + wid * 8192;
        bf16* gbase = (dry ? (bf16*)(A + WS_QKP) : OG) + (size_t)(row0 + 16 * wid + (lane >> 5)) * D + head * 256 + (lane & 31) * 8;
        const bf16* gin = OG + (size_t)(row0 + 16 * wid + (lane >> 5)) * D + head * 256 + (lane & 31) * 8;
        v4u gv[8];
#pragma unroll
        for (int i = 0; i < 8; ++i) gv[i] = *(const v4u*)(gin + (size_t)(2 * i) * D);
#pragma unroll
        for (int i = 0; i < 8; ++i) { const int r = 2 * i + (lane >> 5); *(LAS v4u*)(scr + r * 512 + (((lane & 31) ^ r) * 16)) = gv[i]; }
        asm volatile("s_waitcnt lgkmcnt(0)" ::: "memory");
        LAS unsigned char* lp = scr + tl * 512 + (g & 1) * 8;
#pragma unroll
        for (int eb = 0; eb < 16; ++eb) {
            const int e0 = 16 * eb + 4 * g; const f32x4 h4 = *(const f32x4*)(hn + e0); const f32x4 x = acc[eb];
            LAS v2u* p = (LAS v2u*)(lp + (((2 * eb + (g >> 1)) ^ tl) * 16));
            const v2u og = *p;
            v2u o; o.x = pk2(x[0] * rr * h4[0] * bflo(og.x), x[1] * rr * h4[1] * bfhi(og.x)); o.y = pk2(x[2] * rr * h4[2] * bflo(og.y), x[3] * rr * h4[3] * bfhi(og.y));
            *p = o;
        }
        asm volatile("s_waitcnt lgkmcnt(0)" ::: "memory");
#pragma unroll
        for (int i = 0; i < 8; ++i) { const int r = 2 * i + (lane >> 5); *(v4u*)(gbase + (size_t)(2 * i) * D) = *(const LAS v4u*)(scr + r * 512 + (((lane & 31) ^ r) * 16)); }
    }
    WAIT_ALL_BAR();
#ifdef PROBE_MC
    PC_MARK(6);
#endif
}


__global__ void __launch_bounds__(NWAVES * 64, 2) hybrid_fwd(Args args_unused) {
    extern __shared__ __attribute__((aligned(16))) unsigned char lds[];
    Frame F;
    F.lds = (LAS unsigned char*)lds;
    F.MISC = (volatile LAS unsigned*)(F.lds + MISC_OFF);
#define FRESH() do { int t_ = threadIdx.x; asm volatile("" : "+v"(t_)); F.tid = t_; F.lane = t_ & 63; F.wave = __builtin_amdgcn_readfirstlane(t_ >> 6); \
        unsigned l_ = (unsigned)(size_t)(LAS unsigned char*)lds; asm volatile("" : "+s"(l_)); F.lds = (LAS unsigned char*)(size_t)l_; F.MISC = (volatile LAS unsigned*)(F.lds + MISC_OFF); } while (0)
    FRESH();
    F.G = gridDim.x; { const int bx = blockIdx.x; F.vcu = (F.G % 8 == 0) ? (bx % 8) * (F.G / 8) + bx / 8 : bx; }
    F.ctl = (gu32*)(KA()->ws + WS_CTL);
    for (int u = F.tid; u < (LDS_BYTES - LDSCTL_OFF) / 4; u += NWAVES * 64) ((LAS unsigned*)(F.lds + LDSCTL_OFF))[u] = 0u;
    __syncthreads();
    (void)xcd_barrier_post((unsigned*)(F.ctl + CW_BAR), F.MISC + 8);
#define GRID_BAR() do { FRESH(); XcdBarrier b_; b_.bar = (unsigned*)((gu32*)(KA()->ws + WS_CTL) + CW_BAR); b_.x = (unsigned)__builtin_amdgcn_readfirstlane((int)xb_xcc_id()); b_.st = F.MISC + 8; xcd_barrier(b_); } while (0)

#ifndef PROBE_ONECH
#define PROBE_ONECH -1
#endif
#ifdef PROBE_PHC
#define PT_MARK(cls_) do { if (blockIdx.x == PROBE_WG && threadIdx.x == 0) { const unsigned now_ = (unsigned)__builtin_amdgcn_s_memrealtime(); if ((cls_) == PROBE_PHC || (PROBE_PHC == 9 && (cls_) >= 0)) F.MISC[60] = F.MISC[60] + (now_ - F.MISC[62]); F.MISC[62] = now_; F.MISC[61] = 1u; } } while (0)
#else
#define PT_MARK(cls_) do {} while (0)
#endif
    PT_MARK(-1);
#ifdef PROBE_LAST
    if (blockIdx.x == 0 && threadIdx.x == 0) { const unsigned long long st_ = __builtin_amdgcn_s_memrealtime(); __hip_atomic_store((unsigned long long*)((gu32*)(KA()->ws + WS_CTL) + 12000), st_, __ATOMIC_RELAXED, __HIP_MEMORY_SCOPE_AGENT); }
#endif
    FRESH(); p0_prologue(F);
    GRID_BAR(); PT_MARK(0);
#ifdef PROBE_BARS
    for (int pb_ = 0; pb_ < PROBE_BARS; ++pb_) { GRID_BAR(); }
#endif
#ifdef DUP_P0
    FRESH(); p0_prologue(F);
    GRID_BAR();
#endif
    { if (threadIdx.x == 0) { unsigned full = (F.G == 256) ? 1u : 0u; const unsigned* bw = (const unsigned*)((gu32*)(KA()->ws + WS_CTL) + CW_BAR);
          for (int jx = 0; jx < 16; ++jx) { const unsigned cnt = __hip_atomic_load(bw + XB_XCNT(jx), __ATOMIC_RELAXED, __HIP_MEMORY_SCOPE_AGENT); if (jx < 8 ? cnt != 32u : cnt != 0u) full = 0u; }
          F.MISC[10] = full; }
      __syncthreads(); }
#ifdef FORCE_SAFE
    const bool safe_mode = __builtin_amdgcn_readfirstlane((int)F.MISC[10]) != 12345;
#else
    const bool safe_mode = __builtin_amdgcn_readfirstlane((int)F.MISC[10]) == 0;
#endif
#pragma unroll 1
#ifdef PROBE_DUPCH
    for (int pc = -PROBE_NDUP; pc < 5; ++pc) {
        const int chain = pc < 0 ? PROBE_DUPCH : pc; const int j = chain >> 1;
        FRESH(); pg8::gemm_chain(F.lds + RING_OFF, F.MISC + 16, F.lds + RDYSLOT_OFF, (LAS unsigned long long*)(F.lds + EXTRA_OFF), chain, pc < 0 ? 5 - (pc + 1) : chain, safe_mode);
        if (pc < 0) { GRID_BAR(); continue; }
#else
    for (int chain = 0; chain < 5; ++chain) {
        const int j = chain >> 1;
#if defined(PROBE_TIME) && PROBE_SEG == 3
        unsigned long long pc0_ = PROBE_TIME == 1 ? __builtin_amdgcn_s_memrealtime() : __builtin_amdgcn_s_memtime();
#endif
        FRESH(); pg8::gemm_chain(F.lds + RING_OFF, F.MISC + 16, F.lds + RDYSLOT_OFF, (LAS unsigned long long*)(F.lds + EXTRA_OFF), chain, chain, safe_mode);
#if defined(PROBE_TIME) && PROBE_SEG == 3
        if (chain == PROBE_CH && blockIdx.x == PROBE_WG && threadIdx.x == 0) { const unsigned long long pc1_ = PROBE_TIME == 1 ? __builtin_amdgcn_s_memrealtime() : __builtin_amdgcn_s_memtime(); F.MISC[60] = F.MISC[60] + (unsigned)(pc1_ - pc0_); }
#endif
#endif
        if (chain == 4) break;
        if ((chain & 1) == 0) { FRESH(); cache_to_rings(F, j); }
        GRID_BAR(); PT_MARK((PROBE_ONECH < 0 || chain == PROBE_ONECH) ? 1 : 7);
        if ((chain & 1) == 0) {
            FRESH(); attn_phase(F, j);
#ifdef DUP_ATT
            GRID_BAR(); FRESH(); attn_phase(F, j);
#endif
            GRID_BAR(); PT_MARK(2);
        } else {
            FRESH(); for (int u = F.vcu; u < N_MUNITS; u += F.G) mlstm_a_unit(F, j, u);
            GRID_BAR(); PT_MARK(3);
#ifdef DUP_MA
            FRESH(); for (int u = F.vcu; u < N_MUNITS; u += F.G) mlstm_a_unit(F, j, u);
            GRID_BAR();
#endif
#ifdef DUP_MB
            FRESH(); mlstm_b_phase(F, j, true);
            GRID_BAR();
#endif
            FRESH(); mlstm_b_phase(F, j);
            GRID_BAR(); PT_MARK(4);
#ifdef DUP_MC
            FRESH(); for (int u = F.vcu; u < N_MUNITS; u += F.G) mlstm_c_unit(F, j, u, true);
            GRID_BAR();
#endif
            FRESH(); for (int u = F.vcu; u < N_MUNITS; u += F.G) mlstm_c_unit(F, j, u);
            GRID_BAR(); PT_MARK(5);
        }
    }
    PT_MARK(1);
#if defined(PROBE_TIME) || defined(PROBE_PHC) || defined(PROBE_ATT) || defined(PROBE_MA) || defined(PROBE_MC)
    if (blockIdx.x == PROBE_WG && threadIdx.x == 0) { const unsigned tot = F.MISC[60], cnt = F.MISC[61];
        const unsigned long long wait_ticks = cnt ? (unsigned long long)((float)tot * (float)(PROBE_SCALE * 100.0) / (float)cnt) : 0ull;
        const unsigned long long t0 = __builtin_amdgcn_s_memrealtime(); while (__builtin_amdgcn_s_memrealtime() - t0 < wait_ticks) __builtin_amdgcn_s_sleep(8); }
#endif
#ifdef PROBE_LAST
    if (threadIdx.x == 0) { unsigned* cw_ = (unsigned*)KA()->ws + 12064; const unsigned n_ = __hip_atomic_fetch_add(cw_, 1u, __ATOMIC_RELAXED, __HIP_MEMORY_SCOPE_AGENT);
        if (n_ == gridDim.x - 1) { const unsigned long long st_ = __hip_atomic_load((unsigned long long*)((gu32*)(KA()->ws + WS_CTL) + 12000), __ATOMIC_RELAXED, __HIP_MEMORY_SCOPE_AGENT);
            const unsigned long long t0 = __builtin_amdgcn_s_memrealtime(); const unsigned long long wait_ticks = (unsigned long long)((float)(t0 - st_) * (float)PROBE_SCALE);
            while (__builtin_amdgcn_s_memrealtime() - t0 < wait_ticks) __builtin_amdgcn_s_sleep(8); } }
#endif
#undef GRID_BAR
}

extern "C" void kernel_launch(void* const* d_in, const int* in_sizes, int n_in, void* d_out, int out_size, void* d_ws, size_t ws_size, hipStream_t stream) {
    static int grid = 0;
    if (grid == 0) {
        if (n_in != 24 || (size_t)out_size != O_END || ws_size < WS_END) { fprintf(stderr, "kernel_launch: unexpected shapes: n_in %d out %d ws %zu (need %zu)\n", n_in, out_size, ws_size, (size_t)WS_END); grid = -1; return; }
        int dev = 0, cus = 0, per_cu = 0;
        if (hipGetDevice(&dev) != hipSuccess || hipDeviceGetAttribute(&cus, hipDeviceAttributeMultiprocessorCount, dev) != hipSuccess) { fprintf(stderr, "kernel_launch: device query failed\n"); grid = -1; return; }
        if (hipFuncSetAttribute((const void*)hybrid_fwd, hipFuncAttributeMaxDynamicSharedMemorySize, LDS_BYTES) != hipSuccess) { fprintf(stderr, "kernel_launch: hipFuncSetAttribute failed\n"); grid = -1; return; }
        if (hipOccupancyMaxActiveBlocksPerMultiprocessor(&per_cu, (const void*)hybrid_fwd, NWAVES * 64, LDS_BYTES) != hipSuccess || per_cu < 1)
            fprintf(stderr, "kernel_launch: note: occupancy query reports %d workgroups per CU\n", per_cu);
        (void)hipGetLastError();
        grid = cus;
    }
    if (grid < 0) return;
    if (hipMemsetAsync((char*)d_ws + WS_CTL, 0, CTL_ZERO_BYTES, stream) != hipSuccess) { fprintf(stderr, "kernel_launch: hipMemsetAsync failed\n"); return; }
    Args a{};
    for (int i = 0; i < 24; ++i) a.in[i] = (const float*)d_in[i];
    a.out = (float*)d_out; a.ws = (unsigned char*)d_ws;
    hipLaunchKernelGGL(hybrid_fwd, dim3(grid), dim3(NWAVES * 64), LDS_BYTES, stream, a);
    const hipError_t le = hipPeekAtLastError();
    if (le != hipSuccess) fprintf(stderr, "kernel_launch: launch failed: %s\n", hipGetErrorName(le));
}
```

```cpp
#include <hip/hip_runtime.h>
#include <cstdio>
#include <cstdint>
constexpr int MP = 16384, MS = 1024, MT = 17408, D = 1024, FF = 4096, NQKV = 3072, NMIN = 4352  , NMIN_REAL = 4104;
constexpr int HIDP = 4096 + 64;
constexpr int N_MUNITS = 576;
constexpr size_t SLAB_BYTES = 272 * 256 * 2;
constexpr size_t O_Y = 0, O_KP = 17825792, O_VP = 18874368, O_KS = 19922944, O_VS = 22020096, O_CP = 24117248, O_NP = 24641536, O_MP = 24643584, O_BP = 24643592,
                 O_CS = 24655880, O_NS = 33044488, O_MS = 33077256, O_BS = 33077384, O_END = 33273992;
constexpr size_t MiB = 1u << 20;
constexpr size_t WS_CTL = 0, WS_SSQ = MiB / 2, CTL_ZERO_BYTES = 2 * MiB;
constexpr float SSQ_FIX = 268435456.0f, SSQ_UNFIX = 1.0f / 268435456.0f;
constexpr size_t WS_WINA = 2 * MiB, WS_WOA = 14 * MiB, WS_WINB = 18 * MiB, WS_WOB = 35 * MiB, WS_WUP = 39 * MiB, WS_WDN = 71 * MiB;
constexpr size_t WS_XB = 104 * MiB, WS_GATES = 139 * MiB, WS_STATS = 140 * MiB;
constexpr size_t WS_MIX = 141 * MiB, WS_HID = 175 * MiB, WS_NXT = 320 * MiB, WS_END = 422 * MiB;
constexpr size_t WS_Q = WS_MIX, WS_O = WS_MIX, WS_OG = WS_MIX;
constexpr size_t WS_KP = WS_NXT, WS_VP = WS_NXT + 32 * MiB, WS_RK = WS_NXT + 64 * MiB, WS_RV = WS_NXT + 82 * MiB;
constexpr size_t WS_QKP = WS_NXT, WS_V = WS_NXT + 68 * MiB;
constexpr size_t WS_QC = WS_HID, WS_KC = WS_HID + 34 * MiB, WS_SLAB = WS_HID + 68 * MiB;
static_assert(WS_SLAB + (size_t)N_MUNITS * SLAB_BYTES <= WS_NXT && WS_RV + 18 * MiB <= WS_END && WS_V + 34 * MiB <= WS_END && WS_HID + (size_t)MT * HIDP * 2 <= WS_NXT, "d_ws map");
constexpr int CW_BAR = 4096;
constexpr int RING_OFF = 0, RING_BYTES = 131072, EXTRA_OFF = RING_BYTES, EXTRA_BYTES = 28672  , EPITR_OFF = EXTRA_OFF + 12288, LDSCTL_OFF = EXTRA_OFF + EXTRA_BYTES, MISC_OFF = LDSCTL_OFF + 320, RDYSLOT_OFF = LDSCTL_OFF + 1024  ;
constexpr int LDS_BYTES = 163840;
static_assert(MISC_OFF + 128 <= LDS_BYTES, "LDS map");
constexpr int NWAVES = 8;

namespace pg8 {
#define PG8_LAS __attribute__((address_space(3)))
typedef unsigned short bf16_t;
typedef short bf16x8 __attribute__((ext_vector_type(8)));
typedef float f32x4 __attribute__((ext_vector_type(4)));
typedef unsigned u32x4 __attribute__((ext_vector_type(4)));
constexpr int BM = 256, BK = 64, HALF = 128, HTB = HALF * BK * 2  , STAGE_BYTES = 8 * HTB, NXCD = 8, WGM = 8;

__host__ __device__ __forceinline__ int lds_byte(int r, int c) { const int st = (r >> 4) * 2 + (c >> 5), rr = r & 15, cc = c & 31, ob = rr * 64 + cc * 2; return st * 1024 + (ob ^ (((ob >> 9) & 1) << 5)); }
__host__ __device__ __forceinline__ void stage_rc(int b, int& R, int& C) { const int st = b / 1024, sb = b % 1024, swz = sb ^ (((sb >> 9) & 1) << 5); R = (st >> 1) * 16 + swz / 64; C = (st & 1) * 32 + (swz % 64) / 2; }
__host__ __device__ __forceinline__ int perm32(int rho) { const int n = rho >> 4, i = rho & 15; return 8 * (i >> 2) + 4 * n + (i & 3); }

struct Unit { int pm, pn; };
struct Gemm { const bf16_t* A; const bf16_t* Bt; int M, N, K; };

struct StaticOrder {
    int nM, nN, nwg, G, c;
    __host__ __device__ void init(int M, int N, int G_, int c_) { nM = M / BM; nN = N / BM; nwg = nM * nN; G = G_; c = c_; }
    __host__ __device__ bool next(int i, Unit& u) const {
        const long L = (long)i * G + c; if (L >= nwg) return false;
        int wgid = (int)L; { const int q = nwg / NXCD, r = nwg % NXCD, xcd = wgid % NXCD, off = wgid / NXCD; wgid = (xcd < r ? xcd * (q + 1) : r * (q + 1) + (xcd - r) * q) + off; }
        const int nig = WGM * nN, gid = wgid / nig, fm = gid * WGM, gsz = (nM - fm) < WGM ? (nM - fm) : WGM;
        u.pm = fm + ((wgid % nig) % gsz); u.pn = (wgid % nig) / gsz; return true;
    }
    __device__ __forceinline__ void a_ready(const Unit&) const {}
    __device__ __forceinline__ void done(const Unit&) const {}
};

constexpr int MP_ROWS = MP, MS_ROWS = MS, DM = D;
constexpr size_t BLK_KT = 32768, BLK_AI = 16384;
__host__ __device__ __forceinline__ constexpr int blk_img(int wr, int wcl, int m, int fr, int fq) { return ((4 * wr + m) * 2 + wcl) * 1024 + ((fr * 64 + fq * 16) ^ ((fr >> 3) << 5)); }
constexpr float NEPS = 1e-6f;
struct Args { const float* in[24]; float* out; unsigned char* ws; };
typedef const __attribute__((address_space(4))) Args* KArgs;
__device__ __forceinline__ KArgs KA() { KArgs p = (KArgs)__builtin_amdgcn_kernarg_segment_ptr(); asm volatile("" : "+s"(p)); return p; }
typedef float f32x2_e __attribute__((ext_vector_type(2))); typedef __bf16 bf16x2_e __attribute__((ext_vector_type(2)));
__device__ __forceinline__ unsigned cvt_pk_bf16(float lo, float hi) { f32x2_e v = {lo, hi}; bf16x2_e b = __builtin_convertvector(v, bf16x2_e); return __builtin_bit_cast(unsigned, b); }
__device__ __forceinline__ u32x4 pack8(const f32x4 v0, const f32x4 v1) { u32x4 w; w.x = cvt_pk_bf16(v0[0], v0[1]); w.y = cvt_pk_bf16(v0[2], v0[3]); w.z = cvt_pk_bf16(v1[0], v1[1]); w.w = cvt_pk_bf16(v1[2], v1[3]); return w; }
typedef __amdgpu_buffer_rsrc_t rsrc_t;
__device__ __forceinline__ rsrc_t mk_rsrc(const void* p, unsigned bytes) { return __builtin_amdgcn_make_buffer_rsrc((void*)p, 0, (int)bytes, 0x00020000); }
__device__ __forceinline__ f32x4 bld16(rsrc_t r, unsigned off) { return __builtin_bit_cast(f32x4, __builtin_amdgcn_raw_buffer_load_b128(r, (int)off, 0, 16)); }
__device__ __forceinline__ void bst16(rsrc_t r, unsigned off, u32x4 v, bool wt) { if (wt) __builtin_amdgcn_raw_buffer_store_b128(v, r, (int)off, 0, 16); else __builtin_amdgcn_raw_buffer_store_b128(v, r, (int)off, 0, 0); }
__device__ __forceinline__ void bst16(rsrc_t r, unsigned off, f32x4 v, bool wt) { bst16(r, off, __builtin_bit_cast(u32x4, v), wt); }
__device__ __forceinline__ void epi_tr(PG8_LAS unsigned char* slot, int fr, int fq, const u32x4 in0, const u32x4 in1, u32x4& out0, u32x4& out1) {
    const int lane = fq * 16 + fr, r = lane >> 3, c = lane & 7;
    *(volatile PG8_LAS u32x4*)(slot + fr * 128 + ((fq ^ (fr & 7)) * 16)) = in0;
    *(volatile PG8_LAS u32x4*)(slot + fr * 128 + (((4 + fq) ^ (fr & 7)) * 16)) = in1;
    out0 = *(volatile const PG8_LAS u32x4*)(slot + r * 128 + ((c ^ (r & 7)) * 16));
    out1 = *(volatile const PG8_LAS u32x4*)(slot + (8 + r) * 128 + ((c ^ (r & 7)) * 16));
}
template <int NAI> __device__ __forceinline__ void row_scales(const unsigned long long* ssqk, int row0, float (&rs)[NAI][4], const PG8_LAS unsigned long long* sl = nullptr, int lrow0 = 0) {
    unsigned long long raw[NAI][4];
    if (sl) {
#pragma unroll
        for (int ai = 0; ai < NAI; ++ai)
#pragma unroll
            for (int m = 0; m < 4; ++m) raw[ai][m] = sl[lrow0 + ai * HALF + m * 16];
    } else {
#pragma unroll
        for (int ai = 0; ai < NAI; ++ai)
#pragma unroll
            for (int m = 0; m < 4; ++m) raw[ai][m] = __hip_atomic_load(ssqk + row0 + ai * HALF + m * 16, __ATOMIC_RELAXED, __HIP_MEMORY_SCOPE_AGENT);
    }
#pragma unroll
    for (int ai = 0; ai < NAI; ++ai)
#pragma unroll
        for (int m = 0; m < 4; ++m) rs[ai][m] = __builtin_amdgcn_rsqf(((float)(unsigned)(raw[ai][m] >> 32) * 4294967296.0f + (float)(unsigned)raw[ai][m]) * (SSQ_UNFIX / 1024.0f) + NEPS);
}

struct EpiRes {
    int last, kout, dry, wt;
    __device__ __forceinline__ void operator()(const f32x4 (&acc)[2][2][4][2], const Unit& u, int wr, int wc, int fr, int fq) const { run<2>(acc, u.pm * BM + wr * 64, u.pn, wc, fr, fq); }
    template <int NAI> __device__ __forceinline__ void run(const f32x4 (&acc)[NAI][2][4][2], int rowbase, int pn, int wc, int fr, int fq) const {
        KArgs ka = KA(); float* out = ka->out; unsigned char* ws = ka->ws; unsigned long long* ssq = (unsigned long long*)(ws + WS_SSQ) + (size_t)kout * MT;
        const rsrc_t rb = mk_rsrc(ws + WS_XB, MT * D * 2u);
        const rsrc_t ro = dry ? mk_rsrc(ws + WS_NXT, MT * D * 4u) : mk_rsrc(out, MT * D * 4u), rx = dry ? mk_rsrc(ws + WS_NXT + 68 * MiB, MT * D * 2u) : rb;
        const int row0 = rowbase + fr, col0 = pn * BM + wc * 32 + 8 * fq;
        const unsigned xo = (unsigned)(rowbase >> 8) * (256u * DM * 2u) + (unsigned)(4 * pn + (wc >> 1)) * (unsigned)BLK_KT + (unsigned)blk_img((rowbase >> 6) & 1, wc & 1, 0, fr, fq);
#pragma unroll
        for (int ai = 0; ai < NAI; ++ai) {
            u32x4 b[4][2];
#pragma unroll
            for (int m = 0; m < 4; ++m)
#pragma unroll
                for (int bj = 0; bj < 2; ++bj) b[m][bj] = __builtin_bit_cast(u32x4, bld16(rb, xo + (unsigned)(2 * bj * (int)BLK_KT + ai * (int)BLK_AI + m * 2048)));
#pragma unroll
            for (int m = 0; m < 4; ++m) {
                const int row = row0 + ai * HALF + m * 16; const unsigned eo = (unsigned)(row * DM + col0);
                float ss = 0.f;
#pragma unroll
                for (int bj = 0; bj < 2; ++bj) {
                    const u32x4 w = b[m][bj];
                    const f32x4 b0 = {__uint_as_float(w.x << 16), __uint_as_float(w.x & 0xffff0000u), __uint_as_float(w.y << 16), __uint_as_float(w.y & 0xffff0000u)};
                    const f32x4 b1 = {__uint_as_float(w.z << 16), __uint_as_float(w.z & 0xffff0000u), __uint_as_float(w.w << 16), __uint_as_float(w.w & 0xffff0000u)};
                    const f32x4 v0 = acc[ai][bj][m][0] + b0, v1 = acc[ai][bj][m][1] + b1;
                    if (last) { bst16(ro, (eo + bj * HALF) * 4u, v0, wt); bst16(ro, (eo + bj * HALF) * 4u + 16u, v1, wt); }
                    else bst16(rx, xo + (unsigned)(2 * bj * (int)BLK_KT + ai * (int)BLK_AI + m * 2048), pack8(v0, v1), wt);
                    ss += (v0[0] * v0[0] + v0[1] * v0[1]) + (v0[2] * v0[2] + v0[3] * v0[3]) + (v1[0] * v1[0] + v1[1] * v1[1]) + (v1[2] * v1[2] + v1[3] * v1[3]);
                }
                if (!last) {
                    ss += __shfl_xor(ss, 16); ss += __shfl_xor(ss, 32);
                    if (fq == 0) atomicAdd(ssq + row, (unsigned long long)(ss * SSQ_FIX));
                }
            }
            asm volatile("" ::: "memory");
        }
    }
};

struct EpiUp {
    int kin, wt; const PG8_LAS unsigned long long* sl;
    __device__ __forceinline__ void operator()(const f32x4 (&acc)[2][2][4][2], const Unit& u, int wr, int wc, int fr, int fq) const { run<2>(acc, u.pm * BM + wr * 64, u.pn, wc, fr, fq); }
    template <int NAI> __device__ __forceinline__ void run(const f32x4 (&acc)[NAI][2][4][2], int rowbase, int pn, int wc, int fr, int fq) const {
        KArgs ka = KA(); unsigned char* ws = ka->ws; const unsigned long long* ssq = (const unsigned long long*)(ws + WS_SSQ) + (size_t)kin * MT;
        const rsrc_t rh = mk_rsrc(ws + WS_HID, MT * (unsigned)HIDP * 2u);
        const int row0 = rowbase + fr;
        const unsigned ho = (unsigned)(rowbase >> 8) * (256u * FF * 2u) + (unsigned)(4 * pn + (wc >> 1)) * (unsigned)BLK_KT + (unsigned)blk_img((rowbase >> 6) & 1, wc & 1, 0, fr, fq);
        float rs[NAI][4]; row_scales<NAI>(ssq, row0, rs, sl, (rowbase & 255) + fr);
#pragma unroll
        for (int ai = 0; ai < NAI; ++ai)
#pragma unroll
            for (int m = 0; m < 4; ++m) {
#pragma unroll
                for (int bj = 0; bj < 2; ++bj) {
                    f32x4 v0 = acc[ai][bj][m][0] * rs[ai][m], v1 = acc[ai][bj][m][1] * rs[ai][m];
#pragma unroll
                    for (int i = 0; i < 4; ++i) { const float a = fmaxf(v0[i], 0.f), b = fmaxf(v1[i], 0.f); v0[i] = a * a; v1[i] = b * b; }
                    bst16(rh, ho + (unsigned)(2 * bj * (int)BLK_KT + ai * (int)BLK_AI + m * 2048), pack8(v0, v1), wt);
                }
            }
    }
};

struct EpiQKV {
    int j, kin; const PG8_LAS unsigned long long* sl; PG8_LAS unsigned char* slot;
    __device__ __forceinline__ void operator()(const f32x4 (&acc)[2][2][4][2], const Unit& u, int wr, int wc, int fr, int fq) const { run<2>(acc, u.pm * BM + wr * 64, u.pn, wc, fr, fq); }
    template <int NAI> __device__ __forceinline__ void run(const f32x4 (&acc)[NAI][2][4][2], int rowbase, int pn, int wc, int fr, int fq) const {
        KArgs ka = KA(); unsigned char* ws = ka->ws; float* out = ka->out; const unsigned long long* ssq = (const unsigned long long*)(ws + WS_SSQ) + (size_t)kin * MT; const float* qg = ka->in[12] + j * 64; const float* kg = ka->in[13] + j * 64;
        bf16_t *Q = (bf16_t*)(ws + WS_Q), *KP = (bf16_t*)(ws + WS_KP), *VP = (bf16_t*)(ws + WS_VP), *RK = (bf16_t*)(ws + WS_RK), *RV = (bf16_t*)(ws + WS_RV);
        float *okp = out + O_KP + (size_t)j * 512 * DM, *ovp = out + O_VP + (size_t)j * 512 * DM, *oks = out + O_KS + (size_t)j * MS_ROWS * DM, *ovs = out + O_VS + (size_t)j * MS_ROWS * DM;
        const int t = pn >> 2, head = (pn & 3) * 4 + wc;
        const int row0 = rowbase + fr;
        float rs[NAI][4]; row_scales<NAI>(ssq, row0, rs, sl, (rowbase & 255) + fr);
        f32x4 g[2][2];
        const float* gp = (t == 0) ? qg : kg;
#pragma unroll
        for (int bj = 0; bj < 2; ++bj)
#pragma unroll
            for (int n = 0; n < 2; ++n) { g[bj][n] = (t < 2) ? *(const f32x4*)(gp + 32 * bj + 8 * fq + 4 * n) : (f32x4){1.f, 1.f, 1.f, 1.f}; if (t == 0) g[bj][n] = g[bj][n] * (0.125f * 1.4426950408889634f); }
#pragma unroll
        for (int ai = 0; ai < NAI; ++ai)
#pragma unroll
            for (int m = 0; m < 4; ++m) {
                const int row = row0 + ai * HALF + m * 16;
                f32x4 v[2][2]; float ss = 0.f;
#pragma unroll
                for (int bj = 0; bj < 2; ++bj)
#pragma unroll
                    for (int n = 0; n < 2; ++n) { v[bj][n] = acc[ai][bj][m][n] * rs[ai][m]; const f32x4 x = v[bj][n]; ss += (x[0] * x[0] + x[1] * x[1]) + (x[2] * x[2] + x[3] * x[3]); }
                if (t < 2) {
                    ss += __shfl_xor(ss, 16); ss += __shfl_xor(ss, 32);
                    const float rr = __builtin_amdgcn_rsqf(ss * (1.0f / 64.0f) + NEPS);
#pragma unroll
                    for (int bj = 0; bj < 2; ++bj)
#pragma unroll
                        for (int n = 0; n < 2; ++n) v[bj][n] = v[bj][n] * rr * g[bj][n];
                }
                {
                    u32x4 o0, o1; epi_tr(slot, fr, fq, pack8(v[0][0], v[0][1]), pack8(v[1][0], v[1][1]), o0, o1);
                    const int ln = fq * 16 + fr, col = head * 64 + (ln & 7) * 8;
#pragma unroll
                    for (int h = 0; h < 2; ++h) {
                        const int rw = rowbase + ai * HALF + m * 16 + 8 * h + (ln >> 3);
                        bf16_t* dstb;
                        if (t == 0) dstb = Q + (size_t)rw * DM + col;
                        else if (rw < MP_ROWS) dstb = (t == 1 ? KP : VP) + (size_t)rw * DM + col;
                        else { const int sr = rw - MP_ROWS, b = sr >> 6, tt = sr & 63; dstb = (t == 1 ? RK : RV) + ((size_t)b * 576 + 512 + tt) * DM + col; }
                        *(u32x4*)dstb = h ? o1 : o0;
                    }
                }
                if (t != 0 && (row >= MP_ROWS - 512)) {
#pragma unroll
                    for (int bj = 0; bj < 2; ++bj) {
                        const int col = head * 64 + 32 * bj + 8 * fq;
                        float* dstf;
                        if (row < MP_ROWS) dstf = (t == 1 ? okp : ovp) + (size_t)(row - (MP_ROWS - 512)) * DM + col;
                        else dstf = (t == 1 ? oks : ovs) + (size_t)(row - MP_ROWS) * DM + col;
                        *(f32x4*)dstf = v[bj][0]; *(f32x4*)(dstf + 4) = v[bj][1];
                    }
                }
            }
    }
};

struct EpiMIn {
    int j, kin; const PG8_LAS unsigned long long* sl; PG8_LAS unsigned char* slot;
    __device__ __forceinline__ void operator()(const f32x4 (&acc)[2][2][4][2], const Unit& u, int wr, int wc, int fr, int fq) const { run<2>(acc, u.pm * BM + wr * 64, u.pn, wc, fr, fq); }
    template <int NAI> __device__ __forceinline__ void run(const f32x4 (&acc)[NAI][2][4][2], int rowbase, int pn, int wc, int fr, int fq) const {
        KArgs ka = KA(); unsigned char* ws = ka->ws; float* out = ka->out; const unsigned long long* ssq = (const unsigned long long*)(ws + WS_SSQ) + (size_t)kin * MT; const float* b_i = ka->in[16] + j * 4; const float* b_f = ka->in[17] + j * 4;
        bf16_t *QKP = (bf16_t*)(ws + WS_QKP), *V = (bf16_t*)(ws + WS_V), *OG = (bf16_t*)(ws + WS_OG); float* gates = (float*)(ws + WS_GATES);
        float *ocp = out + O_BP + (size_t)j * 3 * 2048, *ocs = out + O_BS + (size_t)j * 16 * 3 * 2048;
        const int row0 = rowbase + fr, cl0 = wc * 32 + 8 * fq;
        if (pn == 16 && !(wc == 0 && fq == 0)) return;
        float rs[NAI][4]; row_scales<NAI>(ssq, row0, rs, sl, (rowbase & 255) + fr);
#pragma unroll
        for (int ai = 0; ai < NAI; ++ai)
#pragma unroll
            for (int m = 0; m < 4; ++m) {
                const int row = row0 + ai * HALF + m * 16;
                if (pn == 16) {
                    const f32x4 gi = acc[ai][0][m][0] * rs[ai][m] + *(const f32x4*)b_i, gf = acc[ai][0][m][1] * rs[ai][m] + *(const f32x4*)b_f;
                    f32x4 lf;
#pragma unroll
                    for (int i = 0; i < 4; ++i) lf[i] = fminf(gf[i], 0.f) - __logf(1.0f + __expf(-fabsf(gf[i])));
                    *(f32x4*)(gates + (size_t)row * 8) = gi; *(f32x4*)(gates + (size_t)row * 8 + 4) = lf;
                    continue;
                }
                u32x4 wq[2];
#pragma unroll
                for (int bj = 0; bj < 2; ++bj) {
                    f32x4 v0 = acc[ai][bj][m][0] * rs[ai][m], v1 = acc[ai][bj][m][1] * rs[ai][m];
                    if (pn < 8) {
                        const int col = pn * BM + cl0 + bj * HALF;
                        float* dstf = nullptr;
                        if (row < MP_ROWS) { if (row >= MP_ROWS - 3) dstf = ocp + (size_t)(row - (MP_ROWS - 3)) * 2048 + col; }
                        else { const int sr = row - MP_ROWS, b = sr >> 6, tt = sr & 63; if (tt >= 61) dstf = ocs + ((size_t)b * 3 + (tt - 61)) * 2048 + col; }
                        if (dstf) { *(f32x4*)dstf = v0; *(f32x4*)(dstf + 4) = v1; }
                    } else if (pn >= 12) {
#pragma unroll
                        for (int i = 0; i < 4; ++i) { v0[i] = __builtin_amdgcn_rcpf(1.0f + __expf(-v0[i])); v1[i] = __builtin_amdgcn_rcpf(1.0f + __expf(-v1[i])); }
                    }
                    wq[bj] = pack8(v0, v1);
                }
                {
                    u32x4 o0, o1; epi_tr(slot, fr, fq, wq[0], wq[1], o0, o1);
                    const int ln = fq * 16 + fr, cl = wc * 32 + (ln & 3) * 8 + ((ln >> 2) & 1) * HALF;
                    bf16_t* dst = (pn < 8) ? QKP + (size_t)pn * BM + cl : (pn < 12) ? V + (size_t)(pn - 8) * BM + cl : OG + (size_t)(pn - 12) * BM + cl;
                    const int pitch = (pn < 8) ? 2048 : DM;
                    const int rw = rowbase + ai * HALF + m * 16 + (ln >> 3);
                    *(u32x4*)(dst + (size_t)rw * pitch) = o0; *(u32x4*)(dst + (size_t)(rw + 8) * pitch) = o1;
                }
            }
    }
};
}

namespace pg8 {
constexpr int CW_Q = 8192, CW_RDY = 16384;
struct UnitX { const char* A; const char* B; int K, lda, pm, pn, stage; };
__device__ __forceinline__ int chain_nn3(int chain) { return (chain == 4) ? 0 : ((chain & 1) ? 17 : 12); }
__device__ __forceinline__ int chain_scnt(int nN, int q) { return (4 * nN - q + 7) >> 3; }
__device__ __forceinline__ int chain_total(int chain, int q) {
    const int n3 = chain_nn3(chain), t3 = n3 ? chain_scnt(n3, q) + 8 * n3 : 0;
    return chain == 0 ? t3 : (2 + 32) + (8 + 128) + (2 + 32) + t3;
}
__device__ __forceinline__ void chain_decode(int chain, int q, int L, UnitX& u, int& need) {
    KArgs ka = KA(); const unsigned char* ws = ka->ws;
    int s, i, samp = 0;
    if (chain == 0) { s = 3; i = L; }
    else if (L < 34) { s = 0; i = L; samp = 2; }
    else if (L < 172) {
        const int x = L - 34;
        if (x < 56) { s = 1; i = x; samp = 8; } else if (x < 58) { s = 2; i = x - 56; samp = 2; } else { s = 1; i = x - 2; samp = 8; }
    }
    else if (L < 204) { s = 2; i = L - 172 + 2; samp = 2; }
    else { s = 3; i = L - 204; }
    const int l = chain - 1, lin = chain;
    int nN, K = 1024; const unsigned char *A, *B;
    if (s == 0)      { nN = 4;  A = ws + WS_MIX; B = ws + ((l & 1) ? WS_WOB : WS_WOA) + (size_t)(l >> 1) * 1024 * 1024 * 2; }
    else if (s == 1) { nN = 16; A = ws + WS_XB;  B = ws + WS_WUP + (size_t)l * 4096 * 1024 * 2; }
    else if (s == 2) { nN = 4;  A = ws + WS_HID; B = ws + WS_WDN + (size_t)l * HIDP * 1024 * 2; K = 4096; }
    else             { nN = (lin & 1) ? 17 : 12; A = ws + WS_XB; B = (lin & 1) ? ws + WS_WINB + (size_t)(lin >> 1) * 4352 * 1024 * 2 : ws + WS_WINA + (size_t)(lin >> 1) * 3072 * 1024 * 2; samp = chain_scnt(nN, q); }
    if (i < samp) { const int e = q + 8 * i, sp = e / nN; u.pm = 64 + sp; u.pn = e - sp * nN; }
    else { const int ip = i - samp, gsz = 4 * nN, g = ip >= gsz ? 1 : 0, r = ip - g * gsz; u.pm = q + 8 * (4 * g + (r & 3)); u.pn = r >> 2; }
    u.K = K; u.stage = s; u.lda = (s == 2) ? HIDP : K;
    u.A = (const char*)A + (size_t)u.pm * 256 * K * 2; u.B = (const char*)B + (size_t)u.pn * 256 * K * 2;
    need = (s == 1) ? 32 : (s == 2) ? 128 : (s == 3 && chain > 0) ? 32 : 0;
}
__device__ __forceinline__ int chain_kin(int chain, int stage, bool dry) { return stage == 1 ? (dry ? 6 : 2 * chain - 1) : (stage == 3 ? 2 * chain : -1); }
__device__ __forceinline__ void chain_epilogue(int chain, bool dry, bool wt, const PG8_LAS unsigned long long* sl, PG8_LAS unsigned char* slot, const UnitX& u, const f32x4 (&acc)[2][2][4][2], int wr, int wc, int fr, int fq) {
    const int rowbase = u.pm * BM + wr * 64;
    if (u.stage == 0 || u.stage == 2) { EpiRes E{(chain == 4 && u.stage == 2 && !dry) ? 1 : 0, dry ? 9 : 2 * chain - 1 + (u.stage >> 1), dry ? 1 : 0, wt ? 1 : 0}; E.run<2>(acc, rowbase, u.pn, wc, fr, fq); }
    else if (u.stage == 1) { EpiUp E{chain_kin(chain, 1, dry), wt ? 1 : 0, sl}; E.run<2>(acc, rowbase, u.pn, wc, fr, fq); }
    else if (chain & 1) { EpiMIn E{chain >> 1, 2 * chain, sl, slot}; E.run<2>(acc, rowbase, u.pn, wc, fr, fq); }
    else { EpiQKV E{chain >> 1, 2 * chain, sl, slot}; E.run<2>(acc, rowbase, u.pn, wc, fr, fq); }
}

__device__ __forceinline__ void gemm_chain(PG8_LAS unsigned char* lds, volatile PG8_LAS unsigned* bx  , PG8_LAS unsigned char* rslot  , PG8_LAS unsigned long long* sslot  , const int chain, const int cchain  , const bool safe  ) {
    int tid_ = threadIdx.x; asm volatile("" : "+v"(tid_));
    const int tid = tid_, wid = __builtin_amdgcn_readfirstlane(tid >> 6), lane = tid & 63, wr = wid >> 2, wc = wid & 3, fr = lane & 15, fq = lane >> 4;
    unsigned* const ctl = (unsigned*)KA()->ws;
    unsigned* const qw = ctl + CW_Q + 64 * 8 * cchain;
    unsigned* const rdy = ctl + CW_RDY + (size_t)cchain * 3 * 68 * 64;
#define CH_VOFF(LA_, BLK_, vA_, vB_) do { _Pragma("unroll") for (int i_ = 0; i_ < 2; ++i_) { int R_, C_; stage_rc(tid * 16 + i_ * 8192, R_, C_); const int Rb_ = (R_ & ~31) + perm32(R_ & 31); \
        vA_[i_] = (BLK_) ? (unsigned)(tid * 16 + i_ * 8192) : (unsigned)(R_ * (LA_) + C_) * 2u; vB_[i_] = (unsigned)(tid * 16 + i_ * 8192); (void)Rb_; } } while (0)
    const size_t kstep = (size_t)(BK * 2);
    const unsigned ldsw = (unsigned)wid * 1024u;
    const int aoff = lds_byte(wr * 64 + fr, fq * 8), boff = lds_byte(wc * 32 + fr, fq * 8);
#ifndef PG8_A_AUX
#define PG8_A_AUX 16
#endif
#define PG8_SA(b, h) (((b) * 2 + (h)) * HTB)
#define PG8_SB(b, h) ((4 + (b) * 2 + (h)) * HTB)
#define PG8_STAGE_A(bufoff, gbase, voff) do { _Pragma("unroll") for (int _i = 0; _i < 2; ++_i) \
        __builtin_amdgcn_global_load_lds((const unsigned*)((const char*)(gbase) + (voff)[_i]), (PG8_LAS unsigned*)(lds + (bufoff) + ldsw + _i * 8192), 16, 0, PG8_A_AUX); } while (0)
#define PG8_STAGE_B(bufoff, gbase, voff) do { _Pragma("unroll") for (int _i = 0; _i < 2; ++_i) \
        __builtin_amdgcn_global_load_lds((const unsigned*)((const char*)(gbase) + (voff)[_i]), (PG8_LAS unsigned*)(lds + (bufoff) + ldsw + _i * 8192), 16, 0, 0); } while (0)
#define PG8_LDA(dst, b, h) do { _Pragma("unroll") for (int m = 0; m < 4; ++m) _Pragma("unroll") for (int k = 0; k < 2; ++k) dst[m][k] = *(const PG8_LAS bf16x8*)(lds + PG8_SA(b, h) + aoff + m * 2048 + k * 1024); } while (0)
#define PG8_LDB(dst, b, h) do { _Pragma("unroll") for (int n = 0; n < 2; ++n) _Pragma("unroll") for (int k = 0; k < 2; ++k) dst[n][k] = *(const PG8_LAS bf16x8*)(lds + PG8_SB(b, h) + boff + n * 2048 + k * 1024); } while (0)
#define PG8_MMA(ai, bj, At, Bt) do { __builtin_amdgcn_s_setprio(1); _Pragma("unroll") for (int m = 0; m < 4; ++m) _Pragma("unroll") for (int n = 0; n < 2; ++n) _Pragma("unroll") for (int k = 0; k < 2; ++k) \
        acc[ai][bj][m][n] = __builtin_amdgcn_mfma_f32_16x16x32_bf16(Bt[n][k], At[m][k], acc[ai][bj][m][n], 0, 0, 0); __builtin_amdgcn_s_setprio(0); } while (0)
#define PG8_WAIT_V(n) asm volatile("s_waitcnt vmcnt(" #n ")" ::: "memory")
#define PG8_WAIT_L(n) asm volatile("s_waitcnt lgkmcnt(" #n ")" ::: "memory")
#define PG8_BAR __builtin_amdgcn_s_barrier()
#define PG8_SCHED __builtin_amdgcn_sched_barrier(0)
#define PG8_ZERO_ACC() do { _Pragma("unroll") for (int a = 0; a < 2; ++a) _Pragma("unroll") for (int b = 0; b < 2; ++b) _Pragma("unroll") for (int m = 0; m < 4; ++m) _Pragma("unroll") for (int n = 0; n < 2; ++n) acc[a][b][m][n] = (f32x4){0.f, 0.f, 0.f, 0.f}; } while (0)
    unsigned pend = 0u; int par = 0, need_n = 0, upar = 0;
#define CH_SSQ(u) do { upar ^= 1; const int k_ = chain_kin(chain, u.stage, cchain != chain); if (k_ >= 0 && wid == 1) { const unsigned long long* s_ = (const unsigned long long*)(KA()->ws + WS_SSQ) + (size_t)k_ * MT + u.pm * 256 + 2 * lane; \
        _Pragma("unroll") for (int i_ = 0; i_ < 2; ++i_) __builtin_amdgcn_global_load_lds((const unsigned*)(s_ + 128 * i_), (PG8_LAS unsigned*)(sslot + 256 * upar + 128 * i_), 16, 0, 16); } } while (0)
    int qown = (int)(__builtin_amdgcn_s_getreg((3 << 11) | 20) & 7u);
    const int maxsteal = safe ? 7 : 0;
    int qcur = qown, qtried = 0;
#ifndef CH_POP_ASM
#define CH_POP_ASM 0
#endif
#if CH_POP_ASM
#define CH_POP_ISSUE() do { if (wid == 0) { unsigned one_ = 1u; const unsigned* qa_ = qw + 64 * qcur; asm volatile("global_atomic_add %0, %1, %2, off sc0" : "=v"(pend) : "v"(qa_), "v"(one_) : "memory"); } } while (0)
#define CH_POP_WAIT() asm volatile("s_waitcnt vmcnt(8)" : "+v"(pend) :: "memory")
#else
#define CH_POP_ISSUE() do { if (wid == 0 && lane == 0) pend = __hip_atomic_fetch_add(qw + 64 * qcur, 1u, __ATOMIC_RELAXED, __HIP_MEMORY_SCOPE_AGENT); } while (0)
#define CH_POP_WAIT() do {} while (0)
#endif
#ifdef PROBE_NODEP
#define PROBE_NODEP_HOOK() do { if (cchain != chain) need_n = 0; } while (0)
#else
#define PROBE_NODEP_HOOK() do {} while (0)
#endif
#define CH_POP_TAKE(u, ok) do { \
        if (wid == 0) { CH_POP_WAIT(); unsigned L_ = (unsigned)__builtin_amdgcn_readfirstlane((int)pend); int q_ = qcur; \
            while (L_ >= (unsigned)chain_total(chain, q_) && qtried < maxsteal) { ++qtried; qcur = (qcur + 1) & 7; q_ = qcur; \
                unsigned t_ = 0u; if (lane == 0) t_ = __hip_atomic_fetch_add(qw + 64 * q_, 1u, __ATOMIC_RELAXED, __HIP_MEMORY_SCOPE_AGENT); L_ = (unsigned)__builtin_amdgcn_readfirstlane((int)t_); } \
            if (lane == 0) { bx[par * 2] = L_; bx[par * 2 + 1] = (unsigned)q_; } } \
        asm volatile("s_waitcnt lgkmcnt(0)\n\ts_barrier" ::: "memory"); \
        const int Lb_ = __builtin_amdgcn_readfirstlane((int)bx[par * 2]), qb_ = __builtin_amdgcn_readfirstlane((int)bx[par * 2 + 1]); par ^= 1;     ok = Lb_ < chain_total(chain, qb_); \
        if (ok) { chain_decode(chain, qb_, Lb_, u, need_n); PROBE_NODEP_HOOK(); \
            if (need_n && wid == 0) __builtin_amdgcn_global_load_lds(rdy + (size_t)((u.stage - 1) * 68 + u.pm) * 64, (PG8_LAS unsigned*)(rslot + 256 * par), 4, 0, 16); } } while (0)
#define CH_READY(u) do { if (need_n) { \
        if (wid == 0) { unsigned c_ = 0u, sp_ = 0u; \
            for (;;) { c_ = (unsigned)__builtin_amdgcn_readfirstlane((int)__hip_atomic_load(rdy + (size_t)((u.stage - 1) * 68 + u.pm) * 64, __ATOMIC_RELAXED, __HIP_MEMORY_SCOPE_AGENT)); \
                if (c_ >= (unsigned)need_n || ++sp_ > (1u << 20)) break; __builtin_amdgcn_s_sleep(2); } } \
        asm volatile("" ::: "memory"); __builtin_amdgcn_s_barrier(); asm volatile("" ::: "memory"); } } while (0)
#ifdef PROBE_UPOK
#define PROBE_TRY(u, ok) do { if (u.stage == 1) ok = true; } while (0)
#else
#define PROBE_TRY(u, ok) do {} while (0)
#endif
#define CH_TRY(u, ok) do { ok = true; if (need_n) { \
        const unsigned c_ = (unsigned)__builtin_amdgcn_readfirstlane((int)*(volatile PG8_LAS unsigned*)(rslot + 256 * par)); ok = c_ >= (unsigned)need_n; PROBE_TRY(u, ok); } } while (0)
#ifdef PROBE_NODRAIN
#define CH_DRAIN() do {} while (0)
#else
#define CH_DRAIN() asm volatile("s_waitcnt vmcnt(0)" ::: "memory")
#endif
#define CH_DONE(u) do { if (u.stage < 3 && !(chain == 4 && u.stage == 2)) { CH_DRAIN();        \
        if (lane == 0) __hip_atomic_fetch_add(rdy + (size_t)(u.stage * 68 + u.pm) * 64, 1u, __ATOMIC_RELAXED, __HIP_MEMORY_SCOPE_AGENT); } } while (0)

    UnitX cur, nxt; bool have;
    CH_POP_ISSUE(); asm volatile("s_waitcnt vmcnt(0)" : "+v"(pend) :: "memory"); CH_POP_TAKE(cur, have);
    if (!have) return;
    f32x4 acc[2][2][4][2];
    bf16x8 At[4][2], B0[2][2], B1[2][2];
    for (;;) {
        PG8_ZERO_ACC();
        const char* cA = cur.A; const char* cB = cur.B;
#define KST(blk_) ((blk_) ? (unsigned)BLK_KT : (unsigned)(BK * 2))
#define HA(blk_, la_) ((blk_) ? (unsigned)BLK_AI : ((unsigned)(la_) << 8))
#define HB(la_) ((unsigned)BLK_AI)
        bool cblk = cur.stage != 0;
        unsigned voffA[2], voffB[2];
        CH_VOFF(cur.lda, cblk, voffA, voffB);
        CH_READY(cur);
        CH_SSQ(cur);
        PG8_STAGE_B(PG8_SB(0, 0), cB, voffB); PG8_STAGE_B(PG8_SB(0, 1), cB + HB(cur.lda), voffB); PG8_STAGE_A(PG8_SA(0, 0), cA, voffA); PG8_STAGE_A(PG8_SA(0, 1), cA + HA(cblk, cur.lda), voffA);
        if (wr == 1) PG8_BAR;
        PG8_WAIT_V(2); PG8_BAR;
        PG8_STAGE_B(PG8_SB(1, 0), cB + BLK_KT, voffB); PG8_STAGE_A(PG8_SA(1, 0), cA + KST(cblk), voffA); PG8_STAGE_B(PG8_SB(1, 1), cB + HB(cur.lda) + BLK_KT, voffB);
        PG8_WAIT_V(6); PG8_BAR;
        bool brk = false;
        for (;;) {
            bool chainon = false;
            const char* nA = cA; const char* nB = cB;
            int nLA = cur.lda; bool nblk = cblk;
            const int nt = cur.K / BK;
#ifdef PROBE_TIME
#define PT_NOW(v_) do { v_ = PROBE_TIME == 1 ? __builtin_amdgcn_s_memrealtime() : __builtin_amdgcn_s_memtime(); asm volatile("s_waitcnt lgkmcnt(0)" : "+s"(v_) :: "memory"); } while (0)
            const bool ptm_ = wid == 0 && __builtin_amdgcn_workgroup_id_x() == PROBE_WG && (PROBE_STAGE < 0 || cur.stage == PROBE_STAGE) && chain == PROBE_CH && cchain == chain;
            unsigned long long pt0_ = 0; if (ptm_ && PROBE_SEG == 1) PT_NOW(pt0_);
#endif
            for (int t = 0; t < nt; t += 2) {
                if (t == nt - 6) CH_POP_ISSUE();
#if defined(PROBE_TIME) && (PROBE_SEG == 4 || PROBE_SEG == 5)
                unsigned long long pq0_ = 0; if (t == nt - 4 && ptm_) PT_NOW(pq0_);
#endif
                if (t == nt - 4) { bool has_next; CH_POP_TAKE(nxt, has_next);
#if defined(PROBE_TIME) && PROBE_SEG == 4
                    if (ptm_) { unsigned long long pq1_; PT_NOW(pq1_); if (lane == 0) bx[44] = bx[44] + (unsigned)(pq1_ - pq0_); }
#endif

                    brk = has_next && nxt.pm == cur.pm && nxt.stage == cur.stage + 1;
                    chainon = has_next && !brk;
                    if (chainon) { nA = nxt.A; nB = nxt.B; nLA = nxt.lda; nblk = nxt.stage != 0; } }
                const bool last = (t == nt - 2);
                if (last && chainon) { bool ok_; CH_TRY(nxt, ok_);
                    if (!ok_) { chainon = false; brk = true; nA = cA; nB = cB; nLA = cur.lda; nblk = cblk; } }
                const unsigned kstA = KST(cblk), hA = HA(cblk, cur.lda);
                const char* a1 = cA + (size_t)((unsigned)(t + 1) * kstA);
                const char* a2 = last ? nA : cA + (size_t)((unsigned)(t + 2) * kstA); const char* b2 = last ? nB : cB + (size_t)(t + 2) * BLK_KT;
                const char* a3 = a2 + (last ? KST(nblk) : kstA); const char* b3 = b2 + BLK_KT;
                const unsigned h2A = last ? HA(nblk, nLA) : hA, h2B = last ? HB(nLA) : HB(cur.lda);
                unsigned vA2[2], vB2[2];
                if (last) CH_VOFF(nLA, nblk, vA2, vB2);
                else {
#pragma unroll
                    for (int i = 0; i < 2; ++i) { vA2[i] = voffA[i]; vB2[i] = voffB[i]; } }
                PG8_LDB(B0, 0, 0); PG8_LDB(B1, 0, 1); PG8_SCHED; PG8_LDA(At, 0, 0); PG8_STAGE_A(PG8_SA(1, 1), a1 + hA, voffA);
                PG8_WAIT_V(8); PG8_WAIT_L(0); PG8_BAR; PG8_MMA(0, 0, At, B0); PG8_MMA(0, 1, At, B1); PG8_BAR; PG8_SCHED;
                PG8_LDA(At, 0, 1); PG8_STAGE_B(PG8_SB(0, 0), b2, vB2); PG8_STAGE_B(PG8_SB(0, 1), b2 + h2B, vB2); PG8_STAGE_A(PG8_SA(0, 0), a2, vA2);
                PG8_WAIT_V(8); PG8_WAIT_L(0); PG8_BAR; PG8_MMA(1, 0, At, B0); PG8_MMA(1, 1, At, B1); PG8_BAR; PG8_SCHED;
                PG8_LDB(B0, 1, 0); PG8_LDB(B1, 1, 1); PG8_SCHED; PG8_LDA(At, 1, 0); PG8_STAGE_A(PG8_SA(0, 1), a2 + h2A, vA2);
                PG8_WAIT_V(8); PG8_WAIT_L(0); PG8_BAR; PG8_MMA(0, 0, At, B0); PG8_MMA(0, 1, At, B1); PG8_BAR; PG8_SCHED;
                PG8_LDA(At, 1, 1); PG8_STAGE_B(PG8_SB(1, 0), b3, vB2); PG8_STAGE_B(PG8_SB(1, 1), b3 + h2B, vB2); PG8_STAGE_A(PG8_SA(1, 0), a3, vA2);
                PG8_WAIT_V(8); PG8_WAIT_L(0); PG8_BAR; PG8_MMA(1, 0, At, B0); PG8_MMA(1, 1, At, B1); PG8_BAR; PG8_SCHED;
            }
#ifdef PROBE_TIME
            if (ptm_) { if (PROBE_SEG == 1) { unsigned long long pt1_; PT_NOW(pt1_); if (lane == 0) bx[44] = bx[44] + (unsigned)(pt1_ - pt0_); }
                if (lane == 0) bx[45] = bx[45] + (unsigned)nt; }
#endif
            if (wr == 0) PG8_BAR;
#ifdef PROBE_TIME
            if (ptm_ && PROBE_SEG == 2) PT_NOW(pt0_);
#endif
#ifdef PROBE_NOEPI
            if (cchain != chain) { _Pragma("unroll") for (int a_ = 0; a_ < 2; ++a_) _Pragma("unroll") for (int b_ = 0; b_ < 2; ++b_) _Pragma("unroll") for (int m_ = 0; m_ < 4; ++m_)
                asm volatile("" :: "v"(acc[a_][b_][m_][0]), "v"(acc[a_][b_][m_][1])); }
            else
#endif
#ifdef PROBE_ST
            if (cchain != chain) {
                const rsrc_t rq_ = mk_rsrc(KA()->ws + WS_MIX, MT * 1024u * 2u);
                const unsigned qo_ = (PROBE_ST == 1 ? (unsigned)(cur.pm * 256 + wr * 64 + fr) * 1024u + (cur.pn & 3) * 256 + wc * 32 + 8 * fq : (unsigned)((cur.pm * 4 + (cur.pn & 3)) * 8 + wid) * 8192u + lane * 8) * 2u;
                _Pragma("unroll") for (int a_ = 0; a_ < 2; ++a_) _Pragma("unroll") for (int m_ = 0; m_ < 4; ++m_) _Pragma("unroll") for (int b_ = 0; b_ < 2; ++b_) {
                    const u32x4 w_ = pack8(acc[a_][b_][m_][0], acc[a_][b_][m_][1]);
                    bst16(rq_, qo_ + 2u * (PROBE_ST == 1 ? (a_ * 128 + m_ * 16) * 1024 + b_ * 128 : (a_ * 8 + m_ * 2 + b_) * 512), w_, false);
                }
            } else
#endif
            chain_epilogue(chain, cchain != chain, safe || cur.pm >= 64, sslot + 256 * upar, lds + (EPITR_OFF - RING_OFF) + wid * 2048, cur, acc, wr, wc, fr, fq);
#if defined(PROBE_TIME) && PROBE_SEG == 6
            if (ptm_) PT_NOW(pt0_);
#endif
            PG8_ZERO_ACC();
            asm volatile("" ::: "memory");
            CH_DONE(cur);
#ifdef PROBE_TIME
            if (ptm_ && (PROBE_SEG == 2 || PROBE_SEG == 6)) { unsigned long long pt1_; PT_NOW(pt1_); if (lane == 0) bx[44] = bx[44] + (unsigned)(pt1_ - pt0_); }
#endif
            if (!chainon) break;
            cur = nxt; cA = nA; cB = nB; cblk = nblk;
            CH_VOFF(cur.lda, cblk, voffA, voffB);
            CH_SSQ(cur);
            if (wr == 1) PG8_BAR;
        }
        PG8_WAIT_V(0);
        PG8_BAR;
        if (!brk) break;
        cur = nxt;
    }
#undef PG8_SA
#undef PG8_SB
#undef PG8_STAGE_A
#undef PG8_STAGE_B
#undef PG8_LDA
#undef PG8_LDB
#undef PG8_MMA
#undef PG8_WAIT_V
#undef PG8_WAIT_L
#undef PG8_BAR
#undef PG8_SCHED
#undef PG8_ZERO_ACC
#undef CH_POP_ISSUE
#undef CH_POP_WAIT
#undef CH_POP_TAKE
#undef CH_VOFF
#undef CH_SSQ
#undef CH_TRY
#undef KST
#undef HA
#undef HB
#undef CH_READY
#undef CH_DONE
}
}

#define GAS __attribute__((address_space(1)))
#define LAS __attribute__((address_space(3)))
typedef unsigned short bf16;
typedef unsigned v4u __attribute__((ext_vector_type(4)));
typedef float f32x4 __attribute__((ext_vector_type(4)));
typedef short bf16x8 __attribute__((ext_vector_type(8)));
typedef GAS unsigned gu32;
typedef GAS unsigned long long gu64;
#define RLX_AGENT __ATOMIC_RELAXED, __HIP_MEMORY_SCOPE_AGENT
#define LDS_WAIT() asm volatile("s_waitcnt lgkmcnt(0)" ::: "memory")
#define VM_WAIT() asm volatile("s_waitcnt vmcnt(0)" ::: "memory")
__device__ __forceinline__ unsigned long long rt() { return __builtin_amdgcn_s_memrealtime(); }
__device__ __forceinline__ unsigned f2bf(float f) { unsigned u = __builtin_bit_cast(unsigned, f); return (u + 0x7fffu + ((u >> 16) & 1u)) >> 16; }
typedef float f32x2_t __attribute__((ext_vector_type(2))); typedef __bf16 bf16x2_t __attribute__((ext_vector_type(2)));
__device__ __forceinline__ unsigned pk2(float lo, float hi) { f32x2_t v = {lo, hi}; bf16x2_t b = __builtin_convertvector(v, bf16x2_t); return __builtin_bit_cast(unsigned, b); }

#define XB_TMO      128
#define XB_XCNT(j)  (256  + 64 * (j))
#define XB_XSUB(j)  (1280 + 64 * (j))
#define XB_XGEN(j)  (2304 + 64 * (j))
#define XB_TOP      3328
#define XB_TOPGEN   3392
#define XCD_BAR_WORDS 3456
#define XB_SPIN_CAP (1u << 18)

__device__ __forceinline__ unsigned xb_ld(unsigned* p)              { return __hip_atomic_load(p, __ATOMIC_RELAXED, __HIP_MEMORY_SCOPE_AGENT); }
__device__ __forceinline__ unsigned xb_add(unsigned* p, unsigned v) { return __hip_atomic_fetch_add(p, v, __ATOMIC_RELAXED, __HIP_MEMORY_SCOPE_AGENT); }
__device__ __forceinline__ unsigned xb_xcc_id() { return (unsigned)__builtin_amdgcn_s_getreg((3 << 11) | 20) & 0xFu; }
#define XB_SPIN(cond, bar) do { unsigned _sp = 0; while (cond) { __builtin_amdgcn_s_sleep(1); \
    if ((++_sp & 255u) == 0u) { if (xb_ld(&(bar)[XB_TMO])) break; if (_sp > XB_SPIN_CAP) { atomicAdd(&(bar)[XB_TMO], 1u); break; } } } } while (0)

struct XcdBarrier {
    unsigned* bar; unsigned x;
    volatile LAS unsigned* st;
};

__device__ __forceinline__ XcdBarrier xcd_barrier_post(unsigned* bar, volatile LAS unsigned* st) {
    XcdBarrier b; b.bar = bar; b.x = (unsigned)__builtin_amdgcn_readfirstlane((int)xb_xcc_id()); b.st = st;
    if (threadIdx.x == 0) (void)xb_add(&bar[XB_XCNT(b.x)], 1u);
    return b;
}
__device__ __forceinline__ void xcd_barrier_complete(unsigned* bar, unsigned x, unsigned& nloc, unsigned& nx) {
    const unsigned G = gridDim.x * gridDim.y * gridDim.z;
    unsigned sum, cnt, mine, sp = 0u;
    for (;;) {
        sum = 0u; cnt = 0u; mine = 0u;
#pragma unroll
        for (unsigned j = 0; j < 16; ++j) { const unsigned c = xb_ld(&bar[XB_XCNT(j)]); sum += c; cnt += (c > 0u) ? 1u : 0u; mine = (j == x) ? c : mine; }
        if (sum == G) break;
        __builtin_amdgcn_s_sleep(1);
        if ((++sp & 255u) == 0u) { if (xb_ld(&bar[XB_TMO])) break; if (sp > XB_SPIN_CAP) { atomicAdd(&bar[XB_TMO], 1u); break; } }
    }
    nloc = mine > 0u ? mine : 1u; nx = cnt > 0u ? cnt : 1u;
}

__device__ __forceinline__ void xcd_barrier(const XcdBarrier& b) {
    asm volatile("s_waitcnt vmcnt(0)" ::: "memory");
    __syncthreads();
    if (threadIdx.x == 0) {
        unsigned* bar = b.bar;
        __builtin_amdgcn_s_waitcnt(0);
        unsigned nloc = b.st[0], nx = b.st[1];
        if (nloc == 0u) { xcd_barrier_complete(bar, b.x, nloc, nx); b.st[0] = nloc; b.st[1] = nx; }
        const unsigned old = xb_add(&bar[XB_XSUB(b.x)], 1u);
        const unsigned gen = old / nloc;
        if (old + 1u == (gen + 1u) * nloc) {
            __builtin_amdgcn_fence(__ATOMIC_RELEASE, "agent");
            asm volatile("s_waitcnt vmcnt(0)" ::: "memory");
            const unsigned og = xb_add(&bar[XB_TOP], 1u);
            const unsigned tg = og / nx;
            if (og + 1u == (tg + 1u) * nx) xb_add(&bar[XB_TOPGEN], 1u);
            else XB_SPIN(xb_ld(&bar[XB_TOPGEN]) == tg, bar);
            __builtin_amdgcn_fence(__ATOMIC_ACQUIRE, "agent");
            xb_add(&bar[XB_XGEN(b.x)], 1u);
            asm volatile("s_waitcnt vmcnt(0)" ::: "memory");
        } else {
            XB_SPIN(xb_ld(&bar[XB_XGEN(b.x)]) == gen, bar);
            __builtin_amdgcn_fence(__ATOMIC_ACQUIRE, "agent");
            asm volatile("s_waitcnt vmcnt(0)" ::: "memory");
        }
    }
    __syncthreads();
}
typedef unsigned v2u __attribute__((ext_vector_type(2)));
typedef float f32x16 __attribute__((ext_vector_type(16)));
typedef short s16x4 __attribute__((ext_vector_type(4)));
#define WAIT_ALL_BAR() asm volatile("s_waitcnt vmcnt(0) lgkmcnt(0)\n\ts_barrier" ::: "memory")
__device__ __forceinline__ float bflo(unsigned w) { return __builtin_bit_cast(float, w << 16); }
__device__ __forceinline__ float bfhi(unsigned w) { return __builtin_bit_cast(float, w & 0xffff0000u); }
__device__ __forceinline__ void glds16(const void* gsrc, unsigned lds_dst) { unsigned keep;
    asm volatile("s_mov_b32 %0, m0\n\ts_mov_b32 m0, %2\n\ts_nop 0\n\tglobal_load_lds_dwordx4 %1, off\n\ts_mov_b32 m0, %0" : "=&s"(keep) : "v"(gsrc), "s"(lds_dst) : "memory"); }
typedef short v4i16_t __attribute__((ext_vector_type(4)));
__device__ __forceinline__ s16x4 vtr(const LAS unsigned char* p) { return __builtin_bit_cast(s16x4, __builtin_amdgcn_ds_read_tr16_b64_v4i16((LAS v4i16_t*)p)); }
#define LBAR() asm volatile("s_waitcnt lgkmcnt(0)\n\ts_barrier" ::: "memory")

struct Frame {
    LAS unsigned char* lds;
    volatile LAS unsigned* MISC;
    gu32* ctl;
    int tid, lane, wave, vcu, G;
};
using pg8::Args; using pg8::KArgs; using pg8::KA;

__device__ __forceinline__ float wave_sum(float v) {
#pragma unroll
    for (int o = 1; o < 64; o <<= 1) v += __shfl_xor(v, o);
    return v;
}
__device__ __forceinline__ void p0_transpose_item(const float* W, int K, int N, bf16* WT, int drow0, const float* g, LAS float* scr, int k0, int n0, int lane, int ldt) {
    const int n4 = 4 * (lane & 7), kr = lane >> 3; const bool ok = (n0 + n4) < N;
    f32x4 wv[8]; float gv[8];
#pragma unroll
    for (int i = 0; i < 8; ++i) { const int kk = 8 * i + kr; wv[i] = *(const GAS f32x4*)(W + (size_t)(k0 + kk) * N + (ok ? n0 + n4 : 0)); gv[i] = g ? g[k0 + kk] : 1.f; }
#pragma unroll
    for (int i = 0; i < 8; ++i) { const int kk = 8 * i + kr; const f32x4 x = ok ? wv[i] * gv[i] : (f32x4){0.f, 0.f, 0.f, 0.f};
        scr[kk * 33 + n4] = x[0]; scr[kk * 33 + n4 + 1] = x[1]; scr[kk * 33 + n4 + 2] = x[2]; scr[kk * 33 + n4 + 3] = x[3]; }
    LDS_WAIT(); asm volatile("" ::: "memory");
    const int c = lane & 7;
#pragma unroll
    for (int j = 0; j < 4; ++j) { const int nn = (lane >> 3) + 8 * j; const LAS float* s = scr + (8 * c) * 33 + nn;
        v4u o; o.x = pk2(s[0 * 33], s[1 * 33]); o.y = pk2(s[2 * 33], s[3 * 33]); o.z = pk2(s[4 * 33], s[5 * 33]); o.w = pk2(s[6 * 33], s[7 * 33]);
        const int nl = (drow0 & 255) + nn, rb = nl & 127, R = (rb & ~31) + 16 * ((nn >> 2) & 1) + 4 * (nn >> 3) + (nn & 3), ob = (R & 15) * 64 + (c & 3) * 16;
        *(GAS v4u*)((GAS unsigned char*)WT + ((size_t)((drow0 >> 8) * (ldt >> 6) + (k0 >> 6)) * 2 + (nl >> 7)) * 16384 + ((R >> 4) * 2 + (c >> 2)) * 1024 + (ob ^ (((ob >> 9) & 1) << 5))) = o; }
    LDS_WAIT(); asm volatile("" ::: "memory");
}
__device__ __forceinline__ void row_to_bf16(const float* xrow, bf16* orow, unsigned long long* ssq16, int lane) {
    const GAS f32x4* xr = (const GAS f32x4*)xrow + lane;
    f32x4 v[4]; float s = 0.f;
#pragma unroll
    for (int j = 0; j < 4; ++j) { v[j] = xr[64 * j]; s += (v[j].x * v[j].x + v[j].y * v[j].y) + (v[j].z * v[j].z + v[j].w * v[j].w); }
    GAS unsigned long long* o8 = (GAS unsigned long long*)orow + lane;
#pragma unroll
    for (int j = 0; j < 4; ++j) o8[64 * j] = (unsigned long long)pk2(v[j].x, v[j].y) | ((unsigned long long)pk2(v[j].z, v[j].w) << 32);
    if (ssq16) { s = wave_sum(s); if (lane == 0) ssq16[0] = (unsigned long long)(s * SSQ_FIX); }
}
__device__ __forceinline__ void p0_prologue(Frame& F) {
    KArgs ka = KA();
    LAS float* scr = (LAS float*)(F.lds + RING_OFF + F.wave * 16384);
    const int gw = F.vcu * NWAVES + F.wave, NGW = F.G * NWAVES;
    unsigned char* ws = ka->ws;
    constexpr int NITEMS = 2 * 1536 + 2 * 512 + 2 * 2176 + 2 * 512 + 4 * 2048 + 4 * 2048;
    for (int it = gw; it < NITEMS; it += NGW) {
        int r = it; const float* W; const float* g = nullptr; bf16* WT; int K = 1024, N, nnb, ldt = 1024; bool perm = false;
        if (r < 3072) { const int j = r / 1536; r -= j * 1536; W = ka->in[10] + (size_t)j * 1024 * 3072; N = 3072; nnb = 96; WT = (bf16*)(ws + WS_WINA) + (size_t)j * 3072 * 1024; g = ka->in[8] + (2 * j) * 1024; perm = true; }
        else if ((r -= 3072) < 1024) { const int j = r / 512; r -= j * 512; W = ka->in[11] + (size_t)j * 1024 * 1024; N = 1024; nnb = 32; WT = (bf16*)(ws + WS_WOA) + (size_t)j * 1024 * 1024; }
        else if ((r -= 1024) < 4352) { const int j = r / 2176; r -= j * 2176; W = ka->in[15] + (size_t)j * 1024 * NMIN_REAL; N = NMIN_REAL; nnb = 136; WT = (bf16*)(ws + WS_WINB) + (size_t)j * NMIN * 1024; g = ka->in[8] + (2 * j + 1) * 1024; }
        else if ((r -= 4352) < 1024) { const int j = r / 512; r -= j * 512; W = ka->in[21] + (size_t)j * 1024 * 1024; N = 1024; nnb = 32; WT = (bf16*)(ws + WS_WOB) + (size_t)j * 1024 * 1024; }
        else if ((r -= 1024) < 8192) { const int j = r / 2048; r -= j * 2048; W = ka->in[22] + (size_t)j * 1024 * 4096; N = 4096; nnb = 128; WT = (bf16*)(ws + WS_WUP) + (size_t)j * 4096 * 1024; g = ka->in[9] + j * 1024; }
        else { r -= 8192; const int j = r / 2048; r -= j * 2048; W = ka->in[23] + (size_t)j * 4096 * 1024; N = 1024; nnb = 32; K = 4096; ldt = 4096; WT = (bf16*)(ws + WS_WDN) + (size_t)j * 1024 * HIDP; }
        const int kb = r / nnb, nb = r % nnb, n0 = 32 * nb;
        int drow0 = n0;
        if (perm) { const int tile = n0 >> 8, rr = n0 & 255, wc = rr >> 6, bj = (rr & 63) >> 5; drow0 = 256 * tile + 128 * bj + 32 * wc; }
        p0_transpose_item(W, K, N, WT, drow0, g, scr, 64 * kb, n0, F.lane, ldt);
    }
    bf16* XB = (bf16*)(ws + WS_XB); unsigned long long* SSQ = (unsigned long long*)(ws + WS_SSQ);
    for (int m = gw; m < MT; m += NGW) {
        const float* xr = (m < MP) ? ka->in[0] + (size_t)m * D : ka->in[1] + (size_t)(m - MP) * D;
        const int r = m & 255; float s = 0.f;
        unsigned char* pb = (unsigned char*)XB + (size_t)(m >> 8) * (256 * D * 2) + (size_t)(r >> 7) * pg8::BLK_AI;
#pragma unroll
        for (int h = 0; h < 2; ++h) {
            const int g = F.lane + 64 * h;
            const f32x4 v0 = *(const GAS f32x4*)(xr + 8 * g), v1 = *(const GAS f32x4*)(xr + 8 * g + 4);
            s += ((v0.x * v0.x + v0.y * v0.y) + (v0.z * v0.z + v0.w * v0.w)) + ((v1.x * v1.x + v1.y * v1.y) + (v1.z * v1.z + v1.w * v1.w));
            v4u o; o.x = pk2(v0.x, v0.y); o.y = pk2(v0.z, v0.w); o.z = pk2(v1.x, v1.y); o.w = pk2(v1.z, v1.w);
            *(GAS v4u*)(pb + (size_t)(g >> 3) * pg8::BLK_KT + pg8::blk_img((r >> 6) & 1, (g >> 2) & 1, (r >> 4) & 3, r & 15, g & 3)) = o;
        }
        s = wave_sum(s); if (F.lane == 0) SSQ[m] = (unsigned long long)(s * SSQ_FIX);
    }
}
__device__ __forceinline__ void cache_to_rings(Frame& F, int j) {
    KArgs ka = KA();
    const unsigned xcd = __builtin_amdgcn_s_getreg((3 << 11) | 20) & 7u;
    unsigned* ctr = (unsigned*)ka->ws + pg8::CW_Q + 64 * 8 * (5 + j) + 64 * xcd;
    bf16* RK = (bf16*)(ka->ws + WS_RK); bf16* RV = (bf16*)(ka->ws + WS_RV);
    unsigned nx = 0u; if (F.lane == 0) nx = __hip_atomic_fetch_add(ctr, 8u, __ATOMIC_RELAXED, __HIP_MEMORY_SCOPE_AGENT);
    for (;;) {
        const unsigned rl = (unsigned)__builtin_amdgcn_readfirstlane((int)nx);
        if (rl >= 2048u) break;
        if (F.lane == 0) nx = __hip_atomic_fetch_add(ctr, 8u, __ATOMIC_RELAXED, __HIP_MEMORY_SCOPE_AGENT);
#pragma unroll 1
        for (int hb = 0; hb < 2; ++hb) {
        const unsigned r0 = xcd * 2048u + rl + 4u * hb;
        f32x4 v[4][4];
#pragma unroll
        for (int k = 0; k < 4; ++k) {
            const int r = (int)r0 + k, tsr = r >> 13, rr = r & 8191, b = rr >> 9, pos = rr & 511;
            const GAS f32x4* xr = (const GAS f32x4*)((tsr ? ka->in[3] : ka->in[2]) + (((size_t)j * 16 + b) * 512 + pos) * D) + F.lane;
#pragma unroll
            for (int q = 0; q < 4; ++q) v[k][q] = xr[64 * q];
        }
#pragma unroll
        for (int k = 0; k < 4; ++k) {
            const int r = (int)r0 + k, tsr = r >> 13, rr = r & 8191, b = rr >> 9, pos = rr & 511;
            GAS unsigned long long* o8 = (GAS unsigned long long*)((tsr ? RV : RK) + ((size_t)b * 576 + pos) * D) + F.lane;
#pragma unroll
            for (int q = 0; q < 4; ++q) o8[64 * q] = (unsigned long long)pk2(v[k][q].x, v[k][q].y) | ((unsigned long long)pk2(v[k][q].z, v[k][q].w) << 32);
        }
        }
    }
}


__device__ __forceinline__ int crow(int r, int hi) { return (r & 3) + 8 * (r >> 2) + 4 * hi; }
constexpr int AT_STAGE = 32768, AT_HEAD = 8192, AT_V = 4096;
constexpr float LOG2E = 1.4426950408889634f;
__device__ __forceinline__ void attn_unit(Frame& F, int cx, int hg, const bf16* Q, const bf16* KP, const bf16* VP, const bf16* RK, const bf16* RV, bf16* O, const float* relb  , const bool newtab, unsigned& seq  ) {
    const int lane = F.lane, wid = F.wave, r32 = lane & 31, hi = lane >> 5;
    const int hh = wid >> 1, head = 4 * hg + hh, rh = wid & 1;
#define AT_PAIR_SYNC() do { asm volatile("s_waitcnt vmcnt(0) lgkmcnt(0)" ::: "memory"); ++seq; if (lane == 0) F.MISC[64 + wid] = seq; \
        while (__builtin_amdgcn_readfirstlane((int)F.MISC[64 + (wid ^ 1)]) - (int)seq < 0) __builtin_amdgcn_s_sleep(0); asm volatile("" ::: "memory"); } while (0)
#ifdef PROBE_ATT
    unsigned long long pa0_ = 0; const bool pam_ = blockIdx.x == PROBE_WG && F.tid == 0;
    if (pam_ && (PROBE_ATT == 1 || PROBE_ATT == 3)) pa0_ = __builtin_amdgcn_s_memrealtime();
#endif
    LAS unsigned char* ring = F.lds + RING_OFF;
    LAS float* btab = (LAS float*)(F.lds + EXTRA_OFF);
    const bf16 *Kb, *Vb; long kvrow0; int it0; long qrow0;
    if (cx < 256) { Kb = KP; Vb = VP; kvrow0 = (long)(cx - 8) * 64; it0 = cx < 8 ? 2 * (8 - cx) : 0; qrow0 = (long)cx * 64; }
    else { const int b = cx - 256; Kb = RK + (size_t)b * 576 * D; Vb = RV + (size_t)b * 576 * D; kvrow0 = 0; it0 = 0; qrow0 = MP + (long)b * 64; }
    const unsigned lds0 = (unsigned)(size_t)ring;
    const bf16* src0; long srcstep;
    if ((wid & 1) == 0) { src0 = Kb + (kvrow0 + (lane >> 2)) * D + (4 * hg + hh) * 64 + ((lane & 3) ^ ((lane >> 4) & 3)) * 8; srcstep = 0; }
    else { src0 = Vb + (kvrow0 + (lane >> 2)) * D + (4 * hg + hh) * 64 + (lane & 3) * 8; srcstep = 0; }
    const unsigned dst0 = lds0 + hh * AT_HEAD + (wid & 1) * AT_V;
#define AT_DMA(it) do { const bf16* s_ = src0 + (long)(it) * 32 * D; const unsigned d_ = dst0 + ((it) & 3) * AT_STAGE; \
        _Pragma("unroll") for (int p = 0; p < 4; ++p) glds16(s_ + (long)(p & 1) * 16 * D + (p >> 1) * 32, (unsigned)__builtin_amdgcn_readfirstlane(d_ + p * 1024)); } while (0)
    AT_DMA(it0); AT_DMA(it0 + 1);
    (void)srcstep;
    bf16x8 qr[4];
    const bf16* Qw = Q + (qrow0 + 32 * rh + r32) * D + head * 64;
#pragma unroll
    for (int d0 = 0; d0 < 4; ++d0) qr[d0] = *(const bf16x8*)(Qw + d0 * 16 + hi * 8);
    if (newtab && (wid & 1) == 0) {
        const float* rb = relb + (4 * hg + hh) * 257; const float* qg = KA()->in[12] + ((relb - KA()->in[14]) / (16 * 257)) * 64; const float* kg = KA()->in[13] + ((relb - KA()->in[14]) / (16 * 257)) * 64;
        float bm = -3.0e38f, bv[6];
#pragma unroll
        for (int i = 0; i < 6; ++i) { const int e = lane + 64 * i; bv[i] = rb[e < 257 ? e : 256]; bm = fmaxf(bm, bv[i]); }
        float gq = fabsf(qg[lane]), gk = fabsf(kg[lane]);
#pragma unroll
        for (int o = 1; o < 64; o <<= 1) { bm = fmaxf(bm, __shfl_xor(bm, o)); gq = fmaxf(gq, __shfl_xor(gq, o)); gk = fmaxf(gk, __shfl_xor(gk, o)); }
        const float M = LOG2E * (8.2f * gq * gk + bm) + 0.25f;
#pragma unroll
        for (int i = 0; i < 6; ++i) { const int e = lane + 64 * i; if (e < 324) btab[hh * 324 + e] = bv[i] * LOG2E - M; }
    }
    float lrun = 0.f; f32x16 o0 = {}, o1 = {};
    const int tq = 32 * rh + r32;
    const LAS float* bt = btab + hh * 324;
#ifdef PROBE_ATT
    if (pam_ && PROBE_ATT == 3) { F.MISC[60] = F.MISC[60] + (unsigned)(__builtin_amdgcn_s_memrealtime() - pa0_); F.MISC[61] = F.MISC[61] + 1u; }
    if (pam_ && PROBE_ATT == 2) pa0_ = __builtin_amdgcn_s_memrealtime();
#endif
    for (int it = it0; it < 18; it += 2) {
        AT_PAIR_SYNC();
        if (it + 2 < 18) { AT_DMA(it + 2); AT_DMA(it + 3); }
        f32x16 p0[2];
        if (it < 12) { const float cb = bt[256];
#pragma unroll
            for (int s = 0; s < 2; ++s)
#pragma unroll
                for (int r = 0; r < 16; ++r) p0[s][r] = cb; }
        else {
#pragma unroll
            for (int s = 0; s < 2; ++s) { const LAS float* bl = bt + (128 + 512 + tq - 32 * (it + s) - 4 * hi - 27);
#pragma unroll
                for (int r = 0; r < 16; ++r) p0[s][r] = bl[27 - ((r & 3) + 8 * (r >> 2))]; } }
#pragma unroll
        for (int s = 0; s < 2; ++s) { const LAS unsigned char* kb = ring + ((it + s) & 3) * AT_STAGE + hh * AT_HEAD + (r32 >> 4) * 1024 + (r32 & 15) * 64;
            const int ks0 = (hi ^ ((r32 >> 2) & 3)) * 16;
#pragma unroll
          for (int d0 = 0; d0 < 4; ++d0) p0[s] = __builtin_amdgcn_mfma_f32_32x32x16_bf16(*(const LAS bf16x8*)(kb + (d0 >> 1) * 2048 + (ks0 ^ ((d0 & 1) * 32))), qr[d0], p0[s], 0, 0, 0); }
        float ps = 0.f;
#pragma unroll
        for (int s = 0; s < 2; ++s)
#pragma unroll
            for (int r = 0; r < 16; ++r) { p0[s][r] = __builtin_amdgcn_exp2f(p0[s][r]); ps += p0[s][r]; }
        lrun += ps;
#pragma unroll
        for (int s = 0; s < 2; ++s) {
            v4u pw[2];
#pragma unroll
            for (int k = 0; k < 2; ++k) pw[k] = (v4u){pk2(p0[s][8 * k], p0[s][8 * k + 1]), pk2(p0[s][8 * k + 2], p0[s][8 * k + 3]), pk2(p0[s][8 * k + 4], p0[s][8 * k + 5]), pk2(p0[s][8 * k + 6], p0[s][8 * k + 7])};
            const LAS unsigned char* vb = ring + ((it + s) & 3) * AT_STAGE + hh * AT_HEAD + AT_V + ((lane >> 4) & 1) * 32 + (lane & 3) * 8 + (4 * hi + ((lane & 15) >> 2)) * 64;
#pragma unroll
            for (int ks = 0; ks < 2; ++ks) {
                const s16x4 l0 = vtr(vb + ks * 1024), h0 = vtr(vb + ks * 1024 + 512), l1 = vtr(vb + 2048 + ks * 1024), h1 = vtr(vb + 2048 + ks * 1024 + 512);
                const bf16x8 v0 = (bf16x8){l0[0], l0[1], l0[2], l0[3], h0[0], h0[1], h0[2], h0[3]}, v1 = (bf16x8){l1[0], l1[1], l1[2], l1[3], h1[0], h1[1], h1[2], h1[3]};
                const bf16x8 pa = __builtin_bit_cast(bf16x8, pw[ks]);
                o0 = __builtin_amdgcn_mfma_f32_32x32x16_bf16(v0, pa, o0, 0, 0, 0);
                o1 = __builtin_amdgcn_mfma_f32_32x32x16_bf16(v1, pa, o1, 0, 0, 0);
            }
        }
    }
#undef AT_DMA
#ifdef PROBE_ATT
    if (pam_ && PROBE_ATT == 2) { F.MISC[60] = F.MISC[60] + (unsigned)(__builtin_amdgcn_s_memrealtime() - pa0_); F.MISC[61] = F.MISC[61] + 1u; }
#endif
    { auto rr = __builtin_amdgcn_permlane32_swap(__float_as_uint(lrun), __float_as_uint(lrun), false, false); lrun = __uint_as_float(rr[0]) + __uint_as_float(rr[1]); }
    const float rl = 1.0f / lrun;
    AT_PAIR_SYNC();
    {
        LAS unsigned char* scr = ring + wid * 4096;
        LAS unsigned char* wp = scr + r32 * 128 + hi * 8;
#pragma unroll
        for (int g = 0; g < 4; ++g) {
            v2u w0, w1;
            w0.x = pk2(o0[4 * g] * rl, o0[4 * g + 1] * rl); w0.y = pk2(o0[4 * g + 2] * rl, o0[4 * g + 3] * rl);
            w1.x = pk2(o1[4 * g] * rl, o1[4 * g + 1] * rl); w1.y = pk2(o1[4 * g + 2] * rl, o1[4 * g + 3] * rl);
            *(LAS v2u*)(wp + ((g ^ (r32 & 7)) * 16)) = w0; *(LAS v2u*)(wp + (((4 + g) ^ (r32 & 7)) * 16)) = w1;
        }
        asm volatile("s_waitcnt lgkmcnt(0)" ::: "memory");
        bf16* Ob = O + (qrow0 + 32 * rh + (lane >> 3)) * D + head * 64 + (lane & 7) * 8;
#pragma unroll
        for (int i = 0; i < 4; ++i) {
            const int r = 8 * i + (lane >> 3);
            const v4u w = *(const LAS v4u*)(scr + r * 128 + (((lane & 7) ^ (r & 7)) * 16));
            *(v4u*)(Ob + (size_t)(8 * i) * D) = w;
        }
    }
    AT_PAIR_SYNC();
#undef AT_PAIR_SYNC
#ifdef PROBE_ATT
    if (pam_ && PROBE_ATT == 1) { F.MISC[60] = F.MISC[60] + (unsigned)(__builtin_amdgcn_s_memrealtime() - pa0_); F.MISC[61] = F.MISC[61] + 1u; }
#endif
}
__device__ __forceinline__ void attn_phase(Frame& F, int j) {
    KArgs ka = KA(); unsigned char* ws = ka->ws;
    const bf16 *Q = (const bf16*)(ws + WS_Q), *KP = (const bf16*)(ws + WS_KP), *VP = (const bf16*)(ws + WS_VP), *RK = (const bf16*)(ws + WS_RK), *RV = (const bf16*)(ws + WS_RV);
    bf16* O = (bf16*)(ws + WS_O);
    const float* relb = ka->in[14] + (size_t)j * 16 * 257;
    const int x = F.vcu >> 5, c = F.vcu & 31;
    int hgprev = -1;
    unsigned seq = 0u; if (F.lane == 0) F.MISC[64 + F.wave] = 0u;
    WAIT_ALL_BAR();
#pragma unroll 1
    for (int i = 0; ; ++i) {
        int cx, hg;
        if (F.G == 256) { if (i < 4) { cx = 32 * x + 16 * (i & 1) + (c >> 1); hg = 2 * (i >> 1) + (c & 1); } else if (i == 4 && c < 8) { cx = 256 + 2 * x + (c >> 2); hg = c & 3; } else break; }
        else { const int u = F.vcu + i * F.G; if (u >= 272 * 4) break; cx = u >> 2; hg = u & 3; }
        attn_unit(F, cx, hg, Q, KP, VP, RK, RV, O, relb, hg != hgprev, seq); hgprev = hg;
    }
}

struct MUnit { int head, ntok, b, isS; long row0; };
__device__ __forceinline__ void munit(int u, MUnit& m) {
    if (u < 512) { m.head = u & 3; m.ntok = 128; m.row0 = (long)(u >> 2) * 128; m.isS = 0; m.b = 0; }
    else { const int v = u - 512; m.head = v & 3; m.b = v >> 2; m.ntok = 64; m.row0 = MP + (long)m.b * 64; m.isS = 1; }
}
__device__ __forceinline__ f32x4 mfma16(bf16x8 a, bf16x8 b, f32x4 c) { return __builtin_amdgcn_mfma_f32_16x16x32_bf16(a, b, c, 0, 0, 0); }
__device__ __forceinline__ bf16x8 trfrag(const LAS unsigned char* p) { const s16x4 lo = vtr(p), hi = vtr(p + 1024); return (bf16x8){lo[0], lo[1], lo[2], lo[3], hi[0], hi[1], hi[2], hi[3]}; }
constexpr int MSTART_OFF = 2048;


__device__ __forceinline__ void gate_scans(LAS float* xs, int tid, int ntok, float& bt, float& ut, float& pm) {
    const int lane = tid & 63; const bool on = tid < 128;
    float b = on ? xs[128 + (tid < ntok ? tid : 0)] : 0.f; if (tid >= ntok) b = 0.f;
#pragma unroll
    for (int o = 1; o < 64; o <<= 1) { const float y = __shfl_up(b, o); if (lane >= o) b += y; }
    if (on && lane == 63) xs[512 + (tid >> 6)] = b;
    LBAR();
    if (on && tid >= 64) b += xs[512];
    const float ig = (tid < ntok) ? xs[tid] : 0.f;
    float u = (tid < ntok) ? ig - b : -3.0e38f, m = u;
#pragma unroll
    for (int o = 1; o < 64; o <<= 1) { const float y = __shfl_up(m, o); if (lane >= o) m = fmaxf(m, y); }
    if (on && lane == 63) xs[514 + (tid >> 6)] = m;
    LBAR();
    if (on && tid >= 64) m = fmaxf(m, xs[514]);
    if (tid < ntok) { xs[128 + tid] = b; xs[256 + tid] = u; xs[384 + tid] = m; }
    bt = b; ut = u; pm = m;
}

__device__ __forceinline__ int slab_off(int e, int d) { return e < 256 ? (e >> 6) * 32768 + (d >> 3) * 1024 + (e & 63) * 16 + (d & 7) * 2 : 131072 + (d >> 3) * 256 + (e - 256) * 16 + (d & 7) * 2; }
__device__ __forceinline__ void slab_ed(int vi, int& e, int& d) {
    const int off = vi * 8;
    if (off < 131072) { e = (off >> 15) * 64 + ((off >> 4) & 63); d = ((off >> 10) & 31) * 8 + ((off >> 3) & 1) * 4; }
    else { const int t = off - 131072; e = 256 + ((t >> 4) & 15); d = (t >> 8) * 8 + ((t >> 3) & 1) * 4; }
}
__device__ __forceinline__ void mlstm_a_unit(Frame& F, int j, int u) {
    MUnit mu; munit(u, mu); KArgs ka = KA();
#ifdef PROBE_MA
    unsigned pm_last_ = 0; const bool pmm_ = blockIdx.x == PROBE_WG && F.tid == 0 && u < 512;
#define PM_MARK(k_) do { if (pmm_) { const unsigned now_ = (unsigned)__builtin_amdgcn_s_memrealtime(); if ((k_) > 0 && ((k_) - 1 == PROBE_MA || PROBE_MA == 9)) F.MISC[60] = F.MISC[60] + (now_ - pm_last_); if ((k_) == 4) F.MISC[61] = F.MISC[61] + 1u; pm_last_ = now_; } } while (0)
    PM_MARK(0);
#endif
    unsigned char* ws = ka->ws;
    const bf16* QKP = (const bf16*)(ws + WS_QKP); const bf16* V = (const bf16*)(ws + WS_V);
    bf16* QC = (bf16*)(ws + WS_QC); bf16* KC = (bf16*)(ws + WS_KC);
    bf16* slab = (bf16*)(ws + WS_SLAB + (size_t)u * SLAB_BYTES);
    const float* gates = (const float*)(ka->ws + WS_GATES); float* stats = (float*)(ka->ws + WS_STATS);
    LAS float* xs = (LAS float*)(F.lds + EXTRA_OFF + 9216);
    LAS unsigned char* Kt = F.lds + RING_OFF; LAS unsigned char* Wv = F.lds + RING_OFF + 65536;
    const int tid = F.tid, lane = F.lane, wid = F.wave, head = mu.head, ntok = mu.ntok; const long row0 = mu.row0;
    if (tid < ntok) { xs[tid] = gates[(row0 + tid) * 8 + head]; xs[128 + tid] = gates[(row0 + tid) * 8 + 4 + head]; }
    LBAR();
    float bt, ut, pmx; gate_scans(xs, tid, ntok, bt, ut, pmx);
    LBAR();
    const float umax = xs[384 + ntok - 1], bsum = xs[128 + ntok - 1];
    LBAR();
    if (tid < ntok) xs[256 + tid] = expf(ut - umax) * 0.0625f;
    if (tid == 0) { stats[u * 2] = bsum; stats[u * 2 + 1] = umax; }
    const int nh = ntok >> 6;
    const int cgi = tid & 63, rseg = tid >> 6, c = cgi & 31; const bool isk = cgi >= 32;
    const int qcol = (isk ? 1024 : 0) + head * 256 + 8 * c;
    const int vc = tid & 31, kseg = tid >> 5;
    float cw[4][8], cb[8];
#pragma unroll
    for (int jj = 0; jj < 4; ++jj) { const f32x4 w0 = *(const f32x4*)(ka->in[18] + ((size_t)j * 4 + jj) * 2048 + qcol), w1 = *(const f32x4*)(ka->in[18] + ((size_t)j * 4 + jj) * 2048 + qcol + 4);
#pragma unroll
        for (int e = 0; e < 4; ++e) { cw[jj][e] = w0[e]; cw[jj][4 + e] = w1[e]; } }
    { const f32x4 w0 = *(const f32x4*)(ka->in[19] + (size_t)j * 2048 + qcol), w1 = *(const f32x4*)(ka->in[19] + (size_t)j * 2048 + qcol + 4);
#pragma unroll
      for (int e = 0; e < 4; ++e) { cb[e] = w0[e]; cb[4 + e] = w1[e]; } }
    LBAR();
#ifdef PROBE_MA
    PM_MARK(1);
#endif
    for (int hs = 0; hs < nh; ++hs) {
        v4u xr[11], vr[4];
#pragma unroll
        for (int i = 0; i < 11; ++i) { const long gr = row0 + 64 * hs + 8 * rseg + i - 3; xr[i] = *(const v4u*)(QKP + (size_t)(gr < 0 ? 0 : gr) * 2048 + qcol); }
#pragma unroll
        for (int i = 0; i < 4; ++i) vr[i] = *(const v4u*)(V + (size_t)(row0 + 64 * hs + 4 * kseg + i) * D + head * 256 + 8 * vc);
        {
            float x0[8], x1[8], x2[8];
#pragma unroll
            for (int e = 0; e < 8; ++e) { x0[e] = 0.f; x1[e] = 0.f; x2[e] = 0.f; }
#pragma unroll
            for (int i = -3; i < 8; ++i) {
                const int tt = 64 * hs + 8 * rseg + i;
                float x[8];
                {
                    const long gr = row0 + tt; const v4u w = xr[i + 3];
                    x[0] = bflo(w.x); x[1] = bfhi(w.x); x[2] = bflo(w.y); x[3] = bfhi(w.y); x[4] = bflo(w.z); x[5] = bfhi(w.z); x[6] = bflo(w.w); x[7] = bfhi(w.w);
                    if (i < 0) {
                        const int ts = tt < -3 ? -3 : (tt > -1 ? -1 : tt);
                        const float* sp = ka->in[7] + (((size_t)j * 16 + mu.b) * 3 + (3 + ts)) * 2048 + qcol;
                        const f32x4 w0 = *(const f32x4*)sp, w1 = *(const f32x4*)(sp + 4);
                        const bool useS = mu.isS && tt < 0, zero = !mu.isS && gr < 0;
#pragma unroll
                        for (int e = 0; e < 4; ++e) { x[e] = useS ? w0[e] : (zero ? 0.f : x[e]); x[4 + e] = useS ? w1[e] : (zero ? 0.f : x[4 + e]); }
                    }
                }
                if (i >= 0) {
                    float y[8];
#pragma unroll
                    for (int e = 0; e < 8; ++e) { const float s = cb[e] + cw[0][e] * x0[e] + cw[1][e] * x1[e] + cw[2][e] * x2[e] + cw[3][e] * x[e]; float v = s * __builtin_amdgcn_rcpf(1.0f + __expf(-s)); y[e] = v; }
                    v4u o; o.x = pk2(y[0], y[1]); o.y = pk2(y[2], y[3]); o.z = pk2(y[4], y[5]); o.w = pk2(y[6], y[7]);
                    *(v4u*)((isk ? KC : QC) + (size_t)(row0 + tt) * D + head * 256 + 8 * c) = o;
                    if (isk) *(LAS v4u*)(Kt + (c >> 2) * 8192 + (64 * hs + 8 * rseg + i) * 64 + (c & 3) * 16) = o;
                }
#pragma unroll
                for (int e = 0; e < 8; ++e) { x0[e] = x1[e]; x1[e] = x2[e]; x2[e] = x[e]; }
            }
        }
        {
#pragma unroll
            for (int i = 0; i < 4; ++i) {
                const int key = 4 * kseg + i; const float w = xs[256 + 64 * hs + key];
                const v4u x = vr[i];
                v4u o; o.x = pk2(bflo(x.x) * w, bfhi(x.x) * w); o.y = pk2(bflo(x.y) * w, bfhi(x.y) * w); o.z = pk2(bflo(x.z) * w, bfhi(x.z) * w); o.w = pk2(bflo(x.w) * w, bfhi(x.w) * w);
                *(LAS v4u*)(Wv + (vc >> 2) * 8192 + (64 * hs + key) * 64 + (vc & 3) * 16) = o;
            }
            if (tid < 256) { const int key = tid >> 2, ch = tid & 3; v4u o = (v4u){0u, 0u, 0u, 0u}; if (ch == 0) o.x = f2bf(xs[256 + 64 * hs + key]); *(LAS v4u*)(Wv + 8 * 8192 + (64 * hs + key) * 64 + ch * 16) = o; }
        }
    }
    LBAR();
#ifdef PROBE_MA
    PM_MARK(2);
#endif
    f32x4 acc[2][17];
#pragma unroll
    for (int dd = 0; dd < 2; ++dd)
#pragma unroll
        for (int eb = 0; eb < 17; ++eb) acc[dd][eb] = (f32x4){0.f, 0.f, 0.f, 0.f};
    {
        const int g = lane >> 4, q = (lane & 15) >> 2, p = lane & 3;
        for (int ks = 0; ks < 2 * nh; ++ks) {
            const int koff = (32 * ks + 4 * g + q) * 64 + p * 8;
            bf16x8 af[2];
#pragma unroll
            for (int dd = 0; dd < 2; ++dd) { const int db = 2 * wid + dd; af[dd] = trfrag(Kt + (db >> 1) * 8192 + (db & 1) * 32 + koff); }
#pragma unroll
            for (int eb = 0; eb < 17; ++eb) {
                const bf16x8 bfr = trfrag(Wv + (eb >> 1) * 8192 + (eb & 1) * 32 + koff);
                acc[0][eb] = mfma16(af[0], bfr, acc[0][eb]); acc[1][eb] = mfma16(af[1], bfr, acc[1][eb]);
            }
        }
    }
#ifdef PROBE_MA
    PM_MARK(3);
#endif
    {
        const int g = lane >> 4, el = lane & 15;
        unsigned char* sb1 = (unsigned char*)slab + el * 16 + (g & 1) * 8 + wid * 4096 + (g >> 1) * 1024;
        unsigned char* sb2 = (unsigned char*)slab + 131072 + el * 16 + (g & 1) * 8 + wid * 1024 + (g >> 1) * 256;
#pragma unroll
        for (int dd = 0; dd < 2; ++dd)
#pragma unroll
            for (int eb = 0; eb < 17; ++eb) {
                const f32x4 v = acc[dd][eb];
                v2u o; o.x = pk2(v[0], v[1]); o.y = pk2(v[2], v[3]);
                *(v2u*)(eb < 16 ? sb1 + (eb >> 2) * 32768 + (eb & 3) * 256 + dd * 2048 : sb2 + dd * 512) = o;
            }
    }
    LBAR();
#ifdef PROBE_MA
    PM_MARK(4);
#endif
}

__device__ __forceinline__ void mlstm_b_phase(Frame& F, int j, bool dry = false) {
    KArgs ka = KA();
    unsigned char* A = ka->ws; unsigned char* slab0 = A + WS_SLAB;
    float* stats = (float*)(ka->ws + WS_STATS); float* mstart = stats + MSTART_OFF;
    LAS float* tab = (LAS float*)(F.lds + EXTRA_OFF);
    const int tid = F.tid;
    for (int vb = F.vcu; vb < 256; vb += F.G) {
        if (vb < 136) {
            const int head = vb / 34, vi = (vb % 34) * 512 + tid;
            LBAR();
            if (tid < 128) { const int u = tid * 4 + head; tab[272 + tid] = stats[u * 2]; tab[400 + tid] = stats[u * 2 + 1]; }
            LBAR();
            {
                const int ln = tid & 63; float sa = 0.f, sb = -3.0e38f;
                if (tid < 128) { sa = tab[272 + tid]; sb = tab[400 + tid] + sa; }
#pragma unroll
                for (int o = 1; o < 64; o <<= 1) { const float ya = __shfl_up(sa, o), yb = __shfl_up(sb, o); if (ln >= o) { sb = fmaxf(yb + sa, sb); sa = ya + sa; } }
                if (tid == 63) { tab[660] = sa; tab[661] = sb; }
                LBAR();
                if (tid >= 64 && tid < 128) { const float ya = tab[660], yb = tab[661]; sb = fmaxf(yb + sa, sb); sa = ya + sa; }
                if (tid < 128) { const float mend = fmaxf(sa, sb);
                    if (tid < 127) tab[528 + tid + 1] = mend; else tab[256] = mend;
                    if (tid == 0) tab[528] = 0.f; }
            }
            LBAR();
            if (tid < 128) { const float bs = tab[272 + tid], um = tab[400 + tid], m = tab[528 + tid], mn = bs + fmaxf(m, um);
                tab[tid] = expf(bs + m - mn); tab[128 + tid] = expf(bs + um - mn); if (vb % 34 == 0 && !dry) mstart[tid * 4 + head] = m; }
            LBAR();
            f32x4 C = (f32x4){0.f, 0.f, 0.f, 0.f};
            unsigned char* p0 = slab0 + (size_t)head * SLAB_BYTES + (size_t)vi * 8;
            for (int J0 = 0; J0 < 128; J0 += 16) {
                v2u dq[16];
#pragma unroll
                for (int k = 0; k < 16; ++k) dq[k] = *(const v2u*)(p0 + (size_t)(J0 + k) * 4 * SLAB_BYTES);
#pragma unroll
                for (int k = 0; k < 16; ++k) {
                    v2u o; o.x = pk2(C[0], C[1]); o.y = pk2(C[2], C[3]);
                    *(v2u*)(dry ? A + WS_QKP + (size_t)((J0 + k) & 63) * MiB + (size_t)vi * 8 : p0 + (size_t)(J0 + k) * 4 * SLAB_BYTES) = o;
                    const float dc = tab[J0 + k], sc = tab[128 + J0 + k];
                    C[0] = dc * C[0] + sc * bflo(dq[k].x); C[1] = dc * C[1] + sc * bfhi(dq[k].x); C[2] = dc * C[2] + sc * bflo(dq[k].y); C[3] = dc * C[3] + sc * bfhi(dq[k].y);
                }
            }
            int e, d; slab_ed(vi, e, d);
            if (!dry) {
            if (e < 256) *(f32x4*)(ka->out + O_CP + (((size_t)j * 4 + head) * 256 + e) * 256 + d) = C;
            else if (e == 256) *(f32x4*)(ka->out + O_NP + ((size_t)j * 4 + head) * 256 + d) = C;
            if (vb % 34 == 0 && tid == 0) ka->out[O_MP + j * 4 + head] = tab[256];
            }
        } else {
            constexpr int SN = 64 * 17408, SS = 120 * 512;
            for (int idx0 = (vb - 136) * 512 + tid; idx0 < SN; idx0 += 4 * SS) {
                int vi_[4], u_[4], e_[4]; size_t sh_[4]; bool ok_[4]; f32x4 C0_[4], N0_[4]; v2u dq_[4]; float m0_[4], bs_[4], um_[4]; unsigned char* p_[4];
#pragma unroll
                for (int k = 0; k < 4; ++k) {
                    const int idx = idx0 + k * SS; ok_[k] = idx < SN; const int ic = ok_[k] ? idx : 0;
                    const int v = ic / 17408, vi = ic - v * 17408, b = v >> 2, head = v & 3; vi_[k] = vi; u_[k] = 512 + v; int d; slab_ed(vi, e_[k], d);
                    sh_[k] = ((size_t)j * 16 + b) * 4 + head;
                    m0_[k] = ka->in[6][sh_[k]]; bs_[k] = stats[u_[k] * 2]; um_[k] = stats[u_[k] * 2 + 1];
                    C0_[k] = *(const f32x4*)(ka->in[4] + (sh_[k] * 256 + (e_[k] < 256 ? e_[k] : 0)) * 256 + d);
                    N0_[k] = *(const f32x4*)(ka->in[5] + sh_[k] * 256 + d);
                    p_[k] = slab0 + (size_t)u_[k] * SLAB_BYTES + (size_t)vi * 8;
                    dq_[k] = *(const v2u*)p_[k];
                }
#pragma unroll
                for (int k = 0; k < 4; ++k) if (ok_[k]) {
                    int e, d; slab_ed(vi_[k], e, d); const size_t sh = sh_[k];
                    const float m0 = m0_[k], bs = bs_[k], um = um_[k], mn = bs + fmaxf(m0, um), dc = expf(bs + m0 - mn), sc = expf(bs + um - mn);
                    const f32x4 C0 = e < 256 ? C0_[k] : (e == 256 ? N0_[k] : (f32x4){0.f, 0.f, 0.f, 0.f});
                    const v2u dq = dq_[k];
                    v2u o; o.x = pk2(C0[0], C0[1]); o.y = pk2(C0[2], C0[3]); if (!dry) *(v2u*)p_[k] = o;
                    f32x4 Ce; Ce[0] = dc * C0[0] + sc * bflo(dq.x); Ce[1] = dc * C0[1] + sc * bfhi(dq.x); Ce[2] = dc * C0[2] + sc * bflo(dq.y); Ce[3] = dc * C0[3] + sc * bfhi(dq.y);
                    if (!dry) { if (e < 256) *(f32x4*)(ka->out + O_CS + (sh * 256 + e) * 256 + d) = Ce; else if (e == 256) *(f32x4*)(ka->out + O_NS + sh * 256 + d) = Ce;
                        if (vi_[k] == 0) { ka->out[O_MS + sh] = mn; mstart[u_[k]] = m0; } }
                    else if (Ce[0] == 1.2345e30f) ka->out[0] = Ce[1];
                }
            }
        }
    }
}

__device__ __forceinline__ void mlstm_c_unit(Frame& F, int j, int u, bool dry = false) {
#ifdef PROBE_MC
    unsigned pc_last_ = 0; const bool pcm_ = blockIdx.x == PROBE_WG && F.tid == 0 && u < 512;
#define PC_MARK(k_) do { if (pcm_) { const unsigned now_ = (unsigned)__builtin_amdgcn_s_memrealtime(); if ((k_) > 0 && ((k_) - 1 == PROBE_MC || PROBE_MC == 9)) F.MISC[60] = F.MISC[60] + (now_ - pc_last_); if ((k_) == 6) F.MISC[61] = F.MISC[61] + 1u; pc_last_ = now_; } } while (0)
    PC_MARK(0);
#endif
    MUnit mu; munit(u, mu); KArgs ka = KA();
    unsigned char* A = ka->ws;
    const bf16* V = (const bf16*)(A + WS_V); bf16* OG = (bf16*)(A + WS_OG);
    const bf16* QC = (const bf16*)(A + WS_QC); const bf16* KC = (const bf16*)(A + WS_KC);
    const bf16* slab = (const bf16*)(A + WS_SLAB + (size_t)u * SLAB_BYTES);
    const float* gates = (const float*)(ka->ws + WS_GATES); const float* stats = (const float*)(ka->ws + WS_STATS);
    LAS float* xs = (LAS float*)(F.lds + EXTRA_OFF + 9216);
    LAS unsigned char* ring = F.lds + RING_OFF; const unsigned lds0 = (unsigned)(size_t)ring;
    const int tid = F.tid, lane = F.lane, wid = F.wave, head = mu.head, ntok = mu.ntok; const long row0 = mu.row0;
    const int tl = lane & 15, g = lane >> 4, t = 16 * wid + tl;
    const bool active = 16 * wid < ntok;
    const float ms = stats[MSTART_OFF + u];
#pragma unroll
    for (int ct = 0; ct < 4; ++ct)
#pragma unroll
        for (int k = 0; k < 4; ++k) { const int c = wid * 4 + k;
            glds16((const unsigned char*)slab + ct * 32768 + c * 1024 + lane * 16, (unsigned)__builtin_amdgcn_readfirstlane(lds0 + ct * 32768 + c * 1024)); }
    bf16x8 qf[8];
#pragma unroll
    for (int kd = 0; kd < 8; ++kd) qf[kd] = *(const bf16x8*)(QC + (size_t)(row0 + (active ? t : 0)) * D + head * 256 + 32 * kd + 8 * g);
    if (tid < ntok) { xs[tid] = gates[(row0 + tid) * 8 + head]; xs[128 + tid] = gates[(row0 + tid) * 8 + 4 + head]; }
    LBAR();
    float bt, ut, pmx; gate_scans(xs, tid, ntok, bt, ut, pmx);
    if (tid < ntok) { xs[384 + tid] = bt + fmaxf(ms, pmx); xs[256 + tid] = ut * LOG2E; }
    LBAR();
    float b_t = 0.f, m_t = 0.f;
    if (active) { b_t = xs[128 + t]; m_t = xs[384 + t]; }
    const float a_t = (b_t - m_t) * LOG2E - 4.0f, inter_t = expf(b_t + ms - m_t);
    WAIT_ALL_BAR();
#ifdef PROBE_MC
    PC_MARK(1);
#endif
    f32x4 acc[16];
#pragma unroll
    for (int eb = 0; eb < 16; ++eb) acc[eb] = (f32x4){0.f, 0.f, 0.f, 0.f};
    if (active) {
#pragma unroll
        for (int eb = 0; eb < 16; ++eb) {
            const LAS unsigned char* cb = ring + (eb >> 2) * 32768 + g * 1024 + ((eb & 3) * 16 + tl) * 16;
#pragma unroll
            for (int kd = 0; kd < 8; ++kd) acc[eb] = mfma16(*(const LAS bf16x8*)(cb + kd * 4096), qf[kd], acc[eb]);
        }
    }
    WAIT_ALL_BAR();
#ifdef PROBE_MC
    PC_MARK(2);
#endif
#define MC_DMA_KV(kt, bk, bv) do { \
        _Pragma("unroll") for (int k = 0; k < 4; ++k) { const int pc = wid * 4 + k;        \
            glds16(KC + (size_t)(row0 + 64 * (kt) + 16 * k + (lane >> 2)) * D + head * 256 + wid * 32 + ((lane & 3) ^ ((lane >> 4) & 3)) * 8, (unsigned)__builtin_amdgcn_readfirstlane(lds0 + (bk) * 32768 + pc * 1024)); } \
        _Pragma("unroll") for (int k = 0; k < 4; ++k) { const int pc = wid * 4 + k, cg = pc >> 2, rg = pc & 3; \
            glds16(V + (size_t)(row0 + 64 * (kt) + 16 * rg + (lane >> 2)) * D + head * 256 + cg * 32 + (lane & 3) * 8, (unsigned)__builtin_amdgcn_readfirstlane(lds0 + (bv) * 32768 + pc * 1024)); } } while (0)
#pragma unroll
    for (int k = 0; k < 4; ++k) { const int c = wid * 4 + k; const int rr = lane > 15 ? 15 : lane;
        glds16((const unsigned char*)slab + 131072 + c * 256 + rr * 16, (unsigned)__builtin_amdgcn_readfirstlane(lds0 + c * 1024)); }
    MC_DMA_KV(0, 2, 3);
    WAIT_ALL_BAR();
#ifdef PROBE_MC
    PC_MARK(3);
#endif
    float nq = 0.f;
    {
        f32x4 ad = (f32x4){0.f, 0.f, 0.f, 0.f};
        if (active) {
            const LAS unsigned char* cb = ring + g * 1024 + tl * 16;
#pragma unroll
            for (int kd = 0; kd < 8; ++kd) ad = mfma16(*(const LAS bf16x8*)(cb + kd * 4096), qf[kd], ad);
        }
        nq = __shfl(ad[0], tl);
    }
#pragma unroll
    for (int eb = 0; eb < 16; ++eb) acc[eb] = acc[eb] * inter_t;
    float den = inter_t * nq, denp = 0.f;
    WAIT_ALL_BAR();
#ifdef PROBE_MC
    PC_MARK(4);
#endif
    const int nkt = ntok >> 6;
    if (nkt > 1) MC_DMA_KV(1, 0, 1);
    for (int kt = 0; kt < nkt; ++kt) {
        if (kt == 1) WAIT_ALL_BAR();
        const LAS unsigned char* bK = ring + (kt == 0 ? 2 : 0) * 32768; const LAS unsigned char* bV = bK + 32768;
        if (active && kt <= (wid >> 2)) {
            f32x4 sacc[4];
#pragma unroll
            for (int sb = 0; sb < 4; ++sb) { sacc[sb] = (f32x4){0.f, 0.f, 0.f, 0.f};
                const LAS unsigned char* kb = bK + sb * 1024 + tl * 64 + ((g ^ ((tl >> 2) & 3)) * 16);
#pragma unroll
                for (int kd = 0; kd < 8; ++kd) sacc[sb] = mfma16(*(const LAS bf16x8*)(kb + kd * 4096), qf[kd], sacc[sb]); }
            unsigned pw[8];
#pragma unroll
            for (int sb = 0; sb < 4; ++sb) {
                const f32x4 c4 = *(const LAS f32x4*)(xs + 256 + 64 * kt + 16 * sb + 4 * g);
                float pv[4];
#pragma unroll
                for (int r = 0; r < 4; ++r) { const int s = 64 * kt + 16 * sb + 4 * g + r; const float w = __builtin_amdgcn_exp2f(fminf(a_t + c4[r], -4.0f)); pv[r] = (s <= t) ? sacc[sb][r] * w : 0.f; denp += pv[r]; }
                pw[2 * sb] = pk2(pv[0], pv[1]); pw[2 * sb + 1] = pk2(pv[2], pv[3]);
            }
            const bf16x8 pf0 = __builtin_bit_cast(bf16x8, (v4u){pw[0], pw[1], pw[2], pw[3]}), pf1 = __builtin_bit_cast(bf16x8, (v4u){pw[4], pw[5], pw[6], pw[7]});
            const int q = tl >> 2, p = lane & 3;
            const LAS unsigned char* vb = bV + (4 * g + q) * 64 + p * 8;
#pragma unroll
            for (int eb = 0; eb < 16; ++eb) {
                const LAS unsigned char* ve = vb + (eb >> 1) * 4096 + (eb & 1) * 32;
                acc[eb] = mfma16(trfrag(ve), pf0, acc[eb]);
                acc[eb] = mfma16(trfrag(ve + 32 * 64), pf1, acc[eb]);
            }
        }
    }
#undef MC_DMA_KV
#ifdef PROBE_MC
    PC_MARK(5);
#endif
    denp += __shfl_xor(denp, 16); denp += __shfl_xor(denp, 32);
    den += denp;
    const float inv = 1.0f / fmaxf(fabsf(den), expf(-m_t));
    float ss = 0.f;
#pragma unroll
    for (int eb = 0; eb < 16; ++eb) { acc[eb] = acc[eb] * inv; const f32x4 x = acc[eb]; ss += (x[0] * x[0] + x[1] * x[1]) + (x[2] * x[2] + x[3] * x[3]); }
    ss += __shfl_xor(ss, 16); ss += __shfl_xor(ss, 32);
    const float rr = __builtin_amdgcn_rsqf(ss * (1.0f / 256.0f) + 1e-6f);
    if (active) {
        const float* hn = ka->in[20] + (size_t)j * 1024 + head * 256;
        LAS unsigned char* scr = ring + (nkt > 1 ? 2 : 0) * 32768 + wid * 8192;
        bf16* gbase = (dry ? (bf16*)(A + WS_QKP) : OG) + (size_t)(row0 + 16 * wid + (lane >> 5)) * D + head * 256 + (lane & 31) * 8;
        const bf16* gin = OG + (size_t)(row0 + 16 * wid + (lane >> 5)) * D + head * 256 + (lane & 31) * 8;
        v4u gv[8];
#pragma unroll
        for (int i = 0; i < 8; ++i) gv[i] = *(const v4u*)(gin + (size_t)(2 * i) * D);
#pragma unroll
        for (int i = 0; i < 8; ++i) { const int r = 2 * i + (lane >> 5); *(LAS v4u*)(scr + r * 512 + (((lane & 31) ^ r) * 16)) = gv[i]; }
        asm volatile("s_waitcnt lgkmcnt(0)" ::: "memory");
        LAS unsigned char* lp = scr + tl * 512 + (g & 1) * 8;
#pragma unroll
        for (int eb = 0; eb < 16; ++eb) {
            const int e0 = 16 * eb + 4 * g; const f32x4 h4 = *(const f32x4*)(hn + e0); const f32x4 x = acc[eb];
            LAS v2u* p = (LAS v2u*)(lp + (((2 * eb + (g >> 1)) ^ tl) * 16));
            const v2u og = *p;
            v2u o; o.x = pk2(x[0] * rr * h4[0] * bflo(og.x), x[1] * rr * h4[1] * bfhi(og.x)); o.y = pk2(x[2] * rr * h4[2] * bflo(og.y), x[3] * rr * h4[3] * bfhi(og.y));
            *p = o;
        }
        asm volatile("s_waitcnt lgkmcnt(0)" ::: "memory");
#pragma unroll
        for (int i = 0; i < 8; ++i) { const int r = 2 * i + (lane >> 5); *(v4u*)(gbase + (size_t)(2 * i) * D) = *(const LAS v4u*)(scr + r * 512 + (((lane & 31) ^ r) * 16)); }
    }
    WAIT_ALL_BAR();
#ifdef PROBE_MC
    PC_MARK(6);
#endif
}


__global__ void __launch_bounds__(NWAVES * 64, 2) hybrid_fwd(Args args_unused) {
    extern __shared__ __attribute__((aligned(16))) unsigned char lds[];
    Frame F;
    F.lds = (LAS unsigned char*)lds;
    F.MISC = (volatile LAS unsigned*)(F.lds + MISC_OFF);
#define FRESH() do { int t_ = threadIdx.x; asm volatile("" : "+v"(t_)); F.tid = t_; F.lane = t_ & 63; F.wave = __builtin_amdgcn_readfirstlane(t_ >> 6); \
        unsigned l_ = (unsigned)(size_t)(LAS unsigned char*)lds; asm volatile("" : "+s"(l_)); F.lds = (LAS unsigned char*)(size_t)l_; F.MISC = (volatile LAS unsigned*)(F.lds + MISC_OFF); } while (0)
    FRESH();
    F.G = gridDim.x; { const int bx = blockIdx.x; F.vcu = (F.G % 8 == 0) ? (bx % 8) * (F.G / 8) + bx / 8 : bx; }
    F.ctl = (gu32*)(KA()->ws + WS_CTL);
    for (int u = F.tid; u < (LDS_BYTES - LDSCTL_OFF) / 4; u += NWAVES * 64) ((LAS unsigned*)(F.lds + LDSCTL_OFF))[u] = 0u;
    __syncthreads();
    (void)xcd_barrier_post((unsigned*)(F.ctl + CW_BAR), F.MISC + 8);
#define GRID_BAR() do { FRESH(); XcdBarrier b_; b_.bar = (unsigned*)((gu32*)(KA()->ws + WS_CTL) + CW_BAR); b_.x = (unsigned)__builtin_amdgcn_readfirstlane((int)xb_xcc_id()); b_.st = F.MISC + 8; xcd_barrier(b_); } while (0)

#ifndef PROBE_ONECH
#define PROBE_ONECH -1
#endif
#ifdef PROBE_PHC
#define PT_MARK(cls_) do { if (blockIdx.x == PROBE_WG && threadIdx.x == 0) { const unsigned now_ = (unsigned)__builtin_amdgcn_s_memrealtime(); if ((cls_) == PROBE_PHC || (PROBE_PHC == 9 && (cls_) >= 0)) F.MISC[60] = F.MISC[60] + (now_ - F.MISC[62]); F.MISC[62] = now_; F.MISC[61] = 1u; } } while (0)
#else
#define PT_MARK(cls_) do {} while (0)
#endif
    PT_MARK(-1);
#ifdef PROBE_LAST
    if (blockIdx.x == 0 && threadIdx.x == 0) { const unsigned long long st_ = __builtin_amdgcn_s_memrealtime(); __hip_atomic_store((unsigned long long*)((gu32*)(KA()->ws + WS_CTL) + 12000), st_, __ATOMIC_RELAXED, __HIP_MEMORY_SCOPE_AGENT); }
#endif
    FRESH(); p0_prologue(F);
    GRID_BAR(); PT_MARK(0);
#ifdef PROBE_BARS
    for (int pb_ = 0; pb_ < PROBE_BARS; ++pb_) { GRID_BAR(); }
#endif
#ifdef DUP_P0
    FRESH(); p0_prologue(F);
    GRID_BAR();
#endif
    { if (threadIdx.x == 0) { unsigned full = (F.G == 256) ? 1u : 0u; const unsigned* bw = (const unsigned*)((gu32*)(KA()->ws + WS_CTL) + CW_BAR);
          for (int jx = 0; jx < 16; ++jx) { const unsigned cnt = __hip_atomic_load(bw + XB_XCNT(jx), __ATOMIC_RELAXED, __HIP_MEMORY_SCOPE_AGENT); if (jx < 8 ? cnt != 32u : cnt != 0u) full = 0u; }
          F.MISC[10] = full; }
      __syncthreads(); }
#ifdef FORCE_SAFE
    const bool safe_mode = __builtin_amdgcn_readfirstlane((int)F.MISC[10]) != 12345;
#else
    const bool safe_mode = __builtin_amdgcn_readfirstlane((int)F.MISC[10]) == 0;
#endif
#pragma unroll 1
#ifdef PROBE_DUPCH
    for (int pc = -PROBE_NDUP; pc < 5; ++pc) {
        const int chain = pc < 0 ? PROBE_DUPCH : pc; const int j = chain >> 1;
        FRESH(); pg8::gemm_chain(F.lds + RING_OFF, F.MISC + 16, F.lds + RDYSLOT_OFF, (LAS unsigned long long*)(F.lds + EXTRA_OFF), chain, pc < 0 ? 5 - (pc + 1) : chain, safe_mode);
        if (pc < 0) { GRID_BAR(); continue; }
#else
    for (int chain = 0; chain < 5; ++chain) {
        const int j = chain >> 1;
#if defined(PROBE_TIME) && PROBE_SEG == 3
        unsigned long long pc0_ = PROBE_TIME == 1 ? __builtin_amdgcn_s_memrealtime() : __builtin_amdgcn_s_memtime();
#endif
        FRESH(); pg8::gemm_chain(F.lds + RING_OFF, F.MISC + 16, F.lds + RDYSLOT_OFF, (LAS unsigned long long*)(F.lds + EXTRA_OFF), chain, chain, safe_mode);
#if defined(PROBE_TIME) && PROBE_SEG == 3
        if (chain == PROBE_CH && blockIdx.x == PROBE_WG && threadIdx.x == 0) { const unsigned long long pc1_ = PROBE_TIME == 1 ? __builtin_amdgcn_s_memrealtime() : __builtin_amdgcn_s_memtime(); F.MISC[60] = F.MISC[60] + (unsigned)(pc1_ - pc0_); }
#endif
#endif
        if (chain == 4) break;
        if ((chain & 1) == 0) { FRESH(); cache_to_rings(F, j); }
        GRID_BAR(); PT_MARK((PROBE_ONECH < 0 || chain == PROBE_ONECH) ? 1 : 7);
        if ((chain & 1) == 0) {
            FRESH(); attn_phase(F, j);
#ifdef DUP_ATT
            GRID_BAR(); FRESH(); attn_phase(F, j);
#endif
            GRID_BAR(); PT_MARK(2);
        } else {
            FRESH(); for (int u = F.vcu; u < N_MUNITS; u += F.G) mlstm_a_unit(F, j, u);
            GRID_BAR(); PT_MARK(3);
#ifdef DUP_MA
            FRESH(); for (int u = F.vcu; u < N_MUNITS; u += F.G) mlstm_a_unit(F, j, u);
            GRID_BAR();
#endif
#ifdef DUP_MB
            FRESH(); mlstm_b_phase(F, j, true);
            GRID_BAR();
#endif
            FRESH(); mlstm_b_phase(F, j);
            GRID_BAR(); PT_MARK(4);
#ifdef DUP_MC
            FRESH(); for (int u = F.vcu; u < N_MUNITS; u += F.G) mlstm_c_unit(F, j, u, true);
            GRID_BAR();
#endif
            FRESH(); for (int u = F.vcu; u < N_MUNITS; u += F.G) mlstm_c_unit(F, j, u);
            GRID_BAR(); PT_MARK(5);
        }
    }
    PT_MARK(1);
#if defined(PROBE_TIME) || defined(PROBE_PHC) || defined(PROBE_ATT) || defined(PROBE_MA) || defined(PROBE_MC)
    if (blockIdx.x == PROBE_WG && threadIdx.x == 0) { const unsigned tot = F.MISC[60], cnt = F.MISC[61];
        const unsigned long long wait_ticks = cnt ? (unsigned long long)((float)tot * (float)(PROBE_SCALE * 100.0) / (float)cnt) : 0ull;
        const unsigned long long t0 = __builtin_amdgcn_s_memrealtime(); while (__builtin_amdgcn_s_memrealtime() - t0 < wait_ticks) __builtin_amdgcn_s_sleep(8); }
#endif
#ifdef PROBE_LAST
    if (threadIdx.x == 0) { unsigned* cw_ = (unsigned*)KA()->ws + 12064; const unsigned n_ = __hip_atomic_fetch_add(cw_, 1u, __ATOMIC_RELAXED, __HIP_MEMORY_SCOPE_AGENT);
        if (n_ == gridDim.x - 1) { const unsigned long long st_ = __hip_atomic_load((unsigned long long*)((gu32*)(KA()->ws + WS_CTL) + 12000), __ATOMIC_RELAXED, __HIP_MEMORY_SCOPE_AGENT);
            const unsigned long long t0 = __builtin_amdgcn_s_memrealtime(); const unsigned long long wait_ticks = (unsigned long long)((float)(t0 - st_) * (float)PROBE_SCALE);
            while (__builtin_amdgcn_s_memrealtime() - t0 < wait_ticks) __builtin_amdgcn_s_sleep(8); } }
#endif
#undef GRID_BAR
}

extern "C" void kernel_launch(void* const* d_in, const int* in_sizes, int n_in, void* d_out, int out_size, void* d_ws, size_t ws_size, hipStream_t stream) {
    static int grid = 0;
    if (grid == 0) {
        if (n_in != 24 || (size_t)out_size != O_END || ws_size < WS_END) { fprintf(stderr, "kernel_launch: unexpected shapes: n_in %d out %d ws %zu (need %zu)\n", n_in, out_size, ws_size, (size_t)WS_END); grid = -1; return; }
        int dev = 0, cus = 0, per_cu = 0;
        if (hipGetDevice(&dev) != hipSuccess || hipDeviceGetAttribute(&cus, hipDeviceAttributeMultiprocessorCount, dev) != hipSuccess) { fprintf(stderr, "kernel_launch: device query failed\n"); grid = -1; return; }
        if (hipFuncSetAttribute((const void*)hybrid_fwd, hipFuncAttributeMaxDynamicSharedMemorySize, LDS_BYTES) != hipSuccess) { fprintf(stderr, "kernel_launch: hipFuncSetAttribute failed\n"); grid = -1; return; }
        if (hipOccupancyMaxActiveBlocksPerMultiprocessor(&per_cu, (const void*)hybrid_fwd, NWAVES * 64, LDS_BYTES) != hipSuccess || per_cu < 1)
            fprintf(stderr, "kernel_launch: note: occupancy query reports %d workgroups per CU\n", per_cu);
        (void)hipGetLastError();
        grid = cus;
    }
    if (grid < 0) return;
    if (hipMemsetAsync((char*)d_ws + WS_CTL, 0, CTL_ZERO_BYTES, stream) != hipSuccess) { fprintf(stderr, "kernel_launch: hipMemsetAsync failed\n"); return; }
    Args a{};
    for (int i = 0; i < 24; ++i) a.in[i] = (const float*)d_in[i];
    a.out = (float*)d_out; a.ws = (unsigned char*)d_ws;
    hipLaunchKernelGGL(hybrid_fwd, dim3(grid), dim3(NWAVES * 64), LDS_BYTES, stream, a);
    const hipError_t le = hipPeekAtLastError();
    if (le != hipSuccess) fprintf(stderr, "kernel_launch: launch failed: %s\n", hipGetErrorName(le));
}
```
